# Optimizing an MI355X kernel written in HIP

```python
import math
import jax, jax.numpy as jnp
from jax import lax
import numpy as np

D_MODEL = 1024
BATCH = 8
SEQ = 4096
DEPTH = 2

CTX_LEN = 256
GRID_W = 64
EPS = 1e-6
GN_EPS = 64e-5
ROPE_BASE = 10000.0
NEG_INF = -1e30

MIX_W = 256
N_BRANCH = 4
HEAD_DIM = 64

RWKV_HEADS = MIX_W // HEAD_DIM
RWKV_DECAY_RANK = 32
RWKV_ICLR_RANK = 32
RWKV_GATE_RANK = 64

GLA_HEADS = 4
GLA_DK = 32
GLA_DV = 64
GLA_RANK = 16
GLA_TAU = 16.0
GLA_CHUNK = 64

ATTN_HEADS = 4
ATTN_KV_HEADS = 2
WINDOW = 128
ATTN_BLOCK = 128

S5_GROUPS = 16
S5_GROUP_CH = MIX_W // S5_GROUPS
S5_STATE = 64

N_GROUPS = 4
EXPERTS_PER_GROUP = 8
N_EXPERTS = N_GROUPS * EXPERTS_PER_GROUP
EXPERT_HIDDEN = 512
TOP_K = 2
MOE_BLOCK = 128

RWKV_IN = 4 * MIX_W
GLA_IN = 2 * GLA_HEADS * GLA_DK + 2 * GLA_HEADS * GLA_DV + 2 * GLA_RANK
ATTN_IN = (ATTN_HEADS + 2 * ATTN_KV_HEADS) * HEAD_DIM
S5_IN = MIX_W
GATE_IN = N_BRANCH * D_MODEL
P_IN = RWKV_IN + GLA_IN + ATTN_IN + S5_IN + GATE_IN

kernel_name = "hybrid_rwkv_gla_swa_s5_hmoe_dit"


def rmsnorm(x, g):
    xf = x.astype(jnp.float32)
    y = xf * lax.rsqrt(jnp.mean(xf * xf, axis=-1, keepdims=True) + EPS)
    return (y * g.astype(jnp.float32)).astype(x.dtype)


def modulate(h, shift, scale):
    return h * (1.0 + scale) + shift


def to_heads(z, h):
    return z.reshape(z.shape[:-1] + (h, z.shape[-1] // h))


def centered_shift(z):
    zp = jnp.pad(z, ((0, 0), (1, 1), (0, 0)))
    return 0.5 * (zp[:, :-2] + zp[:, 2:])


def split_sections(u):
    o1 = RWKV_IN
    o2 = o1 + GLA_IN
    o3 = o2 + ATTN_IN
    o4 = o3 + S5_IN
    return jnp.split(u, [o1, o2, o3, o4], axis=-1)


def axial_rope_tables(rows):
    row = jnp.repeat(jnp.arange(rows, dtype=jnp.float32), GRID_W)
    col = jnp.tile(jnp.arange(GRID_W, dtype=jnp.float32), rows)
    n_freq = HEAD_DIM // 4
    inv_freq = ROPE_BASE ** (-jnp.arange(n_freq, dtype=jnp.float32) / n_freq)
    ang = jnp.concatenate([row[:, None] * inv_freq, col[:, None] * inv_freq], axis=-1)
    return jnp.cos(ang), jnp.sin(ang)


def apply_rope(z, cos, sin):
    half = HEAD_DIM // 2
    z1, z2 = z[..., :half], z[..., half:]
    cos, sin = cos[:, None, :], sin[:, None, :]
    return jnp.concatenate([z1 * cos - z2 * sin, z1 * sin + z2 * cos], axis=-1)


def rwkv7_scan(r, w, k, v, a, b, s0, reverse):
    def step(s, inp):
        r_t, w_t, k_t, v_t, a_t, b_t = inp
        sa = jnp.einsum('bhvk,bhk->bhv', s, a_t)
        s = s * w_t[:, :, None, :] + sa[..., :, None] * b_t[..., None, :] + v_t[..., :, None] * k_t[..., None, :]
        return s, jnp.einsum('bhvk,bhk->bhv', s, r_t)
    xs = tuple(jnp.moveaxis(z, 1, 0) for z in (r, w, k, v, a, b))
    s_last, ys = lax.scan(step, s0, xs, reverse=reverse)
    return jnp.moveaxis(ys, 0, 1), s_last


def rwkv7_mixer(u_lat, u_ctx, p, ctx_out):
    H = RWKV_HEADS

    def prep(u):
        u = u.astype(jnp.float32)
        mixed = u + (centered_shift(u) - u) * p['rwkv_mu'].reshape(-1)
        r, k, v, xa = jnp.split(mixed, 4, axis=-1)
        kk = to_heads(k * p['rwkv_kk'], H)
        kk = kk * lax.rsqrt(jnp.sum(kk * kk, axis=-1, keepdims=True) + EPS)
        return r, k, v, xa, kk

    def direction(k, xa, kk, d):
        log_w = -jnp.exp(-jax.nn.softplus(-(p['rwkv_w0'][d] + jnp.tanh(xa @ p['rwkv_w1'][d]) @ p['rwkv_w2'][d])) - 0.5)
        iclr = jax.nn.sigmoid(p['rwkv_a0'][d] + (xa @ p['rwkv_a1'][d]) @ p['rwkv_a2'][d])
        k_eff = k * (1.0 + (iclr - 1.0) * p['rwkv_ka'])
        return jnp.exp(to_heads(log_w, H)), to_heads(k_eff, H), -kk, kk * to_heads(iclr, H)

    rl, kl, vl, xal, kkl = prep(u_lat)
    rc, kc, vc, xac, kkc = prep(u_ctx)
    rlh, vlh, rch, vch = to_heads(rl, H), to_heads(vl, H), to_heads(rc, H), to_heads(vc, H)
    s0 = jnp.zeros((u_lat.shape[0], H, HEAD_DIM, HEAD_DIM), jnp.float32)
    y_lat, y_ctx = 0.0, 0.0
    for d in range(2):
        rev = d == 1
        wc, kec, ac, bc = direction(kc, xac, kkc, d)
        yc_d, s_ctx = rwkv7_scan(rch, wc, kec, vch, ac, bc, s0, rev)
        wl, kel, al, bl = direction(kl, xal, kkl, d)
        yl_d, _ = rwkv7_scan(rlh, wl, kel, vlh, al, bl, s_ctx, rev)
        y_lat = y_lat + yl_d
        y_ctx = y_ctx + yc_d

    def finish(y, r, k, v, xa):
        mu = jnp.mean(y, axis=-1, keepdims=True)
        var = jnp.mean(jnp.square(y - mu), axis=-1, keepdims=True)
        y = ((y - mu) * lax.rsqrt(var + GN_EPS)).reshape(r.shape) * p['rwkv_ln_g']
        rh, kh, vh = to_heads(r, H), to_heads(k, H), to_heads(v, H)
        bonus = (jnp.sum(rh * kh * p['rwkv_rk'], axis=-1, keepdims=True) * vh).reshape(r.shape)
        g = jax.nn.sigmoid(xa @ p['rwkv_g1']) @ p['rwkv_g2']
        return (y + bonus) * g

    out_lat = finish(y_lat, rl, kl, vl, xal)
    out_ctx = finish(y_ctx, rc, kc, vc, xac) if ctx_out else None
    return out_lat, out_ctx


def gla_chunked(q, k, v, log_a, s0):
    b, h, t, _ = q.shape
    dv = v.shape[-1]
    n = t // GLA_CHUNK

    def chunks(z):
        return z.reshape(b, h, n, GLA_CHUNK, z.shape[-1])
    q, k, v, log_a = chunks(q), chunks(k), chunks(v), chunks(log_a)
    cum = jnp.cumsum(log_a, axis=3)
    total = cum[:, :, :, -1:, :]
    q_dec = q * jnp.exp(cum)
    k_inv = k * jnp.exp(-cum)
    k_end = k * jnp.exp(total - cum)
    prefix = jnp.tril(jnp.ones((GLA_CHUNK, GLA_CHUNK), jnp.float32))
    scores = jnp.einsum('bhnik,bhnjk->bhnij', q_dec, k_inv) * prefix
    o_intra = jnp.einsum('bhnij,bhnjv->bhniv', scores, v)
    delta = jnp.einsum('bhnjk,bhnjv->bhnkv', k_end, v)
    chunk_decay = jnp.exp(total[:, :, :, 0, :])

    def step(s, inp):
        dcy, ds = inp
        return s * dcy[..., None] + ds, s
    s_last, s_enter = lax.scan(step, s0, (jnp.moveaxis(chunk_decay, 2, 0), jnp.moveaxis(delta, 2, 0)))
    o_inter = jnp.einsum('bhnik,bhnkv->bhniv', q_dec, jnp.moveaxis(s_enter, 0, 2))
    return (o_intra + o_inter).reshape(b, h, t, dv), s_last


def gla_mixer(u_lat, u_ctx, p, ctx_out):
    qk, vw = GLA_HEADS * GLA_DK, GLA_HEADS * GLA_DV

    def bhtd(z):
        return jnp.moveaxis(to_heads(z, GLA_HEADS), 2, 1)

    def prep(u):
        u = u.astype(jnp.float32)
        q, k, v, r, alow = jnp.split(u, [qk, 2 * qk, 2 * qk + vw, 2 * qk + 2 * vw], axis=-1)
        log_a = [bhtd(jax.nn.log_sigmoid(alow[..., d * GLA_RANK:(d + 1) * GLA_RANK] @ p['gla_a2'][d] + p['gla_ab'][d]) / GLA_TAU)
                 for d in range(2)]
        return bhtd(q) * GLA_DK ** -0.5, bhtd(k), bhtd(v), r, log_a

    ql, kl, vl, rl, al = prep(u_lat)
    qc, kc, vc, rc, ac = prep(u_ctx)
    s0 = jnp.zeros((u_lat.shape[0], GLA_HEADS, GLA_DK, GLA_DV), jnp.float32)
    o_lat, o_ctx = 0.0, 0.0
    for d in range(2):
        if d == 1:
            flip = lambda z: jnp.flip(z, axis=2)
        else:
            flip = lambda z: z
        oc_d, s_ctx = gla_chunked(flip(qc), flip(kc), flip(vc), flip(ac[d]), s0)
        ol_d, _ = gla_chunked(flip(ql), flip(kl), flip(vl), flip(al[d]), s_ctx)
        o_lat = o_lat + flip(ol_d)
        o_ctx = o_ctx + flip(oc_d)

    def finish(o, r):
        o = jnp.moveaxis(o, 1, 2)
        o = o * lax.rsqrt(jnp.mean(o * o, axis=-1, keepdims=True) + EPS)
        return o.reshape(r.shape) * p['gla_ln_g'] * jax.nn.silu(r)

    return finish(o_lat, rl), (finish(o_ctx, rc) if ctx_out else None)


def window_attention(u_lat, u_ctx, p, cos, sin, ctx_out):
    H, KVH, hd, BLK = ATTN_HEADS, ATTN_KV_HEADS, HEAD_DIM, ATTN_BLOCK
    G = H // KVH
    scale = hd ** -0.5

    def split_qkv(u):
        q, k, v = jnp.split(u.astype(jnp.float32), [H * hd, (H + KVH) * hd], axis=-1)
        return to_heads(q, H), to_heads(k, KVH), to_heads(v, KVH)

    q, k, v = split_qkv(u_lat)
    qc, kc, vc = split_qkv(u_ctx)
    q = apply_rope(q, cos, sin) * scale
    k = apply_rope(k, cos, sin)
    b, t = q.shape[0], q.shape[1]
    nb = t // BLK
    lc = kc.shape[1]
    sink = p['attn_sink'].astype(jnp.float32).reshape(KVH, G)

    qb = q.reshape(b, nb, BLK, KVH, G, hd)

    def band(z):
        zp = jnp.pad(z, ((0, 0), (BLK, BLK), (0, 0), (0, 0))).reshape(b, nb + 2, BLK, KVH, hd)
        return jnp.concatenate([zp[:, :-2], zp[:, 1:-1], zp[:, 2:]], axis=2)
    kw, vw = band(k), band(v)
    s_w = jnp.einsum('bnqhgd,bnkhd->bnhgqk', qb, kw)
    s_c = jnp.einsum('bnqhgd,bkhd->bnhgqk', qb, kc)
    qpos = jnp.arange(nb)[:, None, None] * BLK + jnp.arange(BLK)[None, :, None]
    kpos = jnp.arange(nb)[:, None, None] * BLK - BLK + jnp.arange(3 * BLK)[None, None, :]
    valid = (jnp.abs(qpos - kpos) <= WINDOW) & (kpos >= 0) & (kpos < t)
    s_w = jnp.where(valid[None, :, None, None], s_w, NEG_INF)
    s_sink = jnp.broadcast_to(sink[None, None, :, :, None, None], s_w.shape[:-1] + (1,))
    probs = jax.nn.softmax(jnp.concatenate([s_w, s_c, s_sink], axis=-1), axis=-1)
    o = (jnp.einsum('bnhgqk,bnkhd->bnqhgd', probs[..., :3 * BLK], vw)
         + jnp.einsum('bnhgqk,bkhd->bnqhgd', probs[..., 3 * BLK:3 * BLK + lc], vc))
    out_lat = o.reshape(b, t, H * hd)

    out_ctx = None
    if ctx_out:
        qcs = qc.reshape(b, lc, KVH, G, hd) * scale
        sc = jnp.einsum('bqhgd,bkhd->bhgqk', qcs, kc)
        sc_sink = jnp.broadcast_to(sink[None, :, :, None, None], sc.shape[:-1] + (1,))
        pc = jax.nn.softmax(jnp.concatenate([sc, sc_sink], axis=-1), axis=-1)
        out_ctx = jnp.einsum('bhgqk,bkhd->bqhgd', pc[..., :lc], vc).reshape(b, lc, H * hd)
    return out_lat, out_ctx


def lti_scan(a_bar, bu, x0):
    bu = bu.at[:, 0].add(a_bar * x0)
    a = jnp.broadcast_to(a_bar, bu.shape)

    def combine(e1, e2):
        a1, b1 = e1
        a2, b2 = e2
        return a1 * a2, a2 * b1 + b2
    return lax.associative_scan(combine, (a, bu), axis=1)[1]


def s5_mixer(u_lat, u_ctx, p, ctx_out):
    f32 = jnp.float32

    def groups(u):
        return u.astype(f32).reshape(u.shape[0], u.shape[1], S5_GROUPS, S5_GROUP_CH)
    ul, uc = groups(u_lat), groups(u_ctx)
    b_mat = lax.complex(p['s5_b_re'].astype(f32), p['s5_b_im'].astype(f32))
    d_skip = p['s5_d'].astype(f32)
    y_lat, y_ctx = d_skip * ul, d_skip * uc
    x0 = jnp.zeros((u_lat.shape[0], S5_GROUPS, S5_STATE), jnp.complex64)
    for d in range(2):
        if d == 1:
            flip = lambda z: jnp.flip(z, axis=1)
        else:
            flip = lambda z: z
        lam = lax.complex(p['s5_lam_re'][d].astype(f32), p['s5_lam_im'][d].astype(f32))
        dt = jnp.exp(p['s5_log_dt'][d].astype(f32))[:, None]
        a_bar = jnp.exp(lam * dt)
        b_bar = ((a_bar - 1.0) / lam)[..., None] * b_mat
        c_mat = lax.complex(p['s5_c_re'][d].astype(f32), p['s5_c_im'][d].astype(f32))
        bu_c = jnp.einsum('gpc,btgc->btgp', b_bar, flip(uc).astype(jnp.complex64))
        bu_l = jnp.einsum('gpc,btgc->btgp', b_bar, flip(ul).astype(jnp.complex64))
        xs_c = lti_scan(a_bar, bu_c, x0)
        xs_l = lti_scan(a_bar, bu_l, xs_c[:, -1])
        y_lat = y_lat + jnp.real(jnp.einsum('gcp,btgp->btgc', c_mat, flip(xs_l)))
        if ctx_out:
            y_ctx = y_ctx + jnp.real(jnp.einsum('gcp,btgp->btgc', c_mat, flip(xs_c)))

    def finish(y):
        y = jax.nn.gelu(y.reshape(y.shape[0], y.shape[1], MIX_W))
        return y * jax.nn.sigmoid(y @ p['s5_w_glu'] + p['s5_b_glu'])
    return finish(y_lat), (finish(y_ctx) if ctx_out else None)


def merge_branches(ys, gate_logits, p):
    gates = jnp.split(gate_logits.astype(jnp.float32), N_BRANCH, axis=-1)
    merged = 0.0
    for i in range(N_BRANCH):
        merged = merged + jax.nn.sigmoid(gates[i]) * (ys[i] @ p['w_branch'][i])
    return merged @ p['w_out']


def hier_moe(h, p):
    n, d = h.shape
    hf = h.astype(jnp.float32)
    rows = jnp.arange(n)
    g_logits = hf @ p['w_router_g'] + p['b_router_g']
    g_sel = jnp.argmax(g_logits, axis=-1).astype(jnp.int32)
    g_w = jax.nn.softmax(g_logits, axis=-1)[rows, g_sel]
    e_logits = (hf @ p['w_router_e'] + p['b_router_e']).reshape(n, N_GROUPS, EXPERTS_PER_GROUP)[rows, g_sel]
    top_v, top_i = lax.top_k(e_logits, TOP_K)
    weights = jax.nn.softmax(top_v, axis=-1) * g_w[:, None]
    expert = g_sel[:, None] * EXPERTS_PER_GROUP + top_i.astype(jnp.int32)

    flat_e = expert.reshape(-1)
    flat_w = weights.reshape(-1)
    flat_tok = jnp.arange(n * TOP_K, dtype=jnp.int32) // TOP_K
    order = jnp.argsort(flat_e)
    se, stok, sw = flat_e[order], flat_tok[order], flat_w[order]
    counts = jnp.zeros((N_EXPERTS,), jnp.int32).at[flat_e].add(1)
    padded = (counts + MOE_BLOCK - 1) // MOE_BLOCK * MOE_BLOCK
    pend = jnp.cumsum(padded)
    pstart = pend - padded
    start = jnp.cumsum(counts) - counts
    dest = pstart[se] + (jnp.arange(n * TOP_K, dtype=jnp.int32) - start[se])
    cap = -(-(n * TOP_K) // MOE_BLOCK) * MOE_BLOCK + N_EXPERTS * MOE_BLOCK
    n_blk = cap // MOE_BLOCK
    buf_tok = jnp.full((cap,), n, jnp.int32).at[dest].set(stok)
    buf_w = jnp.zeros((cap,), jnp.float32).at[dest].set(sw)
    blk_e = jnp.minimum(jnp.searchsorted(pend, jnp.arange(n_blk, dtype=jnp.int32) * MOE_BLOCK, side='right'),
                        N_EXPERTS - 1)
    h_pad = jnp.concatenate([h, jnp.zeros((1, d), h.dtype)], axis=0)
    xb = h_pad[buf_tok].reshape(n_blk, MOE_BLOCK, d)

    def expert_block(args):
        x_blk, e = args
        hid = jax.nn.silu(x_blk @ p['w_exp_gate'][e]) * (x_blk @ p['w_exp_up'][e])
        return hid @ p['w_exp_down'][e]
    y_buf = lax.map(expert_block, (xb, blk_e)).reshape(cap, d) * buf_w[:, None]
    return jax.ops.segment_sum(y_buf, buf_tok, num_segments=n + 1)[:n].astype(h.dtype)


def adaln(cvec, p):
    return jnp.split(jax.nn.silu(cvec) @ p['w_ada'] + p['b_ada'], 6, axis=-1)


def hybrid_layer(x, xc, c, c_ctx, p, cos, sin, ctx_out):
    mods = [m[:, None, :] for m in adaln(c, p)]
    cmods = adaln(c_ctx, p)
    h = modulate(rmsnorm(x, p['norm1_g']), mods[0], mods[1])
    hc = modulate(rmsnorm(xc, p['norm1_g']), cmods[0], cmods[1])
    ua, ub, uatt, us5, ug = split_sections(h @ p['w_in'])
    ca, cb, catt, cs5, cg = split_sections(hc @ p['w_in'])
    ya, yac = rwkv7_mixer(ua, ca, p, ctx_out)
    yb, ybc = gla_mixer(ub, cb, p, ctx_out)
    yc, ycc = window_attention(uatt, catt, p, cos, sin, ctx_out)
    yd, ydc = s5_mixer(us5, cs5, p, ctx_out)
    x = x + (mods[2] * merge_branches((ya, yb, yc, yd), ug, p)).astype(x.dtype)
    if ctx_out:
        xc = xc + (cmods[2] * merge_branches((yac, ybc, ycc, ydc), cg, p)).astype(xc.dtype)

    b, t, d = x.shape
    tokens = modulate(rmsnorm(x, p['norm2_g']), mods[3], mods[4]).reshape(-1, d)
    if ctx_out:
        h2c = modulate(rmsnorm(xc, p['norm2_g']), cmods[3], cmods[4])
        tokens = jnp.concatenate([tokens, h2c.reshape(-1, d)], axis=0)
    y = hier_moe(tokens, p)
    x = x + (mods[5] * y[:b * t].reshape(b, t, d)).astype(x.dtype)
    if ctx_out:
        xc = xc + (cmods[5] * y[b * t:].reshape(xc.shape)).astype(xc.dtype)
    return x, xc


def setup_inputs(seed: int = 0) -> dict:
    key = jax.random.key(seed)
    ks = iter(jax.random.split(key, 64))
    f32 = jnp.float32

    def nrm(shape, scale):
        return scale * jax.random.normal(next(ks), shape, f32)

    def uni(shape, lo, hi):
        return jax.random.uniform(next(ks), shape, f32, lo, hi)

    L, D = DEPTH, D_MODEL
    G, P, CH = S5_GROUPS, S5_STATE, S5_GROUP_CH
    return {
        'x': nrm((BATCH, SEQ, D), 1.0),
        'c': nrm((BATCH, D), 1.0),
        'ctx': nrm((BATCH, CTX_LEN, D), 1.0),
        'c_ctx': nrm((D,), 1.0),
        'norm1_g': 1.0 + nrm((L, D), 0.02),
        'norm2_g': 1.0 + nrm((L, D), 0.02),
        'final_norm_g': 1.0 + nrm((D,), 0.02),
        'w_ada': nrm((L, D, 6 * D), 0.5 * D ** -0.5),
        'b_ada': nrm((L, 6 * D), 0.02),
        'w_in': nrm((L, D, P_IN), D ** -0.5),
        'rwkv_mu': uni((L, 4, MIX_W), 0.0, 1.0),
        'rwkv_w0': uni((L, 2, MIX_W), -5.0, 0.5),
        'rwkv_w1': nrm((L, 2, MIX_W, RWKV_DECAY_RANK), MIX_W ** -0.5),
        'rwkv_w2': nrm((L, 2, RWKV_DECAY_RANK, MIX_W), 0.5 * RWKV_DECAY_RANK ** -0.5),
        'rwkv_a0': nrm((L, 2, MIX_W), 0.1),
        'rwkv_a1': nrm((L, 2, MIX_W, RWKV_ICLR_RANK), MIX_W ** -0.5),
        'rwkv_a2': nrm((L, 2, RWKV_ICLR_RANK, MIX_W), 0.5 * RWKV_ICLR_RANK ** -0.5),
        'rwkv_kk': 0.85 + nrm((L, MIX_W), 0.02),
        'rwkv_ka': 1.0 + nrm((L, MIX_W), 0.02),
        'rwkv_rk': nrm((L, RWKV_HEADS, HEAD_DIM), 0.1),
        'rwkv_g1': nrm((L, MIX_W, RWKV_GATE_RANK), MIX_W ** -0.5),
        'rwkv_g2': nrm((L, RWKV_GATE_RANK, MIX_W), RWKV_GATE_RANK ** -0.5),
        'rwkv_ln_g': 1.0 + nrm((L, MIX_W), 0.02),
        'gla_a2': nrm((L, 2, GLA_RANK, GLA_HEADS * GLA_DK), GLA_RANK ** -0.5),
        'gla_ab': nrm((L, 2, GLA_HEADS * GLA_DK), 0.1),
        'gla_ln_g': 1.0 + nrm((L, MIX_W), 0.02),
        'attn_sink': nrm((L, ATTN_HEADS), 0.5),
        's5_lam_re': -0.5 + nrm((L, 2, G, P), 0.01),
        's5_lam_im': jnp.pi * jnp.arange(P, dtype=f32) + nrm((L, 2, G, P), 0.01),
        's5_log_dt': uni((L, 2, G), math.log(1e-3), math.log(1e-1)),
        's5_b_re': nrm((L, G, P, CH), (2 * CH) ** -0.5),
        's5_b_im': nrm((L, G, P, CH), (2 * CH) ** -0.5),
        's5_c_re': nrm((L, 2, G, CH, P), P ** -0.5),
        's5_c_im': nrm((L, 2, G, CH, P), P ** -0.5),
        's5_d': nrm((L, G, CH), 1.0),
        's5_w_glu': nrm((L, MIX_W, MIX_W), MIX_W ** -0.5),
        's5_b_glu': nrm((L, MIX_W), 0.02),
        'w_branch': nrm((L, N_BRANCH, MIX_W, D), MIX_W ** -0.5),
        'w_out': nrm((L, D, D), D ** -0.5),
        'w_router_g': nrm((L, D, N_GROUPS), D ** -0.5),
        'b_router_g': nrm((L, N_GROUPS), 0.01),
        'w_router_e': nrm((L, D, N_EXPERTS), D ** -0.5),
        'b_router_e': nrm((L, N_EXPERTS), 0.01),
        'w_exp_gate': nrm((L, N_EXPERTS, D, EXPERT_HIDDEN), D ** -0.5),
        'w_exp_up': nrm((L, N_EXPERTS, D, EXPERT_HIDDEN), D ** -0.5),
        'w_exp_down': nrm((L, N_EXPERTS, EXPERT_HIDDEN, D), EXPERT_HIDDEN ** -0.5),
    }


def reference(x, c, ctx, c_ctx, norm1_g, norm2_g, final_norm_g, w_ada, b_ada, w_in,
              rwkv_mu, rwkv_w0, rwkv_w1, rwkv_w2, rwkv_a0, rwkv_a1, rwkv_a2, rwkv_kk, rwkv_ka,
              rwkv_rk, rwkv_g1, rwkv_g2, rwkv_ln_g, gla_a2, gla_ab, gla_ln_g, attn_sink,
              s5_lam_re, s5_lam_im, s5_log_dt, s5_b_re, s5_b_im, s5_c_re, s5_c_im, s5_d,
              s5_w_glu, s5_b_glu, w_branch, w_out, w_router_g, b_router_g, w_router_e, b_router_e,
              w_exp_gate, w_exp_up, w_exp_down):
    rows = x.shape[1] // GRID_W
    cos, sin = axial_rope_tables(rows)
    xc = ctx
    for l in range(DEPTH):
        p = {
            'norm1_g': norm1_g[l], 'norm2_g': norm2_g[l], 'w_ada': w_ada[l], 'b_ada': b_ada[l],
            'w_in': w_in[l],
            'rwkv_mu': rwkv_mu[l], 'rwkv_w0': rwkv_w0[l], 'rwkv_w1': rwkv_w1[l], 'rwkv_w2': rwkv_w2[l],
            'rwkv_a0': rwkv_a0[l], 'rwkv_a1': rwkv_a1[l], 'rwkv_a2': rwkv_a2[l], 'rwkv_kk': rwkv_kk[l],
            'rwkv_ka': rwkv_ka[l], 'rwkv_rk': rwkv_rk[l], 'rwkv_g1': rwkv_g1[l], 'rwkv_g2': rwkv_g2[l],
            'rwkv_ln_g': rwkv_ln_g[l],
            'gla_a2': gla_a2[l], 'gla_ab': gla_ab[l], 'gla_ln_g': gla_ln_g[l],
            'attn_sink': attn_sink[l],
            's5_lam_re': s5_lam_re[l], 's5_lam_im': s5_lam_im[l], 's5_log_dt': s5_log_dt[l],
            's5_b_re': s5_b_re[l], 's5_b_im': s5_b_im[l], 's5_c_re': s5_c_re[l], 's5_c_im': s5_c_im[l],
            's5_d': s5_d[l], 's5_w_glu': s5_w_glu[l], 's5_b_glu': s5_b_glu[l],
            'w_branch': w_branch[l], 'w_out': w_out[l],
            'w_router_g': w_router_g[l], 'b_router_g': b_router_g[l],
            'w_router_e': w_router_e[l], 'b_router_e': b_router_e[l],
            'w_exp_gate': w_exp_gate[l], 'w_exp_up': w_exp_up[l], 'w_exp_down': w_exp_down[l],
        }
        x, xc = hybrid_layer(x, xc, c, c_ctx, p, cos, sin, l < DEPTH - 1)
    return rmsnorm(x, final_norm_g)
```

```cpp
#include <hip/hip_runtime.h>
#include <stdint.h>
#include <stdio.h>

constexpr int D = 1024, NBATCH = 8, SEQ = 4096, CTXL = 256;
constexpr int NLAT = NBATCH * SEQ;
constexpr int NCTX = NBATCH * CTXL;
constexpr int NROW = NLAT + NCTX;
constexpr int PIN = 6688;
constexpr int UW = 2592;
constexpr int NEXP = 32, EH = 512;
constexpr int NTHREADS = 512;
constexpr int MOE_CAP = NROW;

constexpr int U_RWKV = 0, U_ATT = 1024, U_S5 = 1536, U_GLA = 1792;

typedef unsigned short bf16_t;
typedef short bf16x8 __attribute__((ext_vector_type(8)));
typedef float f32x4 __attribute__((ext_vector_type(4)));
#define LDSP(p) ((__attribute__((address_space(3))) unsigned*)(p))

constexpr size_t AL(size_t x) { return (x + 255) & ~(size_t)255; }
constexpr size_t WS_BAR   = 0;
constexpr size_t WS_CNT   = 16384;
constexpr size_t WS_MODS  = 32768;
constexpr size_t WS_WRT   = AL(WS_MODS + (size_t)2 * 9 * 6144 * 4);
constexpr size_t WS_WIN   = AL(WS_WRT + (size_t)36 * 1024 * 4);
constexpr size_t WS_WBR   = AL(WS_WIN + (size_t)PIN * 1024 * 2);
constexpr size_t WS_WOUT  = AL(WS_WBR + (size_t)4 * 1024 * 256 * 2);
constexpr size_t WS_H     = AL(WS_WOUT + (size_t)1024 * 1024 * 2);
constexpr size_t WS_XC    = AL(WS_H + (size_t)NROW * 1024 * 2);
constexpr size_t WS_STOK  = AL(WS_XC + (size_t)NCTX * 1024 * 4);
constexpr size_t WS_TINFO = AL(WS_STOK + (size_t)NEXP * MOE_CAP * 4);
constexpr size_t WS_S5P   = AL(WS_TINFO + (size_t)NROW * 16);
constexpr size_t WS_BIG   = AL(WS_S5P + (size_t)2 * 16 * 64 * 8 + (size_t)2 * 16 * 64 * 16 * 8);
constexpr size_t BIG_U    = 0;
constexpr size_t BIG_MRG  = 0;
constexpr size_t BIG_HID  = 0;
constexpr size_t BIG_WEG  = AL((size_t)NROW * 1024 * 2);
constexpr size_t BIG_WEU  = BIG_WEG + (size_t)NEXP * EH * 1024 * 2;
constexpr size_t BIG_WED  = BIG_WEU + (size_t)NEXP * EH * 1024 * 2;
constexpr size_t BIG_Y    = AL((size_t)NROW * UW * 2);
constexpr size_t BIG_T    = BIG_Y + AL((size_t)NROW * 1024 * 2);
constexpr size_t T_MIX    = BIG_T;
constexpr size_t T_EXT    = T_MIX + AL((size_t)NROW * 768 * 2);
constexpr size_t T_YRW    = T_EXT + AL((size_t)NROW * 1536 * 2);
constexpr size_t T_YGL    = T_YRW + AL((size_t)2 * NROW * 256 * 2);
constexpr size_t T_YS5    = T_YGL + AL((size_t)2 * NROW * 256 * 2);
constexpr size_t T_END    = T_YS5 + AL((size_t)2 * NROW * 256 * 2);
constexpr size_t BIG_YD   = BIG_T;
static_assert(BIG_WED + (size_t)NEXP * 1024 * EH * 2 <= BIG_Y, "experts must fit in U tail");
static_assert(BIG_YD + (size_t)2 * NROW * 1024 * 2 <= T_END, "YD must fit in T");
constexpr size_t WS_END   = WS_BIG + T_END;

struct Args {
    const float* in[46];
    float* out;
    unsigned char* ws;
    int ph_lo, ph_hi;
};

__device__ __forceinline__ bf16_t f2bf(float f) { unsigned u = __float_as_uint(f); u += 0x7FFFu + ((u >> 16) & 1u); return (bf16_t)(u >> 16); }
__device__ __forceinline__ float bf2f(bf16_t h) { return __uint_as_float(((unsigned)h) << 16); }
__device__ __forceinline__ unsigned pack2(float a, float b) { return (unsigned)f2bf(a) | ((unsigned)f2bf(b) << 16); }
__device__ __forceinline__ float siluf(float x) { return x / (1.0f + __expf(-x)); }
__device__ __forceinline__ float sigmf(float x) { return 1.0f / (1.0f + __expf(-x)); }
__device__ __forceinline__ float wave_sum(float v) {
#pragma unroll
    for (int o = 32; o > 0; o >>= 1) v += __shfl_xor(v, o);
    return v;
}

__device__ __forceinline__ void cvt_tile(const float* __restrict__ src, int ldS, int k0, int sc0, bf16_t* __restrict__ dst, int ldD, int dr0, unsigned char* lds) {
    bf16_t* t = (bf16_t*)lds;
    const int tid = threadIdx.x;
#pragma unroll
    for (int i = 0; i < 4; ++i) {
        int e = tid + 512 * i; int k = e >> 5, n = e & 31;
        float v = src[(size_t)(k0 + k) * ldS + sc0 + n];
        t[n * 66 + k] = f2bf(v);
    }
    __syncthreads();
    {
        int n = tid >> 4, k4 = (tid & 15) * 4;
        unsigned x = (unsigned)t[n * 66 + k4] | ((unsigned)t[n * 66 + k4 + 1] << 16);
        unsigned y = (unsigned)t[n * 66 + k4 + 2] | ((unsigned)t[n * 66 + k4 + 3] << 16);
        uint2 w; w.x = x; w.y = y;
        *(uint2*)(dst + (size_t)(dr0 + n) * ldD + k0 + k4) = w;
    }
    __syncthreads();
}

__device__ __forceinline__ int win_src_col(int n) {
    if (n < 1024) return n;
    if (n < 1536) return 1824 + (n - 1024);
    if (n < 1792) return 2336 + (n - 1536);
    if (n < 2592) return 1024 + (n - 1792);
    return n;
}

__device__ __forceinline__ void phase_convert(const Args& a, int l, unsigned char* lds, bool do_main, bool do_experts) {
    unsigned char* ws = a.ws;
    const int nb = gridDim.x, b0 = blockIdx.x;
    if (do_main) {
        {
            const float* src = a.in[9] + (size_t)l * 1024 * PIN;
            bf16_t* dst = (bf16_t*)(ws + WS_WIN);
            for (int w = b0; w < 16 * 209; w += nb) { int kt = w & 15, nt = w >> 4; cvt_tile(src, PIN, kt * 64, win_src_col(nt * 32), dst, 1024, nt * 32, lds); }
        }
        for (int i = 0; i < 4; ++i) {
            const float* src = a.in[37] + ((size_t)l * 4 + i) * 256 * 1024;
            bf16_t* dst = (bf16_t*)(ws + WS_WBR) + (size_t)i * 1024 * 256;
            for (int w = b0; w < 4 * 32; w += nb) { int kt = w & 3, nt = w >> 2; cvt_tile(src, 1024, kt * 64, nt * 32, dst, 256, nt * 32, lds); }
        }
        {
            const float* src = a.in[38] + (size_t)l * 1024 * 1024;
            bf16_t* dst = (bf16_t*)(ws + WS_WOUT);
            for (int w = b0; w < 16 * 32; w += nb) { int kt = w & 15, nt = w >> 4; cvt_tile(src, 1024, kt * 64, nt * 32, dst, 1024, nt * 32, lds); }
        }
        {
            float* dst = (float*)(ws + WS_WRT);
            const float* wg = a.in[39] + (size_t)l * 1024 * 4;
            const float* we = a.in[41] + (size_t)l * 1024 * 32;
            for (int i = b0 * NTHREADS + threadIdx.x; i < 36 * 1024; i += nb * NTHREADS) {
                int o = i >> 10, k = i & 1023;
                dst[i] = (o < 4) ? wg[k * 4 + o] : we[k * 32 + (o - 4)];
            }
        }
    }
    if (do_experts) {
        for (int which = 0; which < 2; ++which) {
            const float* srcb = a.in[43 + which] + (size_t)l * NEXP * 1024 * EH;
            bf16_t* dstb = (bf16_t*)(ws + WS_BIG + (which ? BIG_WEU : BIG_WEG));
            for (int w = b0; w < NEXP * 16 * 16; w += nb) { int e = w >> 8, r = w & 255, kt = r & 15, nt = r >> 4;
                cvt_tile(srcb + (size_t)e * 1024 * EH, EH, kt * 64, nt * 32, dstb + (size_t)e * EH * 1024, 1024, nt * 32, lds); }
        }
        {
            const float* srcb = a.in[45] + (size_t)l * NEXP * EH * 1024;
            bf16_t* dstb = (bf16_t*)(ws + WS_BIG + BIG_WED);
            for (int w = b0; w < NEXP * 8 * 32; w += nb) { int e = w >> 8, r = w & 255, kt = r & 7, nt = r >> 3;
                cvt_tile(srcb + (size_t)e * EH * 1024, 1024, kt * 64, nt * 32, dstb + (size_t)e * 1024 * EH, EH, nt * 32, lds); }
        }
    }
}

__device__ __forceinline__ void phase_ada(const Args& a, unsigned char* lds) {
    float* sil = (float*)lds;
    float* red = (float*)(lds + 9 * 1024 * 4);
    const int tid = threadIdx.x;
    for (int i = tid; i < 9 * 1024; i += NTHREADS) {
        int v = i >> 10, k = i & 1023;
        float x = (v < 8) ? a.in[1][v * 1024 + k] : a.in[3][k];
        sil[i] = siluf(x);
    }
    __syncthreads();
    float* mods = (float*)(a.ws + WS_MODS);
    const int tx = tid & 31, ty = tid >> 5;
    for (int w = blockIdx.x; w < 2 * 192; w += gridDim.x) {
        int l = w / 192, n0 = (w % 192) * 32;
        const float* wa = a.in[7] + (size_t)l * 1024 * 6144;
        float acc[9];
#pragma unroll
        for (int v = 0; v < 9; ++v) acc[v] = 0.f;
        for (int kk = 0; kk < 64; ++kk) {
            int k = ty * 64 + kk;
            float wv = wa[(size_t)k * 6144 + n0 + tx];
#pragma unroll
            for (int v = 0; v < 9; ++v) acc[v] += sil[v * 1024 + k] * wv;
        }
#pragma unroll
        for (int v = 0; v < 9; ++v) red[(ty * 9 + v) * 32 + tx] = acc[v];
        __syncthreads();
        if (tid < 288) {
            int v = tid >> 5, x = tid & 31; float s = 0.f;
            for (int y = 0; y < 16; ++y) s += red[(y * 9 + v) * 32 + x];
            mods[((size_t)l * 9 + v) * 6144 + n0 + x] = s + a.in[8][(size_t)l * 6144 + n0 + x];
        }
        __syncthreads();
    }
}

__device__ __forceinline__ void moe_offsets(const Args& a, int l, int* s_start  , int* s_cnt  ) {
    const unsigned* cnt = (const unsigned*)(a.ws + WS_CNT) + l * 64;
    if (threadIdx.x < 32) s_cnt[threadIdx.x] = (int)cnt[threadIdx.x];
    __syncthreads();
    if (threadIdx.x == 0) { int s = 0; for (int e = 0; e < 32; ++e) { s_start[e] = s; s += s_cnt[e]; } s_start[32] = s; }
    __syncthreads();
}

__device__ __forceinline__ void phase_norm1(const Args& a, int mode, unsigned char* lds) {
    int* s_start = (int*)lds; int* s_cnt = s_start + 64;
    if (mode > 0) moe_offsets(a, mode - 1, s_start, s_cnt);
    const int lane = threadIdx.x & 63, wv = threadIdx.x >> 6;
    const int gw = blockIdx.x * 8 + wv, nw = gridDim.x * 8;
    const int l = (mode == 2) ? 1 : mode;
    const float* mods = (const float*)(a.ws + WS_MODS) + (size_t)l * 9 * 6144;
    const float* pmods = (const float*)(a.ws + WS_MODS) + (size_t)(mode > 0 ? mode - 1 : 0) * 9 * 6144;
    const float* g = (mode == 2) ? a.in[6] : a.in[4] + (size_t)l * 1024;
    bf16_t* H = (bf16_t*)(a.ws + WS_H);
    const bf16_t* YD = (const bf16_t*)(a.ws + WS_BIG + BIG_YD);
    const uint4* tinfo = (const uint4*)(a.ws + WS_TINFO);
    float* XC = (float*)(a.ws + WS_XC);
    const int nrows = (mode == 2) ? NLAT : NROW;
    for (int r = gw; r < nrows; r += nw) {
        const bool lat = r < NLAT;
        const int b = lat ? (r >> 12) : 8;
        const float* xr; float* xw;
        if (lat) { xr = (mode == 0) ? a.in[0] + (size_t)r * 1024 : a.out + (size_t)r * 1024; xw = a.out + (size_t)r * 1024; }
        else { xr = (mode == 0) ? a.in[2] + (size_t)(r - NLAT) * 1024 : XC + (size_t)(r - NLAT) * 1024; xw = XC + (size_t)(r - NLAT) * 1024; }
        float4 v[4];
#pragma unroll
        for (int i = 0; i < 4; ++i) v[i] = ((const float4*)xr)[lane + 64 * i];
        if (mode > 0) {
            const bool has = (mode == 1) || lat;
            if (has) {
                uint4 ti = tinfo[r];
                int e0 = ti.x >> 24, p0 = ti.x & 0xFFFFFF, e1 = ti.z >> 24, p1 = ti.z & 0xFFFFFF;
                float w0 = __uint_as_float(ti.y), w1 = __uint_as_float(ti.w);
                const bf16_t* y0 = YD + (size_t)(s_start[e0] + p0) * 1024;
                const bf16_t* y1 = YD + (size_t)(s_start[e1] + p1) * 1024;
                const float* m5 = pmods + (size_t)b * 6144 + 5 * 1024;
#pragma unroll
                for (int i = 0; i < 4; ++i) {
                    int c = (lane + 64 * i) * 4;
                    uint2 q0 = *(const uint2*)(y0 + c), q1 = *(const uint2*)(y1 + c);
                    float4 mm = *(const float4*)(m5 + c);
                    v[i].x += mm.x * (w0 * bf2f((bf16_t)(q0.x & 0xFFFF)) + w1 * bf2f((bf16_t)(q1.x & 0xFFFF)));
                    v[i].y += mm.y * (w0 * bf2f((bf16_t)(q0.x >> 16)) + w1 * bf2f((bf16_t)(q1.x >> 16)));
                    v[i].z += mm.z * (w0 * bf2f((bf16_t)(q0.y & 0xFFFF)) + w1 * bf2f((bf16_t)(q1.y & 0xFFFF)));
                    v[i].w += mm.w * (w0 * bf2f((bf16_t)(q0.y >> 16)) + w1 * bf2f((bf16_t)(q1.y >> 16)));
                }
                if (mode == 1) {
#pragma unroll
                    for (int i = 0; i < 4; ++i) ((float4*)xw)[lane + 64 * i] = v[i];
                }
            }
        }
        float ss = 0.f;
#pragma unroll
        for (int i = 0; i < 4; ++i) ss += v[i].x * v[i].x + v[i].y * v[i].y + v[i].z * v[i].z + v[i].w * v[i].w;
        ss = wave_sum(ss);
        const float rs = rsqrtf(ss * (1.0f / 1024.0f) + 1e-6f);
        if (mode == 2) {
#pragma unroll
            for (int i = 0; i < 4; ++i) {
                float4 gg = ((const float4*)g)[lane + 64 * i]; float4 o;
                o.x = v[i].x * rs * gg.x; o.y = v[i].y * rs * gg.y; o.z = v[i].z * rs * gg.z; o.w = v[i].w * rs * gg.w;
                ((float4*)xw)[lane + 64 * i] = o;
            }
        } else {
            const float* sh = mods + (size_t)b * 6144;
            const float* sc = mods + (size_t)b * 6144 + 1024;
#pragma unroll
            for (int i = 0; i < 4; ++i) {
                int c = (lane + 64 * i) * 4;
                float4 gg = *(const float4*)(g + c), s4 = *(const float4*)(sh + c), c4 = *(const float4*)(sc + c);
                float o0 = v[i].x * rs * gg.x * (1.f + c4.x) + s4.x, o1 = v[i].y * rs * gg.y * (1.f + c4.y) + s4.y;
                float o2 = v[i].z * rs * gg.z * (1.f + c4.z) + s4.z, o3 = v[i].w * rs * gg.w * (1.f + c4.w) + s4.w;
                uint2 w; w.x = pack2(o0, o1); w.y = pack2(o2, o3);
                *(uint2*)(H + (size_t)r * 1024 + c) = w;
            }
        }
    }
}

__device__ __forceinline__ void phase_norm2(const Args& a, int l, unsigned char* lds) {
    const int lane = threadIdx.x & 63, wv = threadIdx.x >> 6;
    const int gw = blockIdx.x * 8 + wv, nw = gridDim.x * 8;
    const int nrows = (l == 0) ? NROW : NLAT;
    const int per = (nrows + nw - 1) / nw;
    float* s_log = (float*)lds + wv * 64;
    int* s_pe = (int*)(lds + 2048) + wv * 64;
    float* s_pw = (float*)(lds + 4096) + wv * 64;
    int* s_pr = (int*)(lds + 6144) + wv * 64;
    const float* mods = (const float*)(a.ws + WS_MODS) + (size_t)l * 9 * 6144;
    const float* g = a.in[5] + (size_t)l * 1024;
    const float* wrt = (const float*)(a.ws + WS_WRT);
    const float* bg = a.in[40] + l * 4; const float* be = a.in[42] + l * 32;
    bf16_t* H = (bf16_t*)(a.ws + WS_H);
    const float* XC = (const float*)(a.ws + WS_XC);
    int npick = 0;
    const int r0 = gw * per, r1 = min(nrows, r0 + per);
    for (int r = r0; r < r1; ++r) {
        const bool lat = r < NLAT; const int b = lat ? (r >> 12) : 8;
        const float* xr = lat ? a.out + (size_t)r * 1024 : XC + (size_t)(r - NLAT) * 1024;
        float4 v[4]; float ss = 0.f;
#pragma unroll
        for (int i = 0; i < 4; ++i) { v[i] = ((const float4*)xr)[lane + 64 * i]; ss += v[i].x * v[i].x + v[i].y * v[i].y + v[i].z * v[i].z + v[i].w * v[i].w; }
        ss = wave_sum(ss);
        const float rs = rsqrtf(ss * (1.0f / 1024.0f) + 1e-6f);
        const float* sh = mods + (size_t)b * 6144 + 3 * 1024; const float* sc = mods + (size_t)b * 6144 + 4 * 1024;
#pragma unroll
        for (int i = 0; i < 4; ++i) {
            int c = (lane + 64 * i) * 4;
            float4 gg = *(const float4*)(g + c), s4 = *(const float4*)(sh + c), c4 = *(const float4*)(sc + c);
            v[i].x = v[i].x * rs * gg.x * (1.f + c4.x) + s4.x; v[i].y = v[i].y * rs * gg.y * (1.f + c4.y) + s4.y;
            v[i].z = v[i].z * rs * gg.z * (1.f + c4.z) + s4.z; v[i].w = v[i].w * rs * gg.w * (1.f + c4.w) + s4.w;
            uint2 w; w.x = pack2(v[i].x, v[i].y); w.y = pack2(v[i].z, v[i].w);
            *(uint2*)(H + (size_t)r * 1024 + c) = w;
        }
        float mylog = 0.f;
        for (int o = 0; o < 36; ++o) {
            const float* wr = wrt + (size_t)o * 1024; float p = 0.f;
#pragma unroll
            for (int i = 0; i < 4; ++i) { float4 w4 = *(const float4*)(wr + (lane + 64 * i) * 4); p += v[i].x * w4.x + v[i].y * w4.y + v[i].z * w4.z + v[i].w * w4.w; }
            p = wave_sum(p);
            if (lane == o) mylog = p;
        }
        if (lane < 4) mylog += bg[lane]; else if (lane < 36) mylog += be[lane - 4];
        s_log[lane] = mylog;
        __builtin_amdgcn_wave_barrier();
        if (lane == 0) {
            float g0 = s_log[0]; int gs = 0;
            for (int i = 1; i < 4; ++i) if (s_log[i] > g0) { g0 = s_log[i]; gs = i; }
            float den = 0.f; for (int i = 0; i < 4; ++i) den += __expf(s_log[i] - g0);
            float gwgt = 1.0f / den;
            const float* el = s_log + 4 + gs * 8;
            int i0 = 0; float v0 = el[0];
            for (int i = 1; i < 8; ++i) if (el[i] > v0) { v0 = el[i]; i0 = i; }
            int i1 = -1; float v1 = -3.0e38f;
            for (int i = 0; i < 8; ++i) if (i != i0 && el[i] > v1) { v1 = el[i]; i1 = i; }
            float e1 = __expf(v1 - v0); float w0 = gwgt / (1.f + e1), w1 = gwgt * e1 / (1.f + e1);
            s_pe[npick] = gs * 8 + i0; s_pw[npick] = w0; s_pr[npick] = r;
            s_pe[npick + 1] = gs * 8 + i1; s_pw[npick + 1] = w1; s_pr[npick + 1] = r;
        }
        npick += 2;
        __builtin_amdgcn_wave_barrier();
    }
    unsigned* cnt = (unsigned*)(a.ws + WS_CNT) + l * 64;
    int* stok = (int*)(a.ws + WS_STOK);
    unsigned* tinfo = (unsigned*)(a.ws + WS_TINFO);
    for (int i = lane; i < npick; i += 64) {
        int e = s_pe[i]; int r = s_pr[i];
        unsigned p = atomicAdd(&cnt[e], 1u);
        stok[(size_t)e * MOE_CAP + p] = r;
        tinfo[(size_t)r * 4 + (i & 1) * 2 + 0] = ((unsigned)e << 24) | p;
        tinfo[(size_t)r * 4 + (i & 1) * 2 + 1] = __float_as_uint(s_pw[i]);
    }
}

constexpr int G_ASZ = 256 * 64;
template <int NT> struct GemmCfg { static constexpr int BN = 32 * NT, BSZ = BN * 64, STAGE = G_ASZ + BSZ; };

template <int NT>
__device__ __forceinline__ void gemm_loop(f32x4 (&acc)[4][NT], const bf16_t* arow0, const bf16_t* arow1, const bf16_t* brow, int K, unsigned char* lds) {
    constexpr int STAGE = GemmCfg<NT>::STAGE;
    const int tid = threadIdx.x, lane = tid & 63, wid = tid >> 6, wr = wid >> 1, wc = wid & 1, fr = lane & 15, fq = lane >> 4;
    const int nt = K / 32;
    auto stage = [&](int t, int buf) {
        unsigned char* base = lds + buf * STAGE;
        __builtin_amdgcn_global_load_lds((const unsigned*)(arow0 + t * 32), LDSP(base + tid * 16), 16, 0, 0);
        __builtin_amdgcn_global_load_lds((const unsigned*)(arow1 + t * 32), LDSP(base + 8192 + tid * 16), 16, 0, 0);
        if (NT == 4 || tid < 256)
            __builtin_amdgcn_global_load_lds((const unsigned*)(brow + t * 32), LDSP(base + G_ASZ + tid * 16), 16, 0, 0);
    };
    stage(0, 0);
    for (int t = 0; t < nt; ++t) {
        asm volatile("s_waitcnt vmcnt(0)" ::: "memory");
        __syncthreads();
        if (t + 1 < nt) stage(t + 1, (t + 1) & 1);
        const unsigned char* base = lds + (t & 1) * STAGE;
        bf16x8 af[4], bfr[NT];
#pragma unroll
        for (int m = 0; m < 4; ++m) af[m] = *(const bf16x8*)(base + (wr * 64 + m * 16 + fr) * 64 + fq * 16);
#pragma unroll
        for (int n = 0; n < NT; ++n) bfr[n] = *(const bf16x8*)(base + G_ASZ + (wc * 16 * NT + n * 16 + fr) * 64 + fq * 16);
#pragma unroll
        for (int m = 0; m < 4; ++m)
#pragma unroll
            for (int n = 0; n < NT; ++n) acc[m][n] = __builtin_amdgcn_mfma_f32_16x16x32_bf16(bfr[n], af[m], acc[m][n], 0, 0, 0);
    }
    __syncthreads();
}

__device__ __forceinline__ void phase_moe1(const Args& a, int l, unsigned char* lds) {
    int* s_start = (int*)(lds + 2 * GemmCfg<4>::STAGE); int* s_cnt = s_start + 64; int* s_tile = s_cnt + 64;
    moe_offsets(a, l, s_start, s_cnt);
    if (threadIdx.x == 0) { int s = 0; for (int e = 0; e < 32; ++e) { s_tile[e] = s; s += (s_cnt[e] + 255) >> 8; } s_tile[32] = s; }
    __syncthreads();
    const int ntiles = s_tile[32];
    const int tid = threadIdx.x, lane = tid & 63, wid = tid >> 6, wr = wid >> 1, wc = wid & 1, fr = lane & 15, fq = lane >> 4;
    const bf16_t* H = (const bf16_t*)(a.ws + WS_H);
    const bf16_t* WG = (const bf16_t*)(a.ws + WS_BIG + BIG_WEG); const bf16_t* WU = (const bf16_t*)(a.ws + WS_BIG + BIG_WEU);
    bf16_t* HID = (bf16_t*)(a.ws + WS_BIG + BIG_HID);
    const int* stok = (const int*)(a.ws + WS_STOK);
    for (int w = blockIdx.x; w < ntiles * 8; w += gridDim.x) {
        const int rt_g = w >> 3, ntile = w & 7;
        int e = 0; while (s_tile[e + 1] <= rt_g) ++e;
        const int rt = rt_g - s_tile[e], cnt = s_cnt[e], n0 = ntile * 64;
        const int ar0 = tid >> 2, ar1 = 128 + (tid >> 2), kc = (tid & 3) * 8;
        int p0 = rt * 256 + ar0, p1 = rt * 256 + ar1; if (p0 >= cnt) p0 = 0; if (p1 >= cnt) p1 = 0;
        const bf16_t* arow0 = H + (size_t)stok[(size_t)e * MOE_CAP + p0] * 1024 + kc;
        const bf16_t* arow1 = H + (size_t)stok[(size_t)e * MOE_CAP + p1] * 1024 + kc;
        const int rho = tid >> 2;
        const bf16_t* brow = ((rho & 63) < 32 ? WG : WU) + ((size_t)e * EH + n0 + (rho >> 6) * 32 + (rho & 31)) * 1024 + kc;
        f32x4 acc[4][4];
#pragma unroll
        for (int m = 0; m < 4; ++m)
#pragma unroll
            for (int n = 0; n < 4; ++n) acc[m][n] = (f32x4){0.f, 0.f, 0.f, 0.f};
        gemm_loop<4>(acc, arow0, arow1, brow, 1024, lds);
#pragma unroll
        for (int m = 0; m < 4; ++m) {
            const int p = rt * 256 + wr * 64 + m * 16 + fr;
            if (p < cnt) {
                bf16_t* orow = HID + (size_t)(s_start[e] + p) * EH + n0 + wc * 32 + fq * 4;
#pragma unroll
                for (int n = 0; n < 2; ++n) {
                    f32x4 gt = acc[m][n], up = acc[m][n + 2];
                    uint2 o; o.x = pack2(siluf(gt[0]) * up[0], siluf(gt[1]) * up[1]); o.y = pack2(siluf(gt[2]) * up[2], siluf(gt[3]) * up[3]);
                    *(uint2*)(orow + n * 16) = o;
                }
            }
        }
    }
}

__device__ __forceinline__ void phase_moe2(const Args& a, int l, unsigned char* lds) {
    int* s_start = (int*)(lds + 2 * GemmCfg<4>::STAGE); int* s_cnt = s_start + 64; int* s_tile = s_cnt + 64;
    moe_offsets(a, l, s_start, s_cnt);
    if (threadIdx.x == 0) { int s = 0; for (int e = 0; e < 32; ++e) { s_tile[e] = s; s += (s_cnt[e] + 255) >> 8; } s_tile[32] = s; }
    __syncthreads();
    const int ntiles = s_tile[32];
    const int tid = threadIdx.x, lane = tid & 63, wid = tid >> 6, wr = wid >> 1, wc = wid & 1, fr = lane & 15, fq = lane >> 4;
    const bf16_t* HID = (const bf16_t*)(a.ws + WS_BIG + BIG_HID);
    const bf16_t* WD = (const bf16_t*)(a.ws + WS_BIG + BIG_WED);
    bf16_t* YD = (bf16_t*)(a.ws + WS_BIG + BIG_YD);
    for (int w = blockIdx.x; w < ntiles * 8; w += gridDim.x) {
        const int rt_g = w >> 3, ntile = w & 7;
        int e = 0; while (s_tile[e + 1] <= rt_g) ++e;
        const int rt = rt_g - s_tile[e], cnt = s_cnt[e], n0 = ntile * 128;
        const int ar0 = tid >> 2, ar1 = 128 + (tid >> 2), kc = (tid & 3) * 8;
        int p0 = rt * 256 + ar0, p1 = rt * 256 + ar1; if (p0 >= cnt) p0 = 0; if (p1 >= cnt) p1 = 0;
        const bf16_t* arow0 = HID + (size_t)(s_start[e] + p0) * EH + kc;
        const bf16_t* arow1 = HID + (size_t)(s_start[e] + p1) * EH + kc;
        const bf16_t* brow = WD + ((size_t)e * 1024 + n0 + (tid >> 2)) * EH + kc;
        f32x4 acc[4][4];
#pragma unroll
        for (int m = 0; m < 4; ++m)
#pragma unroll
            for (int n = 0; n < 4; ++n) acc[m][n] = (f32x4){0.f, 0.f, 0.f, 0.f};
        gemm_loop<4>(acc, arow0, arow1, brow, EH, lds);
#pragma unroll
        for (int m = 0; m < 4; ++m) {
            const int p = rt * 256 + wr * 64 + m * 16 + fr;
            if (p < cnt) {
                bf16_t* orow = YD + (size_t)(s_start[e] + p) * 1024 + n0 + wc * 64 + fq * 4;
#pragma unroll
                for (int n = 0; n < 4; ++n) {
                    uint2 o; o.x = pack2(acc[m][n][0], acc[m][n][1]); o.y = pack2(acc[m][n][2], acc[m][n][3]);
                    *(uint2*)(orow + n * 16) = o;
                }
            }
        }
    }
}

__device__ __forceinline__ void phase_s5params(const Args& a, int l) {
    float2* abar = (float2*)(a.ws + WS_S5P);
    float2* bbar = abar + 2 * 16 * 64;
    for (int i = blockIdx.x * NTHREADS + threadIdx.x; i < 2 * 16 * 64 * 16; i += gridDim.x * NTHREADS) {
        const int c = i & 15, p = (i >> 4) & 63, g = (i >> 10) & 15, d = i >> 14;
        const float lre = a.in[27][((l * 2 + d) * 16 + g) * 64 + p], lim = a.in[28][((l * 2 + d) * 16 + g) * 64 + p];
        const float dt = __expf(a.in[29][(l * 2 + d) * 16 + g]);
        const float mag = __expf(lre * dt); float sn, cs; sincosf(lim * dt, &sn, &cs);
        const float are = mag * cs, aim = mag * sn;
        if (c == 0) abar[(d * 16 + g) * 64 + p] = make_float2(are, aim);
        const float nre = are - 1.f, nim = aim, den = lre * lre + lim * lim;
        const float qre = (nre * lre + nim * lim) / den, qim = (nim * lre - nre * lim) / den;
        const float bre = a.in[30][((l * 16 + g) * 64 + p) * 16 + c], bim = a.in[31][((l * 16 + g) * 64 + p) * 16 + c];
        bbar[i] = make_float2(qre * bre - qim * bim, qre * bim + qim * bre);
    }
}

__device__ __forceinline__ void phase_g1(const Args& a, unsigned char* lds) {
    const int tid = threadIdx.x, lane = tid & 63, wid = tid >> 6, wr = wid >> 1, wc = wid & 1, fr = lane & 15, fq = lane >> 4;
    const bf16_t* H = (const bf16_t*)(a.ws + WS_H); const bf16_t* W = (const bf16_t*)(a.ws + WS_WIN);
    bf16_t* U = (bf16_t*)(a.ws + WS_BIG + BIG_U);
    const int kc = (tid & 3) * 8;
    for (int w = blockIdx.x; w < (NROW / 256) * 21; w += gridDim.x) {
        const int mt = w / 21, ntl = w % 21, r0 = mt * 256, n0 = ntl * 128;
        f32x4 acc[4][4];
#pragma unroll
        for (int m = 0; m < 4; ++m)
#pragma unroll
            for (int n = 0; n < 4; ++n) acc[m][n] = (f32x4){0.f, 0.f, 0.f, 0.f};
        gemm_loop<4>(acc, H + (size_t)(r0 + (tid >> 2)) * 1024 + kc, H + (size_t)(r0 + 128 + (tid >> 2)) * 1024 + kc, W + (size_t)(n0 + (tid >> 2)) * 1024 + kc, 1024, lds);
#pragma unroll
        for (int m = 0; m < 4; ++m) {
            const int row = r0 + wr * 64 + m * 16 + fr;
#pragma unroll
            for (int n = 0; n < 4; ++n) {
                const int col = n0 + wc * 64 + n * 16 + fq * 4;
                if (col < UW) { uint2 o; o.x = pack2(acc[m][n][0], acc[m][n][1]); o.y = pack2(acc[m][n][2], acc[m][n][3]); *(uint2*)(U + (size_t)row * UW + col) = o; }
            }
        }
    }
}

__device__ __forceinline__ void phase_merge(const Args& a, int l, unsigned char* lds) {
    const int tid = threadIdx.x, lane = tid & 63, wid = tid >> 6, wr = wid >> 1, wc = wid & 1, fr = lane & 15, fq = lane >> 4;
    const bf16_t* H = (const bf16_t*)(a.ws + WS_H); const bf16_t* W = (const bf16_t*)(a.ws + WS_WIN);
    const bf16_t* Y = (const bf16_t*)(a.ws + WS_BIG + BIG_Y); const bf16_t* WB = (const bf16_t*)(a.ws + WS_WBR);
    bf16_t* MG = (bf16_t*)(a.ws + WS_BIG + BIG_MRG);
    const int nrows = (l == 0) ? NROW : NLAT;
    const int kc = (tid & 3) * 8;
    for (int w = blockIdx.x; w < (nrows / 256) * 16; w += gridDim.x) {
        const int mt = w >> 4, ntl = w & 15, r0 = mt * 256, n0 = ntl * 64;
        f32x4 accm[4][2];
#pragma unroll
        for (int m = 0; m < 4; ++m)
#pragma unroll
            for (int n = 0; n < 2; ++n) accm[m][n] = (f32x4){0.f, 0.f, 0.f, 0.f};
#pragma unroll 1
        for (int i = 0; i < 4; ++i) {
            f32x4 ag[4][2], ap[4][2];
#pragma unroll
            for (int m = 0; m < 4; ++m)
#pragma unroll
                for (int n = 0; n < 2; ++n) { ag[m][n] = (f32x4){0.f, 0.f, 0.f, 0.f}; ap[m][n] = (f32x4){0.f, 0.f, 0.f, 0.f}; }
            gemm_loop<2>(ag, H + (size_t)(r0 + (tid >> 2)) * 1024 + kc, H + (size_t)(r0 + 128 + (tid >> 2)) * 1024 + kc,
                         W + (size_t)(UW + i * 1024 + n0 + ((tid >> 2) & 63)) * 1024 + kc, 1024, lds);
            gemm_loop<2>(ap, Y + (size_t)(r0 + (tid >> 2)) * 1024 + 256 * i + kc, Y + (size_t)(r0 + 128 + (tid >> 2)) * 1024 + 256 * i + kc,
                         WB + (size_t)(i * 1024 + n0 + ((tid >> 2) & 63)) * 256 + kc, 256, lds);
#pragma unroll
            for (int m = 0; m < 4; ++m)
#pragma unroll
                for (int n = 0; n < 2; ++n)
#pragma unroll
                    for (int j = 0; j < 4; ++j) accm[m][n][j] += sigmf(ag[m][n][j]) * ap[m][n][j];
        }
#pragma unroll
        for (int m = 0; m < 4; ++m) {
            const int row = r0 + wr * 64 + m * 16 + fr;
#pragma unroll
            for (int n = 0; n < 2; ++n) {
                const int col = n0 + wc * 32 + n * 16 + fq * 4;
                uint2 o; o.x = pack2(accm[m][n][0], accm[m][n][1]); o.y = pack2(accm[m][n][2], accm[m][n][3]);
                *(uint2*)(MG + (size_t)row * 1024 + col) = o;
            }
        }
    }
}

__device__ __forceinline__ void phase_g3(const Args& a, int l, unsigned char* lds) {
    const int tid = threadIdx.x, lane = tid & 63, wid = tid >> 6, wr = wid >> 1, wc = wid & 1, fr = lane & 15, fq = lane >> 4;
    const bf16_t* MG = (const bf16_t*)(a.ws + WS_BIG + BIG_MRG); const bf16_t* W = (const bf16_t*)(a.ws + WS_WOUT);
    const float* mods = (const float*)(a.ws + WS_MODS) + (size_t)l * 9 * 6144;
    float* XC = (float*)(a.ws + WS_XC);
    const int nrows = (l == 0) ? NROW : NLAT;
    const int kc = (tid & 3) * 8;
    for (int w = blockIdx.x; w < (nrows / 256) * 8; w += gridDim.x) {
        const int mt = w >> 3, ntl = w & 7, r0 = mt * 256, n0 = ntl * 128;
        f32x4 acc[4][4];
#pragma unroll
        for (int m = 0; m < 4; ++m)
#pragma unroll
            for (int n = 0; n < 4; ++n) acc[m][n] = (f32x4){0.f, 0.f, 0.f, 0.f};
        gemm_loop<4>(acc, MG + (size_t)(r0 + (tid >> 2)) * 1024 + kc, MG + (size_t)(r0 + 128 + (tid >> 2)) * 1024 + kc, W + (size_t)(n0 + (tid >> 2)) * 1024 + kc, 1024, lds);
#pragma unroll
        for (int m = 0; m < 4; ++m) {
            const int row = r0 + wr * 64 + m * 16 + fr;
            const bool lat = row < NLAT; const int b = lat ? (row >> 12) : 8;
            const float* xo = lat ? ((l == 0) ? a.in[0] + (size_t)row * 1024 : a.out + (size_t)row * 1024) : a.in[2] + (size_t)(row - NLAT) * 1024;
            float* xn = lat ? a.out + (size_t)row * 1024 : XC + (size_t)(row - NLAT) * 1024;
            const float* m2 = mods + (size_t)b * 6144 + 2 * 1024;
#pragma unroll
            for (int n = 0; n < 4; ++n) {
                const int col = n0 + wc * 64 + n * 16 + fq * 4;
                float4 xv = *(const float4*)(xo + col), mv = *(const float4*)(m2 + col);
                xv.x += mv.x * acc[m][n][0]; xv.y += mv.y * acc[m][n][1]; xv.z += mv.z * acc[m][n][2]; xv.w += mv.w * acc[m][n][3];
                *(float4*)(xn + col) = xv;
            }
        }
    }
}

__device__ __forceinline__ void ld4bf(const bf16_t* p, float (&o)[4]) { uint2 q = *(const uint2*)p; o[0] = bf2f((bf16_t)(q.x & 0xFFFF)); o[1] = bf2f((bf16_t)(q.x >> 16)); o[2] = bf2f((bf16_t)(q.y & 0xFFFF)); o[3] = bf2f((bf16_t)(q.y >> 16)); }
__device__ __forceinline__ void st4bf(bf16_t* p, float a0, float a1, float a2, float a3) { uint2 q; q.x = pack2(a0, a1); q.y = pack2(a2, a3); *(uint2*)p = q; }

__device__ __forceinline__ void phase_prep(const Args& a, int l, unsigned char* lds) {
    const int lane = threadIdx.x & 63, wv = threadIdx.x >> 6;
    const int gw = blockIdx.x * 8 + wv, nw = gridDim.x * 8;
    bf16_t* U = (bf16_t*)(a.ws + WS_BIG + BIG_U);
    bf16_t* MIX = (bf16_t*)(a.ws + WS_BIG + T_MIX); bf16_t* EXT = (bf16_t*)(a.ws + WS_BIG + T_EXT);
    float* xa_s = (float*)lds + wv * 512;
    float* t1_s = xa_s + 256;
    const float* mu = a.in[10] + (size_t)l * 1024;
    const float* w0 = a.in[11] + (size_t)l * 512; const float* w1 = a.in[12] + (size_t)l * 2 * 256 * 32; const float* w2 = a.in[13] + (size_t)l * 2 * 32 * 256;
    const float* a0 = a.in[14] + (size_t)l * 512; const float* a1 = a.in[15] + (size_t)l * 2 * 256 * 32; const float* a2 = a.in[16] + (size_t)l * 2 * 32 * 256;
    const float* kkp = a.in[17] + (size_t)l * 256;
    const float* g1 = a.in[20] + (size_t)l * 256 * 64; const float* g2 = a.in[21] + (size_t)l * 64 * 256;
    for (int r = gw; r < NROW; r += nw) {
        const bool lat = r < NLAT;
        {
            bf16_t* ua = U + (size_t)r * UW + U_ATT;
            if (lat) {
                const int t = r & 4095; const float prow = (float)(t >> 6), pcol = (float)(t & 63);
#pragma unroll
                for (int j = 0; j < 3; ++j) {
                    const int idx = lane + 64 * j, hd = idx >> 5, i = idx & 31;
                    const float inv = __expf(-(float)(i & 15) * (9.210340371976184f / 16.0f));
                    const float ang = ((i < 16) ? prow : pcol) * inv; float sn, cs; sincosf(ang, &sn, &cs);
                    const float x1 = bf2f(ua[hd * 64 + i]), x2 = bf2f(ua[hd * 64 + i + 32]);
                    const float sc = (hd < 4) ? 0.125f : 1.0f;
                    ua[hd * 64 + i] = f2bf((x1 * cs - x2 * sn) * sc); ua[hd * 64 + i + 32] = f2bf((x1 * sn + x2 * cs) * sc);
                }
            } else {
                float q[4]; ld4bf(ua + lane * 4, q); st4bf(ua + lane * 4, q[0] * 0.125f, q[1] * 0.125f, q[2] * 0.125f, q[3] * 0.125f);
            }
        }
        bool hp, hn;
        if (lat) { const int t = r & 4095; hp = t > 0; hn = t < 4095; } else { const int s = (r - NLAT) & 255; hp = s > 0; hn = s < 255; }
        float mx[4][4];
#pragma unroll
        for (int sec = 0; sec < 4; ++sec) {
            const int c = sec * 256 + lane * 4; float u0[4], up[4] = {0.f, 0.f, 0.f, 0.f}, un[4] = {0.f, 0.f, 0.f, 0.f};
            ld4bf(U + (size_t)r * UW + c, u0);
            if (hp) ld4bf(U + (size_t)(r - 1) * UW + c, up);
            if (hn) ld4bf(U + (size_t)(r + 1) * UW + c, un);
            const float4 m4 = *(const float4*)(mu + c);
            mx[sec][0] = u0[0] + (0.5f * (up[0] + un[0]) - u0[0]) * m4.x; mx[sec][1] = u0[1] + (0.5f * (up[1] + un[1]) - u0[1]) * m4.y;
            mx[sec][2] = u0[2] + (0.5f * (up[2] + un[2]) - u0[2]) * m4.z; mx[sec][3] = u0[3] + (0.5f * (up[3] + un[3]) - u0[3]) * m4.w;
        }
        float kkv[4];
        {
            const float4 kp = *(const float4*)(kkp + lane * 4);
            kkv[0] = mx[1][0] * kp.x; kkv[1] = mx[1][1] * kp.y; kkv[2] = mx[1][2] * kp.z; kkv[3] = mx[1][3] * kp.w;
            float ss = kkv[0] * kkv[0] + kkv[1] * kkv[1] + kkv[2] * kkv[2] + kkv[3] * kkv[3];
            ss += __shfl_xor(ss, 1); ss += __shfl_xor(ss, 2); ss += __shfl_xor(ss, 4); ss += __shfl_xor(ss, 8);
            const float rn = rsqrtf(ss + 1e-6f);
            kkv[0] *= rn; kkv[1] *= rn; kkv[2] *= rn; kkv[3] *= rn;
        }
        *(float4*)(xa_s + lane * 4) = make_float4(mx[3][0], mx[3][1], mx[3][2], mx[3][3]);
        __builtin_amdgcn_wave_barrier();
        {
            const int dsel = lane >> 5, jj = lane & 31;
            const float* pw = w1 + (size_t)dsel * 256 * 32 + jj; const float* pa = a1 + (size_t)dsel * 256 * 32 + jj; const float* pg = g1 + lane;
            float s0 = 0.f, s1 = 0.f, s2 = 0.f;
#pragma unroll 4
            for (int k = 0; k < 256; ++k) { const float x = xa_s[k]; s0 += x * pw[k * 32]; s1 += x * pa[k * 32]; s2 += x * pg[k * 64]; }
            t1_s[lane] = tanhf(s0); t1_s[64 + lane] = s1; t1_s[128 + lane] = sigmf(s2);
        }
        __builtin_amdgcn_wave_barrier();
        float lw[2][4], ic[2][4], gg[4];
#pragma unroll
        for (int d = 0; d < 2; ++d) {
            float4 zw = *(const float4*)(w0 + d * 256 + lane * 4), za = *(const float4*)(a0 + d * 256 + lane * 4);
#pragma unroll 4
            for (int j = 0; j < 32; ++j) {
                const float tw = t1_s[d * 32 + j], ta = t1_s[64 + d * 32 + j];
                const float4 ww = *(const float4*)(w2 + ((size_t)d * 32 + j) * 256 + lane * 4), aa = *(const float4*)(a2 + ((size_t)d * 32 + j) * 256 + lane * 4);
                zw.x += tw * ww.x; zw.y += tw * ww.y; zw.z += tw * ww.z; zw.w += tw * ww.w;
                za.x += ta * aa.x; za.y += ta * aa.y; za.z += ta * aa.z; za.w += ta * aa.w;
            }
            lw[d][0] = -sigmf(zw.x) * 0.6065306597f; lw[d][1] = -sigmf(zw.y) * 0.6065306597f; lw[d][2] = -sigmf(zw.z) * 0.6065306597f; lw[d][3] = -sigmf(zw.w) * 0.6065306597f;
            ic[d][0] = sigmf(za.x); ic[d][1] = sigmf(za.y); ic[d][2] = sigmf(za.z); ic[d][3] = sigmf(za.w);
        }
        {
            float4 zg = make_float4(0.f, 0.f, 0.f, 0.f);
#pragma unroll 4
            for (int j = 0; j < 64; ++j) { const float tg = t1_s[128 + j]; const float4 w4 = *(const float4*)(g2 + (size_t)j * 256 + lane * 4); zg.x += tg * w4.x; zg.y += tg * w4.y; zg.z += tg * w4.z; zg.w += tg * w4.w; }
            gg[0] = zg.x; gg[1] = zg.y; gg[2] = zg.z; gg[3] = zg.w;
        }
        bf16_t* mr = MIX + (size_t)r * 768 + lane * 4; bf16_t* er = EXT + (size_t)r * 1536 + lane * 4;
        st4bf(mr, mx[0][0], mx[0][1], mx[0][2], mx[0][3]); st4bf(mr + 256, mx[1][0], mx[1][1], mx[1][2], mx[1][3]); st4bf(mr + 512, mx[2][0], mx[2][1], mx[2][2], mx[2][3]);
        st4bf(er, kkv[0], kkv[1], kkv[2], kkv[3]);
        st4bf(er + 256, lw[0][0], lw[0][1], lw[0][2], lw[0][3]); st4bf(er + 512, lw[1][0], lw[1][1], lw[1][2], lw[1][3]);
        st4bf(er + 768, ic[0][0], ic[0][1], ic[0][2], ic[0][3]); st4bf(er + 1024, ic[1][0], ic[1][1], ic[1][2], ic[1][3]);
        st4bf(er + 1280, gg[0], gg[1], gg[2], gg[3]);
        __builtin_amdgcn_wave_barrier();
    }
}

__device__ __forceinline__ int seq_row(int b, int d, int pos) {
    if (pos < 256) { const int s = d ? 255 - pos : pos; return NLAT + b * 256 + s; }
    int t = pos - 256; if (d) t = 4095 - t; return b * 4096 + t;
}

__device__ __forceinline__ void scan_rwkv(const Args& a, int l, int chain, unsigned char* ldsw  ) {
    const int lane = threadIdx.x & 63;
    const int b = chain >> 3, h = (chain >> 1) & 3, d = chain & 1;
    const bf16_t* MIX = (const bf16_t*)(a.ws + WS_BIG + T_MIX); const bf16_t* EXT = (const bf16_t*)(a.ws + WS_BIG + T_EXT);
    bf16_t* YO = (bf16_t*)(a.ws + WS_BIG + T_YRW) + (size_t)d * NROW * 256;
    const float ka = a.in[18][(size_t)l * 256 + h * 64 + lane];
    float* st = (float*)ldsw;
    float s[64];
#pragma unroll
    for (int k = 0; k < 64; ++k) s[k] = 0.f;
    for (int blk = 0; blk < 4352 / 8; ++blk) {
#pragma unroll 2
        for (int j = 0; j < 8; ++j) {
            const int row = seq_row(b, d, blk * 8 + j);
            const bf16_t* er = EXT + (size_t)row * 1536 + h * 64 + lane; const bf16_t* mr = MIX + (size_t)row * 768 + h * 64 + lane;
            const float kkv = bf2f(er[0]), lwv = bf2f(er[256 + d * 256]), icv = bf2f(er[768 + d * 256]);
            const float rr = bf2f(mr[0]), kx = bf2f(mr[256]), vv = bf2f(mr[512]);
            float* sj = st + j * 384;
            sj[lane] = __expf(lwv); sj[64 + lane] = kx * (1.f + (icv - 1.f) * ka); sj[128 + lane] = -kkv; sj[192 + lane] = kkv * icv; sj[256 + lane] = rr; sj[320 + lane] = vv;
        }
        __builtin_amdgcn_wave_barrier();
#pragma unroll 1
        for (int j = 0; j < 8; ++j) {
            const float* sj = st + j * 384;
            const float v = sj[320 + lane];
            float sa = 0.f;
#pragma unroll
            for (int k4 = 0; k4 < 16; ++k4) { if ((k4 & 3) == 0) asm volatile("" : "+v"(sa) :: "memory"); const float4 a4 = *(const float4*)(sj + 128 + k4 * 4); sa += s[k4 * 4] * a4.x + s[k4 * 4 + 1] * a4.y + s[k4 * 4 + 2] * a4.z + s[k4 * 4 + 3] * a4.w; }
            float y = 0.f;
#pragma unroll
            for (int k4 = 0; k4 < 16; ++k4) {
                if ((k4 & 1) == 0) asm volatile("" : "+v"(y) :: "memory");
                const float4 w4 = *(const float4*)(sj + k4 * 4), e4 = *(const float4*)(sj + 64 + k4 * 4), b4 = *(const float4*)(sj + 192 + k4 * 4), r4 = *(const float4*)(sj + 256 + k4 * 4);
                s[k4 * 4] = s[k4 * 4] * w4.x + sa * b4.x + v * e4.x; y += s[k4 * 4] * r4.x;
                s[k4 * 4 + 1] = s[k4 * 4 + 1] * w4.y + sa * b4.y + v * e4.y; y += s[k4 * 4 + 1] * r4.y;
                s[k4 * 4 + 2] = s[k4 * 4 + 2] * w4.z + sa * b4.z + v * e4.z; y += s[k4 * 4 + 2] * r4.z;
                s[k4 * 4 + 3] = s[k4 * 4 + 3] * w4.w + sa * b4.w + v * e4.w; y += s[k4 * 4 + 3] * r4.w;
            }
            const int row = seq_row(b, d, blk * 8 + j);
            YO[(size_t)row * 256 + h * 64 + lane] = f2bf(y);
        }
        __builtin_amdgcn_wave_barrier();
    }
}

__device__ __forceinline__ void scan_gla(const Args& a, int l, int chain, unsigned char* ldsw  ) {
    const int lane = threadIdx.x & 63;
    const int b = chain >> 3, h = (chain >> 1) & 3, d = chain & 1;
    const bf16_t* U = (const bf16_t*)(a.ws + WS_BIG + BIG_U);
    bf16_t* YO = (bf16_t*)(a.ws + WS_BIG + T_YGL) + (size_t)d * NROW * 256;
    const float* A2 = a.in[23] + ((size_t)l * 2 + d) * 16 * 128; const float* AB = a.in[24] + ((size_t)l * 2 + d) * 128;
    float* sa_ = (float*)ldsw;
    float* sk_ = sa_ + 512;
    float* sq_ = sk_ + 512;
    float* sv_ = sq_ + 512;
    float s[32];
#pragma unroll
    for (int k = 0; k < 32; ++k) s[k] = 0.f;
    float a2c[16];
#pragma unroll
    for (int m = 0; m < 16; ++m) a2c[m] = A2[m * 128 + h * 32 + (lane & 31)];
    const float abk = AB[h * 32 + (lane & 31)];
    for (int blk = 0; blk < 4352 / 16; ++blk) {
#pragma unroll 1
        for (int i = 0; i < 8; ++i) {
            const int j = i * 2 + (lane >> 5), k = lane & 31;
            const int row = seq_row(b, d, blk * 16 + j);
            const bf16_t* ug = U + (size_t)row * UW + U_GLA;
            float x = abk;
#pragma unroll
            for (int m = 0; m < 16; ++m) x += bf2f(ug[768 + d * 16 + m]) * a2c[m];
            const float ls = fminf(x, 0.f) - log1pf(__expf(-fabsf(x)));
            sa_[j * 32 + k] = __expf(ls * (1.0f / 16.0f));
            sk_[j * 32 + k] = bf2f(ug[128 + h * 32 + k]);
            sq_[j * 32 + k] = bf2f(ug[h * 32 + k]) * 0.17677669529663687f;
        }
#pragma unroll 4
        for (int j = 0; j < 16; ++j) { const int row = seq_row(b, d, blk * 16 + j); sv_[j * 64 + lane] = bf2f(U[(size_t)row * UW + U_GLA + 256 + h * 64 + lane]); }
        __builtin_amdgcn_wave_barrier();
#pragma unroll 1
        for (int j = 0; j < 16; ++j) {
            const float v = sv_[j * 64 + lane]; float o = 0.f;
#pragma unroll
            for (int k4 = 0; k4 < 8; ++k4) {
                const float4 a4 = *(const float4*)(sa_ + j * 32 + k4 * 4), x4 = *(const float4*)(sk_ + j * 32 + k4 * 4), q4 = *(const float4*)(sq_ + j * 32 + k4 * 4);
                s[k4 * 4] = a4.x * s[k4 * 4] + x4.x * v; o += q4.x * s[k4 * 4];
                s[k4 * 4 + 1] = a4.y * s[k4 * 4 + 1] + x4.y * v; o += q4.y * s[k4 * 4 + 1];
                s[k4 * 4 + 2] = a4.z * s[k4 * 4 + 2] + x4.z * v; o += q4.z * s[k4 * 4 + 2];
                s[k4 * 4 + 3] = a4.w * s[k4 * 4 + 3] + x4.w * v; o += q4.w * s[k4 * 4 + 3];
            }
            const int row = seq_row(b, d, blk * 16 + j);
            YO[(size_t)row * 256 + h * 64 + lane] = f2bf(o);
        }
        __builtin_amdgcn_wave_barrier();
    }
}

__device__ __forceinline__ void scan_s5(const Args& a, int l, int chain, unsigned char* ldsw  ) {
    const int lane = threadIdx.x & 63;
    const int b = chain >> 5, g = (chain >> 1) & 15, d = chain & 1;
    const bf16_t* U = (const bf16_t*)(a.ws + WS_BIG + BIG_U);
    bf16_t* YO = (bf16_t*)(a.ws + WS_BIG + T_YS5) + (size_t)d * NROW * 256;
    const float2* abar = (const float2*)(a.ws + WS_S5P); const float2* bbar = abar + 2 * 16 * 64;
    const float2 ab = abar[(d * 16 + g) * 64 + lane];
    float2 bb[16];
#pragma unroll
    for (int c = 0; c < 16; ++c) bb[c] = bbar[((size_t)(d * 16 + g) * 64 + lane) * 16 + c];
    const float* cre = a.in[32] + ((size_t)(l * 2 + d) * 16 + g) * 16 * 64; const float* cim = a.in[33] + ((size_t)(l * 2 + d) * 16 + g) * 16 * 64;
    float* su = (float*)ldsw;
    float* sx = su + 256;
    float xr = 0.f, xi = 0.f;
    for (int blk = 0; blk < 4352 / 16; ++blk) {
#pragma unroll
        for (int i = 0; i < 4; ++i) { const int idx = lane + 64 * i, j = idx >> 4, c = idx & 15; const int row = seq_row(b, d, blk * 16 + j); su[idx] = bf2f(U[(size_t)row * UW + U_S5 + g * 16 + c]); }
        __builtin_amdgcn_wave_barrier();
#pragma unroll 1
        for (int j = 0; j < 16; ++j) {
            float br = 0.f, bi = 0.f;
#pragma unroll
            for (int c4 = 0; c4 < 4; ++c4) { const float4 u4 = *(const float4*)(su + j * 16 + c4 * 4);
                br += bb[c4 * 4].x * u4.x + bb[c4 * 4 + 1].x * u4.y + bb[c4 * 4 + 2].x * u4.z + bb[c4 * 4 + 3].x * u4.w;
                bi += bb[c4 * 4].y * u4.x + bb[c4 * 4 + 1].y * u4.y + bb[c4 * 4 + 2].y * u4.z + bb[c4 * 4 + 3].y * u4.w; }
            const float nr = ab.x * xr - ab.y * xi + br, ni = ab.x * xi + ab.y * xr + bi;
            xr = nr; xi = ni;
            *(float2*)(sx + j * 132 + lane * 2) = make_float2(xr, xi);
        }
        __builtin_amdgcn_wave_barrier();
        {
            const int j = lane >> 2, cg = lane & 3;
            float y[4] = {0.f, 0.f, 0.f, 0.f};
#pragma unroll 2
            for (int p4 = 0; p4 < 16; ++p4) {
                const float4 xA = *(const float4*)(sx + j * 132 + p4 * 8), xB = *(const float4*)(sx + j * 132 + p4 * 8 + 4);
#pragma unroll
                for (int c = 0; c < 4; ++c) {
                    const float4 r4 = *(const float4*)(cre + (cg * 4 + c) * 64 + p4 * 4), i4 = *(const float4*)(cim + (cg * 4 + c) * 64 + p4 * 4);
                    y[c] += r4.x * xA.x - i4.x * xA.y + r4.y * xA.z - i4.y * xA.w + r4.z * xB.x - i4.z * xB.y + r4.w * xB.z - i4.w * xB.w;
                }
            }
            const int row = seq_row(b, d, blk * 16 + j);
            st4bf(YO + (size_t)row * 256 + g * 16 + cg * 4, y[0], y[1], y[2], y[3]);
        }
        __builtin_amdgcn_wave_barrier();
    }
}

__device__ __forceinline__ void attn_simple(const Args& a, int l, int aw, int naw, unsigned char* ldsw  ) {
    const int lane = threadIdx.x & 63;
    const bf16_t* U = (const bf16_t*)(a.ws + WS_BIG + BIG_U);
    bf16_t* Y = (bf16_t*)(a.ws + WS_BIG + BIG_Y);
    float* sq = (float*)ldsw;
    float* sp = sq + 128;
    const int nrows = (l == 0) ? NROW : NLAT;
    for (int task = aw; task < nrows * 2; task += naw) {
        const int r = task >> 1, kvh = task & 1;
        const bool lat = r < NLAT;
        int b, lo = 0, nW = 0;
        if (lat) { b = r >> 12; const int t = r & 4095; lo = max(0, t - 128); const int hi = min(4095, t + 128); nW = hi - lo + 1; } else { b = (r - NLAT) >> 8; }
        const int nK = nW + 256;
        const bf16_t* qp = U + (size_t)r * UW + U_ATT + kvh * 128;
        sq[lane] = bf2f(qp[lane]); sq[64 + lane] = bf2f(qp[64 + lane]);
        __builtin_amdgcn_wave_barrier();
        const float sink0 = a.in[26][l * 4 + kvh * 2], sink1 = a.in[26][l * 4 + kvh * 2 + 1];
        float s0[9], s1[9]; float m0 = sink0, m1 = sink1;
#pragma unroll
        for (int i = 0; i < 9; ++i) {
            const int kk = lane + 64 * i; s0[i] = -3.0e38f; s1[i] = -3.0e38f;
            if (kk < nK) {
                const int krow = (kk < nW) ? (b * 4096 + lo + kk) : (NLAT + b * 256 + (kk - nW));
                const bf16_t* kp = U + (size_t)krow * UW + U_ATT + 256 + kvh * 64;
                float d0 = 0.f, d1 = 0.f;
#pragma unroll
                for (int c = 0; c < 8; ++c) {
                    const uint4 kq = *(const uint4*)(kp + c * 8);
                    const float k0 = bf2f((bf16_t)(kq.x & 0xFFFF)), k1 = bf2f((bf16_t)(kq.x >> 16)), k2 = bf2f((bf16_t)(kq.y & 0xFFFF)), k3 = bf2f((bf16_t)(kq.y >> 16));
                    const float k4 = bf2f((bf16_t)(kq.z & 0xFFFF)), k5 = bf2f((bf16_t)(kq.z >> 16)), k6 = bf2f((bf16_t)(kq.w & 0xFFFF)), k7 = bf2f((bf16_t)(kq.w >> 16));
                    const float4 qa = *(const float4*)(sq + c * 8), qb = *(const float4*)(sq + c * 8 + 4), qc = *(const float4*)(sq + 64 + c * 8), qd = *(const float4*)(sq + 64 + c * 8 + 4);
                    d0 += k0 * qa.x + k1 * qa.y + k2 * qa.z + k3 * qa.w + k4 * qb.x + k5 * qb.y + k6 * qb.z + k7 * qb.w;
                    d1 += k0 * qc.x + k1 * qc.y + k2 * qc.z + k3 * qc.w + k4 * qd.x + k5 * qd.y + k6 * qd.z + k7 * qd.w;
                }
                s0[i] = d0; s1[i] = d1; m0 = fmaxf(m0, d0); m1 = fmaxf(m1, d1);
            }
        }
#pragma unroll
        for (int o = 32; o > 0; o >>= 1) { m0 = fmaxf(m0, __shfl_xor(m0, o)); m1 = fmaxf(m1, __shfl_xor(m1, o)); }
        float l0 = 0.f, l1 = 0.f;
#pragma unroll
        for (int i = 0; i < 9; ++i) {
            const int kk = lane + 64 * i;
            if (kk < nK) { const float p0 = __expf(s0[i] - m0), p1 = __expf(s1[i] - m1); l0 += p0; l1 += p1; *(float2*)(sp + kk * 2) = make_float2(p0, p1); }
        }
        l0 = wave_sum(l0) + __expf(sink0 - m0); l1 = wave_sum(l1) + __expf(sink1 - m1);
        __builtin_amdgcn_wave_barrier();
        float o0 = 0.f, o1 = 0.f;
        const bf16_t* vbase = U + U_ATT + 384 + kvh * 64 + lane;
        for (int kk = 0; kk < nK; ++kk) {
            const int krow = (kk < nW) ? (b * 4096 + lo + kk) : (NLAT + b * 256 + (kk - nW));
            const float v = bf2f(vbase[(size_t)krow * UW]);
            const float2 p = *(const float2*)(sp + kk * 2);
            o0 += p.x * v; o1 += p.y * v;
        }
        bf16_t* yo = Y + (size_t)r * 1024 + 512 + kvh * 128;
        yo[lane] = f2bf(o0 / l0); yo[64 + lane] = f2bf(o1 / l1);
        __builtin_amdgcn_wave_barrier();
    }
}

__device__ __forceinline__ void phase_scan(const Args& a, int l, unsigned char* lds) {
    const int wv = threadIdx.x >> 6;
    unsigned char* ldsw = lds + wv * 12288;
    const int bid = blockIdx.x;
    if (bid < 8) scan_rwkv(a, l, bid * 8 + wv, ldsw);
    else if (bid < 16) scan_gla(a, l, (bid - 8) * 8 + wv, ldsw);
    else if (bid < 48) scan_s5(a, l, (bid - 16) * 8 + wv, ldsw);
    else attn_simple(a, l, (bid - 48) * 8 + wv, (gridDim.x - 48) * 8, ldsw);
}

__device__ __forceinline__ void phase_fin(const Args& a, int l, unsigned char* lds) {
    const int lane = threadIdx.x & 63, wv = threadIdx.x >> 6;
    const int gw = blockIdx.x * 8 + wv, nw = gridDim.x * 8;
    const bf16_t* U = (const bf16_t*)(a.ws + WS_BIG + BIG_U);
    const bf16_t* MIX = (const bf16_t*)(a.ws + WS_BIG + T_MIX); const bf16_t* EXT = (const bf16_t*)(a.ws + WS_BIG + T_EXT);
    const bf16_t* YRW = (const bf16_t*)(a.ws + WS_BIG + T_YRW); const bf16_t* YGL = (const bf16_t*)(a.ws + WS_BIG + T_YGL); const bf16_t* YS5 = (const bf16_t*)(a.ws + WS_BIG + T_YS5);
    bf16_t* Y = (bf16_t*)(a.ws + WS_BIG + BIG_Y);
    float* ys = (float*)lds + wv * 256;
    const int nrows = (l == 0) ? NROW : NLAT;
    const int c = lane * 4;
    const float4 rk4 = *(const float4*)(a.in[19] + (size_t)l * 256 + c), lng = *(const float4*)(a.in[22] + (size_t)l * 256 + c);
    const float4 glng = *(const float4*)(a.in[25] + (size_t)l * 256 + c);
    const float4 d4 = *(const float4*)(a.in[34] + (size_t)l * 256 + c), bgl = *(const float4*)(a.in[36] + (size_t)l * 256 + c);
    const float* wglu = a.in[35] + (size_t)l * 256 * 256;
    for (int r = gw; r < nrows; r += nw) {
        {
            float y0[4], y1[4], rr[4], kk[4], vv[4], gg[4];
            ld4bf(YRW + (size_t)r * 256 + c, y0); ld4bf(YRW + (size_t)(NROW + r) * 256 + c, y1);
            ld4bf(MIX + (size_t)r * 768 + c, rr); ld4bf(MIX + (size_t)r * 768 + 256 + c, kk); ld4bf(MIX + (size_t)r * 768 + 512 + c, vv);
            ld4bf(EXT + (size_t)r * 1536 + 1280 + c, gg);
            float y[4] = {y0[0] + y1[0], y0[1] + y1[1], y0[2] + y1[2], y0[3] + y1[3]};
            float sm = y[0] + y[1] + y[2] + y[3];
            sm += __shfl_xor(sm, 1); sm += __shfl_xor(sm, 2); sm += __shfl_xor(sm, 4); sm += __shfl_xor(sm, 8);
            const float mu = sm * (1.0f / 64.0f);
            float vs = (y[0] - mu) * (y[0] - mu) + (y[1] - mu) * (y[1] - mu) + (y[2] - mu) * (y[2] - mu) + (y[3] - mu) * (y[3] - mu);
            vs += __shfl_xor(vs, 1); vs += __shfl_xor(vs, 2); vs += __shfl_xor(vs, 4); vs += __shfl_xor(vs, 8);
            const float rsd = rsqrtf(vs * (1.0f / 64.0f) + 64e-5f);
            float bs = rr[0] * kk[0] * rk4.x + rr[1] * kk[1] * rk4.y + rr[2] * kk[2] * rk4.z + rr[3] * kk[3] * rk4.w;
            bs += __shfl_xor(bs, 1); bs += __shfl_xor(bs, 2); bs += __shfl_xor(bs, 4); bs += __shfl_xor(bs, 8);
            st4bf(Y + (size_t)r * 1024 + c,
                  ((y[0] - mu) * rsd * lng.x + bs * vv[0]) * gg[0], ((y[1] - mu) * rsd * lng.y + bs * vv[1]) * gg[1],
                  ((y[2] - mu) * rsd * lng.z + bs * vv[2]) * gg[2], ((y[3] - mu) * rsd * lng.w + bs * vv[3]) * gg[3]);
        }
        {
            float o0[4], o1[4], rr[4];
            ld4bf(YGL + (size_t)r * 256 + c, o0); ld4bf(YGL + (size_t)(NROW + r) * 256 + c, o1);
            ld4bf(U + (size_t)r * UW + U_GLA + 512 + c, rr);
            float o[4] = {o0[0] + o1[0], o0[1] + o1[1], o0[2] + o1[2], o0[3] + o1[3]};
            float ss = o[0] * o[0] + o[1] * o[1] + o[2] * o[2] + o[3] * o[3];
            ss += __shfl_xor(ss, 1); ss += __shfl_xor(ss, 2); ss += __shfl_xor(ss, 4); ss += __shfl_xor(ss, 8);
            const float rn = rsqrtf(ss * (1.0f / 64.0f) + 1e-6f);
            st4bf(Y + (size_t)r * 1024 + 256 + c, o[0] * rn * glng.x * siluf(rr[0]), o[1] * rn * glng.y * siluf(rr[1]), o[2] * rn * glng.z * siluf(rr[2]), o[3] * rn * glng.w * siluf(rr[3]));
        }
        {
            float y0[4], y1[4], uu[4];
            ld4bf(YS5 + (size_t)r * 256 + c, y0); ld4bf(YS5 + (size_t)(NROW + r) * 256 + c, y1); ld4bf(U + (size_t)r * UW + U_S5 + c, uu);
            float y[4] = {d4.x * uu[0] + y0[0] + y1[0], d4.y * uu[1] + y0[1] + y1[1], d4.z * uu[2] + y0[2] + y1[2], d4.w * uu[3] + y0[3] + y1[3]};
#pragma unroll
            for (int j = 0; j < 4; ++j) { const float x = y[j]; y[j] = 0.5f * x * (1.f + tanhf(0.7978845608028654f * (x + 0.044715f * x * x * x))); }
            *(float4*)(ys + c) = make_float4(y[0], y[1], y[2], y[3]);
            __builtin_amdgcn_wave_barrier();
            float4 z = bgl;
#pragma unroll 8
            for (int k = 0; k < 256; ++k) { const float yk = ys[k]; const float4 w4 = *(const float4*)(wglu + (size_t)k * 256 + c); z.x += yk * w4.x; z.y += yk * w4.y; z.z += yk * w4.z; z.w += yk * w4.w; }
            st4bf(Y + (size_t)r * 1024 + 768 + c, y[0] * sigmf(z.x), y[1] * sigmf(z.y), y[2] * sigmf(z.z), y[3] * sigmf(z.w));
            __builtin_amdgcn_wave_barrier();
        }
    }
}

constexpr int LDS_BYTES = 128 * 1024;
enum { PH_PRO = 0, PH_N1, PH_G1, PH_PREP, PH_SCAN, PH_FIN, PH_MERGE, PH_G3, PH_N2, PH_M1, PH_M2, PH_PER_LAYER };
constexpr int PH_FINAL = 2 * PH_PER_LAYER, PH_COUNT = PH_FINAL + 1;

__global__ void __launch_bounds__(NTHREADS, 2) mega(Args a) {
    extern __shared__ __attribute__((aligned(16))) unsigned char lds[];
#define IN(p) ((p) >= a.ph_lo && (p) < a.ph_hi)
#define LAYER(l) { constexpr int base = (l) * PH_PER_LAYER; \
        if (IN(base + PH_PRO)) { phase_convert(a, l, lds, true, false); if ((l) == 0) phase_ada(a, lds); phase_s5params(a, l); } \
        if (IN(base + PH_N1)) phase_norm1(a, l, lds); \
        if (IN(base + PH_G1)) phase_g1(a, lds); \
        if (IN(base + PH_PREP)) phase_prep(a, l, lds); \
        if (IN(base + PH_SCAN)) phase_scan(a, l, lds); \
        if (IN(base + PH_FIN)) phase_fin(a, l, lds); \
        if (IN(base + PH_MERGE)) { phase_convert(a, l, lds, false, true); phase_merge(a, l, lds); } \
        if (IN(base + PH_G3)) phase_g3(a, l, lds); \
        if (IN(base + PH_N2)) phase_norm2(a, l, lds); \
        if (IN(base + PH_M1)) phase_moe1(a, l, lds); \
        if (IN(base + PH_M2)) phase_moe2(a, l, lds); }
    LAYER(0)
    LAYER(1)
#undef LAYER
    if (IN(PH_FINAL)) phase_norm1(a, 2, lds);
#undef IN
}

extern "C" void kernel_launch(void* const* d_in, const int* in_sizes, int n_in, void* d_out, int out_size, void* d_ws, size_t ws_size, hipStream_t stream) {
    static int inited = 0;
    if (!inited) {
        if (n_in != 46 || ws_size < WS_END) { fprintf(stderr, "kernel_launch: bad sizes n_in %d ws %zu need %zu\n", n_in, ws_size, (size_t)WS_END); inited = -1; return; }
        if (hipFuncSetAttribute((const void*)mega, hipFuncAttributeMaxDynamicSharedMemorySize, LDS_BYTES) != hipSuccess) { fprintf(stderr, "hipFuncSetAttribute failed\n"); inited = -1; return; }
        inited = 1;
    }
    if (inited < 0) return;
    (void)hipMemsetAsync((char*)d_ws, 0, 32768, stream);
    Args a{};
    for (int i = 0; i < 46; ++i) a.in[i] = (const float*)d_in[i];
    a.out = (float*)d_out; a.ws = (unsigned char*)d_ws;
    for (int p = 0; p < PH_COUNT; ++p) {
        a.ph_lo = p; a.ph_hi = p + 1;
        hipLaunchKernelGGL(mega, dim3(256), dim3(NTHREADS), LDS_BYTES, stream, a);
    }
}
```

```cpp
#include <hip/hip_runtime.h>
#include <stdint.h>
#include <stdio.h>

constexpr int D = 1024, NBATCH = 8, SEQ = 4096, CTXL = 256;
constexpr int NLAT = NBATCH * SEQ;
constexpr int NCTX = NBATCH * CTXL;
constexpr int NROW = NLAT + NCTX;
constexpr int PIN = 6688;
constexpr int UW = 2592;
constexpr int NEXP = 32, EH = 512;
constexpr int NTHREADS = 512;
constexpr int MOE_CAP = NROW;

constexpr int U_RWKV = 0, U_ATT = 1024, U_S5 = 1536, U_GLA = 1792;

typedef unsigned short bf16_t;
typedef short bf16x8 __attribute__((ext_vector_type(8)));
typedef float f32x4 __attribute__((ext_vector_type(4)));
#define LDSP(p) ((__attribute__((address_space(3))) unsigned*)(p))

constexpr size_t AL(size_t x) { return (x + 255) & ~(size_t)255; }
constexpr size_t WS_BAR   = 0;
constexpr size_t WS_CNT   = 16384;
constexpr size_t WS_MODS  = 32768;
constexpr size_t WS_WRT   = AL(WS_MODS + (size_t)2 * 9 * 6144 * 4);
constexpr size_t WS_WIN   = AL(WS_WRT + (size_t)36 * 1024 * 4);
constexpr size_t WS_WBR   = AL(WS_WIN + (size_t)PIN * 1024 * 2);
constexpr size_t WS_WOUT  = AL(WS_WBR + (size_t)4 * 1024 * 256 * 2);
constexpr size_t WS_H     = AL(WS_WOUT + (size_t)1024 * 1024 * 2);
constexpr size_t WS_XC    = AL(WS_H + (size_t)NROW * 1024 * 2);
constexpr size_t WS_STOK  = AL(WS_XC + (size_t)NCTX * 1024 * 4);
constexpr size_t WS_TINFO = AL(WS_STOK + (size_t)NEXP * MOE_CAP * 4);
constexpr size_t WS_S5P   = AL(WS_TINFO + (size_t)NROW * 16);
constexpr size_t WS_S5PW  = AL(WS_S5P + (size_t)2 * 16 * 64 * 8 + (size_t)2 * 16 * 64 * 16 * 8);
constexpr size_t WS_S5KF  = AL(WS_S5PW + (size_t)2 * 16 * 64 * 17 * 8);
constexpr size_t WS_S5E   = AL(WS_S5KF + (size_t)16 * 256 * 512 * 2);
constexpr size_t WS_WGLU  = AL(WS_S5E + (size_t)16 * 2 * 128 * 256 * 2);
constexpr size_t WS_RW1   = AL(WS_WGLU + (size_t)256 * 256 * 2);
constexpr size_t WS_RW2   = AL(WS_RW1 + (size_t)192 * 256 * 2);
constexpr size_t WS_S5KT  = AL(WS_RW2 + (size_t)(4 * 256 * 32 + 256 * 64) * 2);
constexpr size_t WS_BIG   = AL(WS_S5KT + (size_t)2 * 16 * 16 * 256 * 4);
constexpr size_t BIG_U    = 0;
constexpr size_t BIG_MRG  = 0;
constexpr size_t BIG_HID  = 0;
constexpr size_t BIG_WEG  = AL((size_t)NROW * 1024 * 2);
constexpr size_t BIG_WEU  = BIG_WEG + (size_t)NEXP * EH * 1024 * 2;
constexpr size_t BIG_WED  = BIG_WEU + (size_t)NEXP * EH * 1024 * 2;
constexpr size_t BIG_Y    = AL((size_t)NROW * UW * 2);
constexpr size_t BIG_T    = BIG_Y + AL((size_t)NROW * 1024 * 2);
constexpr size_t T_MIX    = BIG_T;
constexpr size_t T_EXT    = T_MIX + AL((size_t)NROW * 768 * 2);
constexpr size_t T_YRW    = T_EXT + AL((size_t)NROW * 1536 * 2);
constexpr size_t T_GD     = T_YRW + AL((size_t)2 * NROW * 256 * 2);
constexpr size_t T_GDEC   = T_GD + AL((size_t)64 * 68 * 8192);
constexpr size_t T_AC     = T_GDEC + AL((size_t)64 * 68 * 128);
constexpr size_t T_XE     = T_AC + AL((size_t)16 * 2176 * 512 * 2);
constexpr size_t T_END    = T_XE + AL((size_t)NROW * 256 * 2);
constexpr size_t BIG_YD   = BIG_T;
static_assert(BIG_WED + (size_t)NEXP * 1024 * EH * 2 <= BIG_Y, "experts must fit in U tail");
static_assert(BIG_YD + (size_t)2 * NROW * 1024 * 2 <= T_END, "YD must fit in T");
constexpr size_t WS_END   = WS_BIG + T_END;

struct Args {
    const float* in[46];
    float* out;
    unsigned char* ws;
    int ph_lo, ph_hi;
};

#define XB_TMO      128
#define XB_XCNT(j)  (256  + 64 * (j))
#define XB_XSUB(j)  (1280 + 64 * (j))
#define XB_XGEN(j)  (2304 + 64 * (j))
#define XB_TOP      3328
#define XB_TOPGEN   3392
#define XCD_BAR_WORDS 3456
#define XB_SPIN_CAP (1u << 18)
#define LAS __attribute__((address_space(3)))

__device__ __forceinline__ unsigned xb_ld(unsigned* p)              { return __hip_atomic_load(p, __ATOMIC_RELAXED, __HIP_MEMORY_SCOPE_AGENT); }
__device__ __forceinline__ unsigned xb_add(unsigned* p, unsigned v) { return __hip_atomic_fetch_add(p, v, __ATOMIC_RELAXED, __HIP_MEMORY_SCOPE_AGENT); }
__device__ __forceinline__ unsigned xb_xcc_id() { return (unsigned)__builtin_amdgcn_s_getreg((3 << 11) | 20) & 0xFu; }
#define XB_SPIN(cond, bar) do { unsigned _sp = 0; while (cond) { __builtin_amdgcn_s_sleep(1); \
    if ((++_sp & 255u) == 0u) { if (xb_ld(&(bar)[XB_TMO])) break; if (_sp > XB_SPIN_CAP) { atomicAdd(&(bar)[XB_TMO], 1u); break; } } } } while (0)

struct XcdBarrier {
    unsigned* bar; unsigned x;
    volatile LAS unsigned* st;
};

__device__ __forceinline__ XcdBarrier xcd_barrier_post(unsigned* bar, volatile LAS unsigned* st) {
    XcdBarrier b; b.bar = bar; b.x = xb_xcc_id(); b.st = st;
    if (threadIdx.x == 0) (void)xb_add(&bar[XB_XCNT(b.x)], 1u);
    return b;
}
__device__ __forceinline__ void xcd_barrier_complete(unsigned* bar, unsigned x, unsigned& nloc, unsigned& nx) {
    const unsigned G = gridDim.x * gridDim.y * gridDim.z;
    unsigned sum, cnt, mine, sp = 0u;
    for (;;) {
        sum = 0u; cnt = 0u; mine = 0u;
#pragma unroll
        for (unsigned j = 0; j < 16; ++j) { const unsigned c = xb_ld(&bar[XB_XCNT(j)]); sum += c; cnt += (c > 0u) ? 1u : 0u; mine = (j == x) ? c : mine; }
        if (sum == G) break;
        __builtin_amdgcn_s_sleep(1);
        if ((++sp & 255u) == 0u) { if (xb_ld(&bar[XB_TMO])) break; if (sp > XB_SPIN_CAP) { atomicAdd(&bar[XB_TMO], 1u); break; } }
    }
    nloc = mine > 0u ? mine : 1u; nx = cnt > 0u ? cnt : 1u;
}

__device__ __forceinline__ void xcd_barrier(const XcdBarrier& b) {
    asm volatile("s_waitcnt vmcnt(0)" ::: "memory");
    __syncthreads();
    if (threadIdx.x == 0) {
        unsigned* bar = b.bar;
        __builtin_amdgcn_s_waitcnt(0);
        unsigned nloc = b.st[0], nx = b.st[1];
        if (nloc == 0u) { xcd_barrier_complete(bar, b.x, nloc, nx); b.st[0] = nloc; b.st[1] = nx; }
        const unsigned old = xb_add(&bar[XB_XSUB(b.x)], 1u);
        const unsigned gen = old / nloc;
        if (old + 1u == (gen + 1u) * nloc) {
            __builtin_amdgcn_fence(__ATOMIC_RELEASE, "agent");
            asm volatile("s_waitcnt vmcnt(0)" ::: "memory");
            const unsigned og = xb_add(&bar[XB_TOP], 1u);
            const unsigned tg = og / nx;
            if (og + 1u == (tg + 1u) * nx) xb_add(&bar[XB_TOPGEN], 1u);
            else XB_SPIN(xb_ld(&bar[XB_TOPGEN]) == tg, bar);
            __builtin_amdgcn_fence(__ATOMIC_ACQUIRE, "agent");
            xb_add(&bar[XB_XGEN(b.x)], 1u);
            asm volatile("s_waitcnt vmcnt(0)" ::: "memory");
        } else {
            XB_SPIN(xb_ld(&bar[XB_XGEN(b.x)]) == gen, bar);
            __builtin_amdgcn_fence(__ATOMIC_ACQUIRE, "agent");
            asm volatile("s_waitcnt vmcnt(0)" ::: "memory");
        }
    }
    __syncthreads();
}

__device__ __forceinline__ bf16_t f2bf(float f) { unsigned u = __float_as_uint(f); u += 0x7FFFu + ((u >> 16) & 1u); return (bf16_t)(u >> 16); }
__device__ __forceinline__ float bf2f(bf16_t h) { return __uint_as_float(((unsigned)h) << 16); }
typedef __bf16 bf2_t __attribute__((ext_vector_type(2)));
typedef float f2_t __attribute__((ext_vector_type(2)));
__device__ __forceinline__ unsigned pack2(float a, float b) { f2_t v = {a, b}; bf2_t h = __builtin_convertvector(v, bf2_t); return __builtin_bit_cast(unsigned, h); }
__device__ __forceinline__ float siluf(float x) { return x / (1.0f + __expf(-x)); }
__device__ __forceinline__ float sigmf(float x) { return 1.0f / (1.0f + __expf(-x)); }
__device__ __forceinline__ float wave_sum(float v) {
#pragma unroll
    for (int o = 32; o > 0; o >>= 1) v += __shfl_xor(v, o);
    return v;
}

__device__ __forceinline__ void ld4bf(const bf16_t* p, float (&o)[4]) { uint2 q = *(const uint2*)p; o[0] = bf2f((bf16_t)(q.x & 0xFFFF)); o[1] = bf2f((bf16_t)(q.x >> 16)); o[2] = bf2f((bf16_t)(q.y & 0xFFFF)); o[3] = bf2f((bf16_t)(q.y >> 16)); }
__device__ __forceinline__ void st4bf(bf16_t* p, float a0, float a1, float a2, float a3) { uint2 q; q.x = pack2(a0, a1); q.y = pack2(a2, a3); *(uint2*)p = q; }

__device__ __forceinline__ void cvt_tile(const float* __restrict__ src, int ldS, int k0, int sc0, bf16_t* __restrict__ dst, int ldD, int dr0, unsigned char* lds) {
    bf16_t* t = (bf16_t*)lds;
    const int tid = threadIdx.x;
    float4 v[2];
#pragma unroll
    for (int i = 0; i < 2; ++i) v[i] = *(const float4*)(src + (size_t)(k0 + (tid >> 3) + 64 * i) * ldS + sc0 + (tid & 7) * 4);
#pragma unroll
    for (int i = 0; i < 2; ++i) {
        const int k = (tid >> 3) + 64 * i, n = (tid & 7) * 4;
        t[(n + 0) * 136 + k] = f2bf(v[i].x); t[(n + 1) * 136 + k] = f2bf(v[i].y); t[(n + 2) * 136 + k] = f2bf(v[i].z); t[(n + 3) * 136 + k] = f2bf(v[i].w);
    }
    __syncthreads();
    {
        const int n = tid >> 4, k8 = (tid & 15) * 8;
        *(uint4*)(dst + (size_t)(dr0 + n) * ldD + k0 + k8) = *(const uint4*)(t + n * 136 + k8);
    }
    __syncthreads();
}

template <class TF>
__device__ __forceinline__ void cvt_stream(int total, int b0, int nb, TF tf, unsigned char* lds) {
    const int tid = threadIdx.x;
    int w = b0; if (w >= total) return;
    const float* sp; int ldS; bf16_t* dp; int ldD;
    tf(w, sp, ldS, dp, ldD);
    float4 v0 = *(const float4*)(sp + (size_t)(tid >> 3) * ldS + (tid & 7) * 4), v1 = *(const float4*)(sp + (size_t)((tid >> 3) + 64) * ldS + (tid & 7) * 4);
    int buf = 0;
    for (; w < total; w += nb) {
        bf16_t* dcur = dp; const int ldc = ldD;
        const float4 c0 = v0, c1 = v1;
        if (w + nb < total) {
            tf(w + nb, sp, ldS, dp, ldD);
            v0 = *(const float4*)(sp + (size_t)(tid >> 3) * ldS + (tid & 7) * 4); v1 = *(const float4*)(sp + (size_t)((tid >> 3) + 64) * ldS + (tid & 7) * 4);
        }
        bf16_t* t = (bf16_t*)(lds + buf * 8704);
        {
            const int k = tid >> 3, n = (tid & 7) * 4;
            t[(n + 0) * 136 + k] = f2bf(c0.x); t[(n + 1) * 136 + k] = f2bf(c0.y); t[(n + 2) * 136 + k] = f2bf(c0.z); t[(n + 3) * 136 + k] = f2bf(c0.w);
            t[(n + 0) * 136 + k + 64] = f2bf(c1.x); t[(n + 1) * 136 + k + 64] = f2bf(c1.y); t[(n + 2) * 136 + k + 64] = f2bf(c1.z); t[(n + 3) * 136 + k + 64] = f2bf(c1.w);
        }
        __syncthreads();
        {
            const int n = tid >> 4, k8 = (tid & 15) * 8;
            *(uint4*)(dcur + (size_t)n * ldc + k8) = *(const uint4*)(t + n * 136 + k8);
        }
        buf ^= 1;
    }
    __syncthreads();
}

__device__ __forceinline__ int win_src_col(int n) {
    if (n < 1024) return n;
    if (n < 1536) return 1824 + (n - 1024);
    if (n < 1792) return 2336 + (n - 1536);
    if (n < 2592) return 1024 + (n - 1792);
    return n;
}

__device__ __forceinline__ void phase_convert(const Args& a, int l, unsigned char* lds, bool do_main, bool do_experts, int b0, int nb) {
    unsigned char* ws = a.ws;
    if (do_main) {
        {
            const float* src = a.in[9] + (size_t)l * 1024 * PIN;
            bf16_t* dst = (bf16_t*)(ws + WS_WIN);
            cvt_stream(8 * 209, b0, nb, [=](int w, const float*& sp, int& ldS, bf16_t*& dp, int& ldD) {
                const int kt = w & 7, nt = w >> 3; sp = src + (size_t)(kt * 128) * PIN + win_src_col(nt * 32); ldS = PIN; dp = dst + (size_t)(nt * 32) * 1024 + kt * 128; ldD = 1024; }, lds);
        }
        for (int i = 0; i < 4; ++i) {
            const float* src = a.in[37] + ((size_t)l * 4 + i) * 256 * 1024;
            bf16_t* dst = (bf16_t*)(ws + WS_WBR) + (size_t)i * 1024 * 256;
            for (int w = b0; w < 2 * 32; w += nb) { int kt = w & 1, nt = w >> 1; cvt_tile(src, 1024, kt * 128, nt * 32, dst, 256, nt * 32, lds); }
        }
        {
            const float* src = a.in[38] + (size_t)l * 1024 * 1024;
            bf16_t* dst = (bf16_t*)(ws + WS_WOUT);
            for (int w = b0; w < 8 * 32; w += nb) { int kt = w & 7, nt = w >> 3; cvt_tile(src, 1024, kt * 128, nt * 32, dst, 1024, nt * 32, lds); }
        }
        {
            bf16_t* r1 = (bf16_t*)(ws + WS_RW1); bf16_t* r2 = (bf16_t*)(ws + WS_RW2);
            const float* w1 = a.in[12] + (size_t)l * 2 * 256 * 32; const float* a1 = a.in[15] + (size_t)l * 2 * 256 * 32; const float* g1 = a.in[20] + (size_t)l * 256 * 64;
            const float* w2 = a.in[13] + (size_t)l * 2 * 32 * 256; const float* a2 = a.in[16] + (size_t)l * 2 * 32 * 256; const float* g2 = a.in[21] + (size_t)l * 64 * 256;
            for (int i = b0 * NTHREADS + threadIdx.x; i < 192 * 256; i += nb * NTHREADS) {
                const int k = i & 255, n = i >> 8; float v;
                if (n < 64) v = w1[((n >> 5) * 256 + k) * 32 + (n & 31)]; else if (n < 128) v = a1[(((n - 64) >> 5) * 256 + k) * 32 + (n & 31)]; else v = g1[k * 64 + (n - 128)];
                r1[i] = f2bf(v);
            }
            for (int i = b0 * NTHREADS + threadIdx.x; i < 4 * 256 * 32; i += nb * NTHREADS) {
                const int k = i & 31, n = (i >> 5) & 255, blk = i >> 13;
                const float v = (blk < 2) ? w2[(blk * 32 + k) * 256 + n] : a2[((blk - 2) * 32 + k) * 256 + n];
                r2[i] = f2bf(v);
            }
            for (int i = b0 * NTHREADS + threadIdx.x; i < 256 * 64; i += nb * NTHREADS) { const int k = i & 63, n = i >> 6; r2[4 * 256 * 32 + i] = f2bf(g2[k * 256 + n]); }
        }
        {
            const float* src = a.in[35] + (size_t)l * 256 * 256;
            bf16_t* dst = (bf16_t*)(ws + WS_WGLU);
            for (int w = b0; w < 2 * 8; w += nb) { int kt = w & 1, nt = w >> 1; cvt_tile(src, 256, kt * 128, nt * 32, dst, 256, nt * 32, lds); }
        }
        {
            float* dst = (float*)(ws + WS_WRT);
            const float* wg = a.in[39] + (size_t)l * 1024 * 4;
            const float* we = a.in[41] + (size_t)l * 1024 * 32;
            for (int i = b0 * NTHREADS + threadIdx.x; i < 36 * 1024; i += nb * NTHREADS) {
                int o = i >> 10, k = i & 1023;
                dst[i] = (o < 4) ? wg[k * 4 + o] : we[k * 32 + (o - 4)];
            }
        }
    }
    if (do_experts) {
        const float* g0 = a.in[43] + (size_t)l * NEXP * 1024 * EH; const float* u0 = a.in[44] + (size_t)l * NEXP * 1024 * EH; const float* d0 = a.in[45] + (size_t)l * NEXP * EH * 1024;
        bf16_t* dg = (bf16_t*)(ws + WS_BIG + BIG_WEG); bf16_t* du = (bf16_t*)(ws + WS_BIG + BIG_WEU); bf16_t* dd = (bf16_t*)(ws + WS_BIG + BIG_WED);
        cvt_stream(3 * 4096, b0, nb, [=](int w, const float*& sp, int& ldS, bf16_t*& dp, int& ldD) {
            const int which = w >> 12, r2 = w & 4095, e = r2 >> 7, r = r2 & 127;
            if (which < 2) { const int kt = r & 7, nt = r >> 3; sp = (which ? u0 : g0) + (size_t)e * 1024 * EH + (size_t)(kt * 128) * EH + nt * 32; ldS = EH;
                             dp = (which ? du : dg) + (size_t)e * EH * 1024 + (size_t)(nt * 32) * 1024 + kt * 128; ldD = 1024; }
            else { const int kt = r & 3, nt = r >> 2; sp = d0 + (size_t)e * EH * 1024 + (size_t)(kt * 128) * 1024 + nt * 32; ldS = 1024;
                   dp = dd + (size_t)e * 1024 * EH + (size_t)(nt * 32) * EH + kt * 128; ldD = EH; }
        }, lds);
    }
}

__device__ __forceinline__ void phase_ada(const Args& a, unsigned char* lds) {
    float* sil = (float*)lds;
    float* red = (float*)(lds + 9 * 1024 * 4);
    const int tid = threadIdx.x;
    for (int i = tid; i < 9 * 1024; i += NTHREADS) {
        int v = i >> 10, k = i & 1023;
        float x = (v < 8) ? a.in[1][v * 1024 + k] : a.in[3][k];
        sil[i] = siluf(x);
    }
    __syncthreads();
    float* mods = (float*)(a.ws + WS_MODS);
    const int tx = tid & 31, ty = tid >> 5;
    for (int w = blockIdx.x; w < 2 * 192; w += gridDim.x) {
        int l = w / 192, n0 = (w % 192) * 32;
        const float* wa = a.in[7] + (size_t)l * 1024 * 6144;
        float acc[9];
#pragma unroll
        for (int v = 0; v < 9; ++v) acc[v] = 0.f;
        for (int kk = 0; kk < 64; ++kk) {
            int k = ty * 64 + kk;
            float wv = wa[(size_t)k * 6144 + n0 + tx];
#pragma unroll
            for (int v = 0; v < 9; ++v) acc[v] += sil[v * 1024 + k] * wv;
        }
#pragma unroll
        for (int v = 0; v < 9; ++v) red[(ty * 9 + v) * 32 + tx] = acc[v];
        __syncthreads();
        if (tid < 288) {
            int v = tid >> 5, x = tid & 31; float s = 0.f;
            for (int y = 0; y < 16; ++y) s += red[(y * 9 + v) * 32 + x];
            mods[((size_t)l * 9 + v) * 6144 + n0 + x] = s + a.in[8][(size_t)l * 6144 + n0 + x];
        }
        __syncthreads();
    }
}

__device__ __forceinline__ void moe_offsets(const Args& a, int l, int* s_start  , int* s_cnt  ) {
    const unsigned* cnt = (const unsigned*)(a.ws + WS_CNT) + l * 64;
    if (threadIdx.x < 32) s_cnt[threadIdx.x] = (int)cnt[threadIdx.x];
    __syncthreads();
    if (threadIdx.x == 0) { int s = 0; for (int e = 0; e < 32; ++e) { s_start[e] = s; s += s_cnt[e]; } s_start[32] = s; }
    __syncthreads();
}

__device__ __forceinline__ void phase_norm1(const Args& a, int mode, unsigned char* lds) {
    int* s_start = (int*)lds; int* s_cnt = s_start + 64;
    if (mode > 0) moe_offsets(a, mode - 1, s_start, s_cnt);
    int tid = threadIdx.x; asm volatile("" : "+v"(tid));
    const int lane = tid & 63, wv = tid >> 6;
    const int l = (mode == 2) ? 1 : mode;
    const float* mods = (const float*)(a.ws + WS_MODS) + (size_t)l * 9 * 6144;
    const float* pmods = (const float*)(a.ws + WS_MODS) + (size_t)(mode > 0 ? mode - 1 : 0) * 9 * 6144;
    const float* g = (mode == 2) ? a.in[6] : a.in[4] + (size_t)l * 1024;
    bf16_t* H = (bf16_t*)(a.ws + WS_H);
    const bf16_t* YD = (const bf16_t*)(a.ws + WS_BIG + BIG_YD);
    const uint4* tinfo = (const uint4*)(a.ws + WS_TINFO);
    float* XC = (float*)(a.ws + WS_XC);
    const int nrows = (mode == 2) ? NLAT : NROW;
    const int gw = blockIdx.x * 8 + wv, nw = gridDim.x * 8;
    float* M5 = (float*)(lds + 1024);
    float* GS = M5 + 9 * 1024;
    float* SHV = GS + 9 * 1024;
    for (int i = tid; i < 9 * 1024; i += NTHREADS) {
        const int c = i & 1023, b = i >> 10;
        if (mode > 0) M5[i] = pmods[(size_t)b * 6144 + 5 * 1024 + c];
        if (mode == 2) GS[i] = g[c];
        else { GS[i] = g[c] * (1.f + mods[(size_t)b * 6144 + 1024 + c]); SHV[i] = mods[(size_t)b * 6144 + c]; }
    }
    __syncthreads();
    auto xsrc = [&](int r) -> const float* {
        if (r < NLAT) return (mode == 0) ? a.in[0] + (size_t)r * 1024 : a.out + (size_t)r * 1024;
        return (mode == 0) ? a.in[2] + (size_t)(r - NLAT) * 1024 : XC + (size_t)(r - NLAT) * 1024;
    };
    float4 nv[4]; uint4 nti = make_uint4(0u, 0u, 0u, 0u);
    if (gw < nrows) {
        const float* xr0 = xsrc(gw);
#pragma unroll
        for (int i = 0; i < 2; ++i) { nv[2 * i] = ((const float4*)xr0)[(lane + 64 * i) * 2]; nv[2 * i + 1] = ((const float4*)xr0)[(lane + 64 * i) * 2 + 1]; }
        if (mode > 0) nti = tinfo[gw];
    }
#pragma unroll 1
    for (int r = gw; r < nrows; r += nw) {
        const bool lat = r < NLAT;
        const int bj = lat ? (r >> 12) : 8;
        float* xw = lat ? a.out + (size_t)r * 1024 : XC + (size_t)(r - NLAT) * 1024;
        float4 v[4];
#pragma unroll
        for (int i = 0; i < 4; ++i) v[i] = nv[i];
        const uint4 ti_cur = nti;
        {
            const int rn = min(r + nw, nrows - 1);
            const float* xrn = xsrc(rn);
#pragma unroll
            for (int i = 0; i < 2; ++i) { nv[2 * i] = ((const float4*)xrn)[(lane + 64 * i) * 2]; nv[2 * i + 1] = ((const float4*)xrn)[(lane + 64 * i) * 2 + 1]; }
            if (mode > 0) nti = tinfo[rn];
        }
        if (mode > 0) {
            const uint4 ti = ti_cur;
            const int e0 = ti.x >> 24, p0 = ti.x & 0xFFFFFF, e1 = ti.z >> 24, p1 = ti.z & 0xFFFFFF;
            const float w0 = __uint_as_float(ti.y), w1 = __uint_as_float(ti.w);
            const bf16_t* y0 = YD + (size_t)(s_start[e0] + p0) * 1024;
            const bf16_t* y1 = YD + (size_t)(s_start[e1] + p1) * 1024;
            const float* m5 = M5 + bj * 1024;
#pragma unroll
            for (int i = 0; i < 2; ++i) {
                const int c = (lane + 64 * i) * 8;
                const uint4 q0 = *(const uint4*)(y0 + c), q1 = *(const uint4*)(y1 + c);
                const float4 ma = *(const float4*)(m5 + c), mb = *(const float4*)(m5 + c + 4);
                v[2 * i].x += ma.x * (w0 * bf2f((bf16_t)(q0.x & 0xFFFF)) + w1 * bf2f((bf16_t)(q1.x & 0xFFFF)));
                v[2 * i].y += ma.y * (w0 * bf2f((bf16_t)(q0.x >> 16)) + w1 * bf2f((bf16_t)(q1.x >> 16)));
                v[2 * i].z += ma.z * (w0 * bf2f((bf16_t)(q0.y & 0xFFFF)) + w1 * bf2f((bf16_t)(q1.y & 0xFFFF)));
                v[2 * i].w += ma.w * (w0 * bf2f((bf16_t)(q0.y >> 16)) + w1 * bf2f((bf16_t)(q1.y >> 16)));
                v[2 * i + 1].x += mb.x * (w0 * bf2f((bf16_t)(q0.z & 0xFFFF)) + w1 * bf2f((bf16_t)(q1.z & 0xFFFF)));
                v[2 * i + 1].y += mb.y * (w0 * bf2f((bf16_t)(q0.z >> 16)) + w1 * bf2f((bf16_t)(q1.z >> 16)));
                v[2 * i + 1].z += mb.z * (w0 * bf2f((bf16_t)(q0.w & 0xFFFF)) + w1 * bf2f((bf16_t)(q1.w & 0xFFFF)));
                v[2 * i + 1].w += mb.w * (w0 * bf2f((bf16_t)(q0.w >> 16)) + w1 * bf2f((bf16_t)(q1.w >> 16)));
            }
            if (mode == 1) {
#pragma unroll
                for (int i = 0; i < 2; ++i) { ((float4*)xw)[(lane + 64 * i) * 2] = v[2 * i]; ((float4*)xw)[(lane + 64 * i) * 2 + 1] = v[2 * i + 1]; }
            }
        }
        float ss = 0.f;
#pragma unroll
        for (int i = 0; i < 4; ++i) ss += v[i].x * v[i].x + v[i].y * v[i].y + v[i].z * v[i].z + v[i].w * v[i].w;
        ss = wave_sum(ss);
        const float rs = rsqrtf(ss * (1.0f / 1024.0f) + 1e-6f);
        const float* gsp = GS + bj * 1024;
        if (mode == 2) {
#pragma unroll
            for (int i = 0; i < 2; ++i) {
                const int c = (lane + 64 * i) * 8;
                const float4 ga = *(const float4*)(gsp + c), gb = *(const float4*)(gsp + c + 4);
                float4 oa, ob;
                oa.x = v[2 * i].x * rs * ga.x; oa.y = v[2 * i].y * rs * ga.y; oa.z = v[2 * i].z * rs * ga.z; oa.w = v[2 * i].w * rs * ga.w;
                ob.x = v[2 * i + 1].x * rs * gb.x; ob.y = v[2 * i + 1].y * rs * gb.y; ob.z = v[2 * i + 1].z * rs * gb.z; ob.w = v[2 * i + 1].w * rs * gb.w;
                ((float4*)xw)[(lane + 64 * i) * 2] = oa; ((float4*)xw)[(lane + 64 * i) * 2 + 1] = ob;
            }
        } else {
            const float* shp = SHV + bj * 1024;
#pragma unroll
            for (int i = 0; i < 2; ++i) {
                const int c = (lane + 64 * i) * 8;
                const float4 ga = *(const float4*)(gsp + c), gb = *(const float4*)(gsp + c + 4), sa = *(const float4*)(shp + c), sb = *(const float4*)(shp + c + 4);
                uint4 w;
                w.x = pack2(v[2 * i].x * rs * ga.x + sa.x, v[2 * i].y * rs * ga.y + sa.y); w.y = pack2(v[2 * i].z * rs * ga.z + sa.z, v[2 * i].w * rs * ga.w + sa.w);
                w.z = pack2(v[2 * i + 1].x * rs * gb.x + sb.x, v[2 * i + 1].y * rs * gb.y + sb.y); w.w = pack2(v[2 * i + 1].z * rs * gb.z + sb.z, v[2 * i + 1].w * rs * gb.w + sb.w);
                *(uint4*)(H + (size_t)r * 1024 + c) = w;
            }
        }
    }
}

__device__ __forceinline__ unsigned char* hist_base_bytes(unsigned char* lds) { return lds + 112 * 1024; }
__device__ __forceinline__ void phase_norm2(const Args& a, int l, unsigned char* lds) {
    int tid = threadIdx.x; asm volatile("" : "+v"(tid));
    const int lane = tid & 63, wv = tid >> 6, fr = lane & 15, fq = lane >> 4;
    const int nrows = (l == 0) ? NROW : NLAT;
    const int per = nrows / 256;
    const int rbase = blockIdx.x * per;
    constexpr int HP = 1026;
    float* HT = (float*)lds;
    float* PART = (float*)(lds + 16 * HP * 4);
    float* LOG = PART + 8 * 16 * 48;
    int* PKE = (int*)(LOG + 16 * 40);
    float* PKW = (float*)(PKE + 272);
    const float* mods = (const float*)(a.ws + WS_MODS) + (size_t)l * 9 * 6144;
    const float* g = a.in[5] + (size_t)l * 1024;
    const float* wrt = (const float*)(a.ws + WS_WRT);
    const float* bg = a.in[40] + l * 4; const float* be = a.in[42] + l * 32;
    bf16_t* H = (bf16_t*)(a.ws + WS_H);
    const float* XC = (const float*)(a.ws + WS_XC);
    float bw[32][3];
#pragma unroll
    for (int nt = 0; nt < 3; ++nt) {
        const int o = 16 * nt + fr;
#pragma unroll
        for (int k4 = 0; k4 < 8; ++k4) {
            const float4 w4 = *(const float4*)(wrt + (size_t)min(o, 35) * 1024 + 128 * wv + 32 * fq + 4 * k4);
            const float zk = (o < 36) ? 1.0f : 0.0f;
            bw[4 * k4][nt] = w4.x * zk; bw[4 * k4 + 1][nt] = w4.y * zk; bw[4 * k4 + 2][nt] = w4.z * zk; bw[4 * k4 + 3][nt] = w4.w * zk;
        }
    }
    float* GS = (float*)(hist_base_bytes(lds));
    float* SHV = GS + 2048;
    const int b_lo = (rbase < NLAT) ? (rbase >> 12) : 8;
    for (int i = tid; i < 2048; i += NTHREADS) {
        const int j = i >> 10, c = i & 1023, b = min(b_lo + j, 8);
        GS[i] = g[c] * (1.f + mods[(size_t)b * 6144 + 4 * 1024 + c]); SHV[i] = mods[(size_t)b * 6144 + 3 * 1024 + c];
    }
    __syncthreads();
    const int ntile = (per + 15) / 16;
    float4 xv[2][4];
#pragma unroll
    for (int u = 0; u < 2; ++u) {
        const int ri = 2 * wv + u;
        const int r = rbase + ri;
        const float* xr = (r < NLAT) ? a.out + (size_t)r * 1024 : XC + (size_t)(r - NLAT) * 1024;
#pragma unroll
        for (int i = 0; i < 4; ++i) xv[u][i] = ((const float4*)xr)[lane + 64 * i];
    }
#pragma unroll 1
    for (int tile = 0; tile < ntile; ++tile) {
#pragma unroll
        for (int u = 0; u < 2; ++u) {
            const int rl = 2 * wv + u, ri = tile * 16 + rl;
            if (ri < per) {
                const int r = rbase + ri;
                const bool lat = r < NLAT; const int b = lat ? (r >> 12) : 8;
                float4 v[4]; float ss = 0.f;
#pragma unroll
                for (int i = 0; i < 4; ++i) { v[i] = xv[u][i]; ss += v[i].x * v[i].x + v[i].y * v[i].y + v[i].z * v[i].z + v[i].w * v[i].w; }
                ss = wave_sum(ss);
                const float rs = rsqrtf(ss * (1.0f / 1024.0f) + 1e-6f);
                const float* gsp = GS + (b - b_lo) * 1024; const float* shp = SHV + (b - b_lo) * 1024;
#pragma unroll
                for (int i = 0; i < 4; ++i) {
                    const int c = (lane + 64 * i) * 4;
                    const float4 gg = *(const float4*)(gsp + c), s4 = *(const float4*)(shp + c);
                    const float o0 = v[i].x * rs * gg.x + s4.x, o1 = v[i].y * rs * gg.y + s4.y;
                    const float o2 = v[i].z * rs * gg.z + s4.z, o3 = v[i].w * rs * gg.w + s4.w;
                    uint2 w; w.x = pack2(o0, o1); w.y = pack2(o2, o3);
                    *(uint2*)(H + (size_t)r * 1024 + c) = w;
                    *(float2*)(HT + rl * HP + c) = make_float2(o0, o1); *(float2*)(HT + rl * HP + c + 2) = make_float2(o2, o3);
                }
            }
        }
        __syncthreads();
#pragma unroll
        for (int u = 0; u < 2; ++u) {
            const int ri = (tile + 1) * 16 + 2 * wv + u;
            if (ri < per) {
                const int r = rbase + ri;
                const float* xr = (r < NLAT) ? a.out + (size_t)r * 1024 : XC + (size_t)(r - NLAT) * 1024;
#pragma unroll
                for (int i = 0; i < 4; ++i) xv[u][i] = ((const float4*)xr)[lane + 64 * i];
            }
        }
        {
            f32x4 acc[3];
#pragma unroll
            for (int nt = 0; nt < 3; ++nt) acc[nt] = (f32x4){0.f, 0.f, 0.f, 0.f};
            const float* hp = HT + fr * HP + 128 * wv + 32 * fq;
#pragma unroll
            for (int k2 = 0; k2 < 16; ++k2) {
                if ((k2 & 3) == 0) asm volatile("" ::: "memory");
                const float2 a2 = *(const float2*)(hp + 2 * k2);
#pragma unroll
                for (int nt = 0; nt < 3; ++nt) acc[nt] = __builtin_amdgcn_mfma_f32_16x16x4f32(a2.x, bw[2 * k2][nt], acc[nt], 0, 0, 0);
#pragma unroll
                for (int nt = 0; nt < 3; ++nt) acc[nt] = __builtin_amdgcn_mfma_f32_16x16x4f32(a2.y, bw[2 * k2 + 1][nt], acc[nt], 0, 0, 0);
            }
#pragma unroll
            for (int nt = 0; nt < 3; ++nt)
#pragma unroll
                for (int j = 0; j < 4; ++j) PART[(wv * 16 + 4 * fq + j) * 48 + 16 * nt + fr] = acc[nt][j];
        }
        __syncthreads();
        for (int i = tid; i < 16 * 36; i += NTHREADS) {
            const int row = i / 36, o = i % 36; float s = (o < 4) ? bg[o] : be[o - 4];
#pragma unroll
            for (int w = 0; w < 8; ++w) s += PART[(w * 16 + row) * 48 + o];
            LOG[row * 40 + o] = s;
        }
        __syncthreads();
        if (tid < 16 && tile * 16 + tid < per) {
            const float* lg = LOG + tid * 40;
            float g0 = lg[0]; int gs = 0;
            for (int i = 1; i < 4; ++i) if (lg[i] > g0) { g0 = lg[i]; gs = i; }
            float den = 0.f; for (int i = 0; i < 4; ++i) den += __expf(lg[i] - g0);
            const float gwgt = 1.0f / den;
            const float* el = lg + 4 + gs * 8;
            int i0 = 0; float v0 = el[0];
            for (int i = 1; i < 8; ++i) if (el[i] > v0) { v0 = el[i]; i0 = i; }
            int i1 = -1; float v1 = -3.0e38f;
            for (int i = 0; i < 8; ++i) if (i != i0 && el[i] > v1) { v1 = el[i]; i1 = i; }
            const float e1 = __expf(v1 - v0);
            const int ri = tile * 16 + tid;
            PKE[ri * 2] = gs * 8 + i0; PKW[ri * 2] = gwgt / (1.f + e1);
            PKE[ri * 2 + 1] = gs * 8 + i1; PKW[ri * 2 + 1] = gwgt * e1 / (1.f + e1);
        }
        __syncthreads();
    }
    unsigned* cnt = (unsigned*)(a.ws + WS_CNT) + l * 64;
    int* stok = (int*)(a.ws + WS_STOK);
    unsigned* tinfo = (unsigned*)(a.ws + WS_TINFO);
    unsigned* hist = (unsigned*)(PKW + 272);
    static_assert(NEXP <= 64, "slot histogram");
    if (tid < 64) hist[tid] = 0u;
    __syncthreads();
    const bool has = tid < per * 2;
    int e = 0; unsigned lr = 0u;
    if (has) { e = PKE[tid]; lr = atomicAdd(&hist[e], 1u); }
    __syncthreads();
    if (tid < NEXP) { const unsigned c = hist[tid]; hist[tid] = c ? atomicAdd(&cnt[tid], c) : 0u; }
    __syncthreads();
    if (has) {
        const int r = rbase + (tid >> 1);
        const unsigned p = hist[e] + lr;
        stok[(size_t)e * MOE_CAP + p] = r;
        tinfo[(size_t)r * 4 + (tid & 1) * 2 + 0] = ((unsigned)e << 24) | p;
        tinfo[(size_t)r * 4 + (tid & 1) * 2 + 1] = __float_as_uint(PKW[tid]);
    }
}

#define XCD_UNITS(w, total) for (int _cs = ((total) + 7) >> 3, _i = (int)(blockIdx.x >> 3), w = (int)(blockIdx.x & 7) * _cs + _i; _i < _cs; _i += 32, w += 32) if (w < (total))
constexpr int G_ASZ = 256 * 128;
template <int NT> struct GemmCfg { static constexpr int BN = 32 * NT, BSZ = BN * 128, STAGE = G_ASZ + BSZ, NLD = 4 + NT / 2; };
constexpr int G_LDS = 3 * GemmCfg<4>::STAGE;

template <int NT, class AF, class BF>
__device__ __forceinline__ void gemm_pipe(f32x4 (&acc)[4][NT], AF aofn, BF bofn, int K, unsigned char* lds, const unsigned char* wsbase) {
    constexpr int STAGE = GemmCfg<NT>::STAGE;
    const int tid = threadIdx.x, lane = tid & 63, wid = tid >> 6, wr = wid >> 1, wc = wid & 1, fr = lane & 15, fq = lane >> 4;
    const int nt = K / 64;
    const int srow = tid >> 3; const unsigned schunk = ((tid & 7) ^ (srow & 7)) * 16;
    const unsigned ap0 = aofn(srow) + schunk, ap1 = aofn(srow + 64) + schunk, ap2 = aofn(srow + 128) + schunk, ap3 = aofn(srow + 192) + schunk;
    const unsigned bp0 = bofn(srow) + schunk, bp1 = (NT == 4) ? bofn(srow + 64) + schunk : bp0;
    auto stage = [&](int t, int buf) {
        unsigned char* base = lds + buf * STAGE + tid * 16;
        const unsigned char* gb = wsbase + (size_t)t * 128;
        __builtin_amdgcn_global_load_lds((const unsigned*)(gb + ap0), LDSP(base), 16, 0, 0);
        __builtin_amdgcn_global_load_lds((const unsigned*)(gb + ap1), LDSP(base + 8192), 16, 0, 0);
        __builtin_amdgcn_global_load_lds((const unsigned*)(gb + ap2), LDSP(base + 16384), 16, 0, 0);
        __builtin_amdgcn_global_load_lds((const unsigned*)(gb + ap3), LDSP(base + 24576), 16, 0, 0);
        __builtin_amdgcn_global_load_lds((const unsigned*)(gb + bp0), LDSP(base + G_ASZ), 16, 0, 0);
        if (NT == 4) __builtin_amdgcn_global_load_lds((const unsigned*)(gb + bp1), LDSP(base + G_ASZ + 8192), 16, 0, 0);
    };
    stage(0, 0);
    if (nt > 1) stage(1, 1);
    const int aoff = (wr * 64 + fr) * 128, boff = G_ASZ + (wc * 16 * NT + fr) * 128, sw = fr & 7;
    int buf = 0;
    for (int t = 0; t < nt; ++t) {
        if (t + 1 < nt) { if (NT == 4) asm volatile("s_waitcnt vmcnt(6)" ::: "memory"); else asm volatile("s_waitcnt vmcnt(5)" ::: "memory"); }
        else asm volatile("s_waitcnt vmcnt(0)" ::: "memory");
        __builtin_amdgcn_s_barrier();
        asm volatile("" ::: "memory");
        if (t + 2 < nt) { int nb = buf + 2; if (nb >= 3) nb -= 3; stage(t + 2, nb); }
        const unsigned char* base = lds + buf * STAGE;
#pragma unroll
        for (int kh = 0; kh < 2; ++kh) {
            bf16x8 af[4], bfr[NT];
            const int ch = ((kh * 4 + fq) ^ sw) * 16;
#pragma unroll
            for (int m = 0; m < 4; ++m) af[m] = *(const bf16x8*)(base + aoff + m * 2048 + ch);
#pragma unroll
            for (int n = 0; n < NT; ++n) bfr[n] = *(const bf16x8*)(base + boff + n * 2048 + ch);
            __builtin_amdgcn_s_setprio(1);
#pragma unroll
            for (int m = 0; m < 4; ++m)
#pragma unroll
                for (int n = 0; n < NT; ++n) acc[m][n] = __builtin_amdgcn_mfma_f32_16x16x32_bf16(bfr[n], af[m], acc[m][n], 0, 0, 0);
            __builtin_amdgcn_s_setprio(0);
        }
        ++buf; if (buf == 3) buf = 0;
    }
    __builtin_amdgcn_s_barrier();
    asm volatile("" ::: "memory");
}

template <int NT, class AF1, class BF1, class AF2, class BF2, class SW>
__device__ __forceinline__ void gemm_pipe_seg(f32x4 (&acc)[4][NT], AF1 a1, BF1 b1, int K1, AF2 a2, BF2 b2, int K2, SW on_switch, unsigned char* lds, const unsigned char* wsbase, int mode = 0) {
    constexpr int STAGE = GemmCfg<NT>::STAGE;
    const int tid = threadIdx.x, lane = tid & 63, wid = tid >> 6, wr = wid >> 1, wc = wid & 1, fr = lane & 15, fq = lane >> 4;
    const int nt1 = K1 / 64, nt = nt1 + K2 / 64;
    const int srow = tid >> 3; const unsigned schunk = ((tid & 7) ^ (srow & 7)) * 16;
    const unsigned p1[6] = {a1(srow) + schunk, a1(srow + 64) + schunk, a1(srow + 128) + schunk, a1(srow + 192) + schunk, b1(srow) + schunk, (NT == 4) ? b1(srow + 64) + schunk : 0u};
    const unsigned p2[6] = {a2(srow) + schunk, a2(srow + 64) + schunk, a2(srow + 128) + schunk, a2(srow + 192) + schunk, b2(srow) + schunk, (NT == 4) ? b2(srow + 64) + schunk : 0u};
    auto stage = [&](int t, int buf) {
        unsigned char* base = lds + buf * STAGE + tid * 16;
        const bool s1 = t < nt1;
        const unsigned char* gb = wsbase + (size_t)(s1 ? t : t - nt1) * 128;
        __builtin_amdgcn_global_load_lds((const unsigned*)(gb + (s1 ? p1[0] : p2[0])), LDSP(base), 16, 0, 0);
        __builtin_amdgcn_global_load_lds((const unsigned*)(gb + (s1 ? p1[1] : p2[1])), LDSP(base + 8192), 16, 0, 0);
        __builtin_amdgcn_global_load_lds((const unsigned*)(gb + (s1 ? p1[2] : p2[2])), LDSP(base + 16384), 16, 0, 0);
        __builtin_amdgcn_global_load_lds((const unsigned*)(gb + (s1 ? p1[3] : p2[3])), LDSP(base + 24576), 16, 0, 0);
        __builtin_amdgcn_global_load_lds((const unsigned*)(gb + (s1 ? p1[4] : p2[4])), LDSP(base + G_ASZ), 16, 0, 0);
        if (NT == 4) __builtin_amdgcn_global_load_lds((const unsigned*)(gb + (s1 ? p1[5] : p2[5])), LDSP(base + G_ASZ + 8192), 16, 0, 0);
    };
    if (mode != 2) { stage(0, 0); stage(1, 1); }
    if (mode == 1) return;
    const int aoff = (wr * 64 + fr) * 128, boff = G_ASZ + (wc * 16 * NT + fr) * 128, sw = fr & 7;
    int buf = 0;
    for (int t = 0; t < nt; ++t) {
        if (t + 1 < nt) { if (NT == 4) asm volatile("s_waitcnt vmcnt(6)" ::: "memory"); else asm volatile("s_waitcnt vmcnt(5)" ::: "memory"); } else asm volatile("s_waitcnt vmcnt(0)" ::: "memory");
        __builtin_amdgcn_s_barrier();
        asm volatile("" ::: "memory");
        if (t + 2 < nt) { int nb = buf + 2; if (nb >= 3) nb -= 3; stage(t + 2, nb); }
        const unsigned char* base = lds + buf * STAGE;
#pragma unroll
        for (int kh = 0; kh < 2; ++kh) {
            bf16x8 af[4], bfr[NT];
            const int ch = ((kh * 4 + fq) ^ sw) * 16;
#pragma unroll
            for (int m = 0; m < 4; ++m) af[m] = *(const bf16x8*)(base + aoff + m * 2048 + ch);
#pragma unroll
            for (int n = 0; n < NT; ++n) bfr[n] = *(const bf16x8*)(base + boff + n * 2048 + ch);
            __builtin_amdgcn_s_setprio(1);
#pragma unroll
            for (int m = 0; m < 4; ++m)
#pragma unroll
                for (int n = 0; n < NT; ++n) acc[m][n] = __builtin_amdgcn_mfma_f32_16x16x32_bf16(bfr[n], af[m], acc[m][n], 0, 0, 0);
            __builtin_amdgcn_s_setprio(0);
        }
        if (t == nt1 - 1) on_switch(acc);
        ++buf; if (buf == 3) buf = 0;
    }
    __builtin_amdgcn_s_barrier();
    asm volatile("" ::: "memory");
}

namespace g8 {
constexpr int BK = 64, HALF = 128, HTB = HALF * BK * 2;
__device__ __forceinline__ int lds_byte(int r, int c) { const int st = (r >> 4) * 2 + (c >> 5), rr = r & 15, cc = c & 31, ob = rr * 64 + cc * 2; return st * 1024 + (ob ^ (((ob >> 9) & 1) << 5)); }
__device__ __forceinline__ void stage_rc(int b, int& R, int& C) { const int st = b / 1024, sb = b % 1024, swz = sb ^ (((sb >> 9) & 1) << 5); R = (st >> 1) * 16 + swz / 64; C = (st & 1) * 32 + (swz % 64) / 2; }
}
#define G8_WAIT_V(n) asm volatile("s_waitcnt vmcnt(" #n ")" ::: "memory")
#define G8_WAIT_L(n) asm volatile("s_waitcnt lgkmcnt(" #n ")" ::: "memory")
#define G8_BAR __builtin_amdgcn_s_barrier()
#define G8_SCHED __builtin_amdgcn_sched_barrier(0)

template <bool ASTORE, class AF, class BF>
__device__ __forceinline__ void gemm8p(f32x4 (&acc)[2][2][4][2], AF aoff, BF boff, int K, unsigned char* lds, const unsigned char* wsbase) {
    using namespace g8;
    unsigned sa[2][2];
    if (ASTORE) {
#pragma unroll
        for (int i = 0; i < 2; ++i) { int R, C; stage_rc(threadIdx.x * 16 + i * 8192, R, C);
#pragma unroll
            for (int h = 0; h < 2; ++h) sa[h][i] = aoff(h * HALF + R) + C * 2; }
    }
    auto srcoff = [&](int T, int op, int h, int i) -> unsigned {
        int R, C; stage_rc(T * 16 + i * 8192, R, C);
        if (op == 0) return ASTORE ? sa[h][i] : (aoff(h * HALF + R) + C * 2);
        return boff(h * HALF + R) + C * 2;
    };
#define G8_SA(b, h) (lds + ((b) * 2 + (h)) * HTB)
#define G8_SB(b, h) (lds + (4 + (b) * 2 + (h)) * HTB)
#define G8_STAGE_X(T, P, OP, H, kt) do { _Pragma("unroll") for (int _i = 0; _i < 2; ++_i) \
        __builtin_amdgcn_global_load_lds((const unsigned*)(wsbase + srcoff(T, OP, H, _i) + (size_t)(kt) * (BK * 2)), LDSP((P) + (T) * 16 + _i * 8192), 16, 0, 0); } while (0)
#define G8_STAGE(P, OP, H, kt) G8_STAGE_X(tq, P, OP, H, kt)
#define G8_LDA(dst, b, h) _Pragma("unroll") for (int m = 0; m < 4; ++m) _Pragma("unroll") for (int k = 0; k < 2; ++k) \
        dst[m][k] = *(const bf16x8*)(G8_SA(b, h) + lds_byte(wr * 64 + m * 16 + fr, k * 32 + fq * 8))
#define G8_LDB(dst, b, h) _Pragma("unroll") for (int n = 0; n < 2; ++n) _Pragma("unroll") for (int k = 0; k < 2; ++k) \
        dst[n][k] = *(const bf16x8*)(G8_SB(b, h) + lds_byte(wc * 32 + n * 16 + fr, k * 32 + fq * 8))
#define G8_MMA(ai, bj, At, Bt) do { __builtin_amdgcn_s_setprio(1); \
        _Pragma("unroll") for (int m = 0; m < 4; ++m) _Pragma("unroll") for (int n = 0; n < 2; ++n) _Pragma("unroll") for (int k = 0; k < 2; ++k) \
            acc[ai][bj][m][n] = __builtin_amdgcn_mfma_f32_16x16x32_bf16(Bt[n][k], At[m][k], acc[ai][bj][m][n], 0, 0, 0); \
        __builtin_amdgcn_s_setprio(0); } while (0)
    int wid = threadIdx.x >> 6, lane = threadIdx.x & 63, wr = wid >> 2, wc = wid & 3, fr = lane & 15, fq = lane >> 4;
    bf16x8 At[4][2], B0[2][2], B1[2][2];
    const int nt = K / BK;
    int tq = threadIdx.x; asm volatile("" : "+v"(tq));
    G8_STAGE(G8_SB(0, 0), 1, 0, 0); G8_STAGE(G8_SA(0, 0), 0, 0, 0);
    G8_STAGE(G8_SB(0, 1), 1, 1, 0); G8_STAGE(G8_SA(0, 1), 0, 1, 0);
    if (wr == 1) G8_BAR;
    G8_WAIT_V(4); G8_BAR;
    G8_STAGE(G8_SB(1, 0), 1, 0, 1); G8_STAGE(G8_SA(1, 0), 0, 0, 1); G8_STAGE(G8_SB(1, 1), 1, 1, 1);
    G8_WAIT_V(6); G8_BAR;
    for (int t = 0; t < nt - 2; t += 2) {
        tq = threadIdx.x; asm volatile("" : "+v"(tq));
        G8_LDB(B0, 0, 0); G8_SCHED; G8_LDA(At, 0, 0); G8_STAGE(G8_SA(1, 1), 0, 1, t + 1);
        G8_WAIT_L(8); G8_BAR; G8_WAIT_L(0); G8_MMA(0, 0, At, B0); G8_BAR; G8_SCHED;
        G8_LDB(B1, 0, 1); G8_STAGE(G8_SB(0, 0), 1, 0, t + 2);
        G8_BAR; G8_WAIT_L(0); G8_MMA(0, 1, At, B1); G8_BAR;
        G8_LDA(At, 0, 1); G8_STAGE(G8_SA(0, 0), 0, 0, t + 2);
        G8_BAR; G8_WAIT_L(0); G8_MMA(1, 0, At, B0); G8_BAR; G8_SCHED;
        G8_STAGE(G8_SB(0, 1), 1, 1, t + 2);
        G8_WAIT_V(6); G8_BAR; G8_MMA(1, 1, At, B1); G8_BAR;
        G8_LDB(B0, 1, 0); G8_SCHED; G8_LDA(At, 1, 0); G8_STAGE(G8_SA(0, 1), 0, 1, t + 2);
        G8_WAIT_L(8); G8_BAR; G8_WAIT_L(0); G8_MMA(0, 0, At, B0); G8_BAR; G8_SCHED;
        G8_LDB(B1, 1, 1); G8_STAGE(G8_SB(1, 0), 1, 0, t + 3);
        G8_BAR; G8_WAIT_L(0); G8_MMA(0, 1, At, B1); G8_BAR;
        G8_LDA(At, 1, 1); G8_STAGE(G8_SA(1, 0), 0, 0, t + 3);
        G8_BAR; G8_WAIT_L(0); G8_MMA(1, 0, At, B0); G8_BAR; G8_SCHED;
        G8_STAGE(G8_SB(1, 1), 1, 1, t + 3);
        G8_WAIT_V(6); G8_BAR; G8_MMA(1, 1, At, B1); G8_BAR;
    }
    int tz = threadIdx.x; asm volatile("" : "+v"(tz)); wid = tz >> 6; lane = tz & 63; wr = wid >> 2; wc = wid & 3; fr = lane & 15; fq = lane >> 4;
    { G8_LDB(B0, 0, 0); G8_WAIT_V(0); G8_LDA(At, 0, 0); G8_STAGE_X(tz, G8_SA(1, 1), 0, 1, nt - 1);
      G8_BAR; G8_WAIT_L(0); G8_MMA(0, 0, At, B0); G8_BAR;
      G8_LDB(B1, 0, 1); G8_BAR; G8_WAIT_L(0); G8_MMA(0, 1, At, B1); G8_BAR;
      G8_LDA(At, 0, 1); G8_WAIT_V(4); G8_BAR; G8_WAIT_L(0); G8_MMA(1, 0, At, B0); G8_MMA(1, 1, At, B1); G8_BAR; }
    { G8_LDB(B0, 1, 0); G8_LDA(At, 1, 0); G8_WAIT_V(2); G8_BAR; G8_WAIT_L(0); G8_MMA(0, 0, At, B0); G8_BAR;
      G8_LDB(B1, 1, 1); G8_WAIT_V(0); G8_BAR; G8_WAIT_L(0); G8_MMA(0, 1, At, B1); G8_BAR;
      G8_LDA(At, 1, 1); G8_BAR; G8_WAIT_L(0); G8_MMA(1, 0, At, B0); G8_MMA(1, 1, At, B1); G8_BAR; }
    if (wr == 0) G8_BAR;
    __syncthreads();
#undef G8_SA
#undef G8_SB
#undef G8_STAGE_X
#undef G8_STAGE
#undef G8_LDA
#undef G8_LDB
#undef G8_MMA
}

template <class UF, class EF>
__device__ __forceinline__ void gemm8s(UF unit_fn, unsigned pitchA, unsigned pitchB, int K, EF epi, unsigned char* lds, const unsigned char* wsbase) {
    using namespace g8;
    const int tid = threadIdx.x, wid = __builtin_amdgcn_readfirstlane(tid >> 6), lane = tid & 63, wr = wid >> 2, wc = wid & 3, fr = lane & 15, fq = lane >> 4;
    const int nt = K / BK;
    unsigned voffA[2], voffB[2];
#pragma unroll
    for (int i = 0; i < 2; ++i) { int R, C; stage_rc(tid * 16 + i * 8192, R, C); voffA[i] = (unsigned)R * pitchA + (unsigned)C * 2u;
        const int p = R & 31, Rp = (R & ~31) | (((p & 15) >> 2) * 8 + (p >> 4) * 4 + (p & 3)); voffB[i] = (unsigned)Rp * pitchB + (unsigned)C * 2u; }
    const size_t kstep = (size_t)(BK * 2);
    const size_t hstepA = (size_t)HALF * pitchA, hstepB = (size_t)HALF * pitchB;
    const unsigned ldsw = (unsigned)wid * 1024u;
    const int aoff = lds_byte(wr * 64 + fr, fq * 8), boff = lds_byte(wc * 32 + fr, fq * 8);
#define S8_SA(b, h) (((b) * 2 + (h)) * HTB)
#define S8_SB(b, h) ((4 + (b) * 2 + (h)) * HTB)
#define S8_STAGE(bufoff, gbase, voff) do { _Pragma("unroll") for (int _i = 0; _i < 2; ++_i) \
        __builtin_amdgcn_global_load_lds((const unsigned*)((const unsigned char*)(gbase) + (voff)[_i]), LDSP(lds + (bufoff) + ldsw + _i * 8192), 16, 0, 0); } while (0)
#define S8_LDA(dst, b, h) do { _Pragma("unroll") for (int m = 0; m < 4; ++m) _Pragma("unroll") for (int k = 0; k < 2; ++k) dst[m][k] = *(const bf16x8*)(lds + S8_SA(b, h) + aoff + m * 2048 + k * 1024); } while (0)
#define S8_LDB(dst, b, h) do { _Pragma("unroll") for (int n = 0; n < 2; ++n) _Pragma("unroll") for (int k = 0; k < 2; ++k) dst[n][k] = *(const bf16x8*)(lds + S8_SB(b, h) + boff + n * 2048 + k * 1024); } while (0)
#define S8_MMA(ai, bj, At, Bt) do { __builtin_amdgcn_s_setprio(1); _Pragma("unroll") for (int m = 0; m < 4; ++m) _Pragma("unroll") for (int n = 0; n < 2; ++n) _Pragma("unroll") for (int k = 0; k < 2; ++k) \
        acc[ai][bj][m][n] = __builtin_amdgcn_mfma_f32_16x16x32_bf16(Bt[n][k], At[m][k], acc[ai][bj][m][n], 0, 0, 0); __builtin_amdgcn_s_setprio(0); } while (0)
    unsigned caB, cbB, naB, nbB; int ctag, ntag, ui = 0;
    if (!unit_fn(0, caB, cbB, ctag)) return;
    f32x4 acc[2][2][4][2];
#pragma unroll
    for (int a_ = 0; a_ < 2; ++a_)
#pragma unroll
        for (int b_ = 0; b_ < 2; ++b_)
#pragma unroll
            for (int m = 0; m < 4; ++m)
#pragma unroll
                for (int n = 0; n < 2; ++n) acc[a_][b_][m][n] = (f32x4){0.f, 0.f, 0.f, 0.f};
    bf16x8 At[4][2], B0[2][2], B1[2][2];
    const unsigned char* cA = wsbase + caB; const unsigned char* cB = wsbase + cbB;
    S8_STAGE(S8_SB(0, 0), cB, voffB); S8_STAGE(S8_SA(0, 0), cA, voffA); S8_STAGE(S8_SB(0, 1), cB + hstepB, voffB); S8_STAGE(S8_SA(0, 1), cA + hstepA, voffA);
    if (wr == 1) G8_BAR;
    G8_WAIT_V(4); G8_BAR;
    S8_STAGE(S8_SB(1, 0), cB + kstep, voffB); S8_STAGE(S8_SA(1, 0), cA + kstep, voffA); S8_STAGE(S8_SB(1, 1), cB + hstepB + kstep, voffB);
    G8_WAIT_V(6); G8_BAR;
    for (;;) {
        const bool has_next = unit_fn(ui + 1, naB, nbB, ntag);
        const unsigned char* nA = has_next ? wsbase + naB : cA; const unsigned char* nB = has_next ? wsbase + nbB : cB;
        for (int t = 0; t < nt; t += 2) {
            const bool last = (t == nt - 2);
            const unsigned char* a1 = cA + (size_t)(t + 1) * kstep;
            const unsigned char* a2 = last ? nA : cA + (size_t)(t + 2) * kstep; const unsigned char* b2 = last ? nB : cB + (size_t)(t + 2) * kstep;
            const unsigned char* a3 = a2 + kstep; const unsigned char* b3 = b2 + kstep;
            S8_LDB(B0, 0, 0); G8_SCHED; S8_LDA(At, 0, 0); S8_STAGE(S8_SA(1, 1), a1 + hstepA, voffA);
            G8_WAIT_L(8); G8_BAR; G8_WAIT_L(0); S8_MMA(0, 0, At, B0); G8_BAR; G8_SCHED;
            S8_LDB(B1, 0, 1); S8_STAGE(S8_SB(0, 0), b2, voffB);
            G8_BAR; G8_WAIT_L(0); S8_MMA(0, 1, At, B1); G8_BAR;
            S8_LDA(At, 0, 1); S8_STAGE(S8_SA(0, 0), a2, voffA);
            G8_BAR; G8_WAIT_L(0); S8_MMA(1, 0, At, B0); G8_BAR; G8_SCHED;
            S8_STAGE(S8_SB(0, 1), b2 + hstepB, voffB);
            G8_WAIT_V(6); G8_BAR; S8_MMA(1, 1, At, B1); G8_BAR;
            S8_LDB(B0, 1, 0); G8_SCHED; S8_LDA(At, 1, 0); S8_STAGE(S8_SA(0, 1), a2 + hstepA, voffA);
            G8_WAIT_L(8); G8_BAR; G8_WAIT_L(0); S8_MMA(0, 0, At, B0); G8_BAR; G8_SCHED;
            S8_LDB(B1, 1, 1); S8_STAGE(S8_SB(1, 0), b3, voffB);
            G8_BAR; G8_WAIT_L(0); S8_MMA(0, 1, At, B1); G8_BAR;
            S8_LDA(At, 1, 1); S8_STAGE(S8_SA(1, 0), a3, voffA);
            G8_BAR; G8_WAIT_L(0); S8_MMA(1, 0, At, B0); G8_BAR; G8_SCHED;
            S8_STAGE(S8_SB(1, 1), b3 + hstepB, voffB);
            G8_WAIT_V(6); G8_BAR; S8_MMA(1, 1, At, B1); G8_BAR;
        }
        epi(acc, ctag);
        if (!has_next) break;
#pragma unroll
        for (int a_ = 0; a_ < 2; ++a_)
#pragma unroll
            for (int b_ = 0; b_ < 2; ++b_)
#pragma unroll
                for (int m = 0; m < 4; ++m)
#pragma unroll
                    for (int n = 0; n < 2; ++n) acc[a_][b_][m][n] = (f32x4){0.f, 0.f, 0.f, 0.f};
        cA = nA; cB = nB; ctag = ntag; ++ui;
    }
    G8_WAIT_V(0);
    if (wr == 0) G8_BAR;
    G8_BAR;
#undef S8_SA
#undef S8_SB
#undef S8_STAGE
#undef S8_LDA
#undef S8_LDB
#undef S8_MMA
}

__device__ __forceinline__ void phase_moe1(const Args& a, int l, unsigned char* lds) {
    int* s_start = (int*)(lds + G_LDS); int* s_cnt = s_start + 64; int* s_tile = s_cnt + 64;
    moe_offsets(a, l, s_start, s_cnt);
    if (threadIdx.x == 0) { int s = 0; for (int e = 0; e < 32; ++e) { s_tile[e] = s; s += (s_cnt[e] + 255) >> 8; } s_tile[32] = s; }
    __syncthreads();
    const int ntiles = s_tile[32];
    const bf16_t* H = (const bf16_t*)(a.ws + WS_H);
    const bf16_t* WG = (const bf16_t*)(a.ws + WS_BIG + BIG_WEG);
    bf16_t* HID = (bf16_t*)(a.ws + WS_BIG + BIG_HID);
    const int* stok = (const int*)(a.ws + WS_STOK);
    XCD_UNITS(w, ntiles * 4) {
        const int rt_g = w >> 2, ntile = w & 3;
        int e = 0; while (s_tile[e + 1] <= rt_g) ++e;
        const int rt = rt_g - s_tile[e], cnt = s_cnt[e], n0 = ntile * 128;
        f32x4 acc[2][2][4][2];
#pragma unroll
        for (int i0 = 0; i0 < 2; ++i0)
#pragma unroll
            for (int i1 = 0; i1 < 2; ++i1)
#pragma unroll
                for (int m = 0; m < 4; ++m)
#pragma unroll
                    for (int n = 0; n < 2; ++n) acc[i0][i1][m][n] = (f32x4){0.f, 0.f, 0.f, 0.f};
        gemm8p<true>(acc, [=](int r) -> unsigned { int p = rt * 256 + r; if (p >= cnt) p = 0; return (unsigned)(WS_H + (size_t)stok[(size_t)e * MOE_CAP + p] * 2048); },
               [=](int rho) -> unsigned { const int p5 = rho & 31, rp = (rho & 96) | (((p5 & 15) >> 2) * 8 + (p5 >> 4) * 4 + (p5 & 3));
                   return (unsigned)(WS_BIG + BIG_WEG + ((size_t)(rho >> 7) * ((size_t)NEXP * EH * 1024) + ((size_t)e * EH + n0 + rp) * 1024) * 2); }, 1024, lds, a.ws);
        int tid = threadIdx.x; asm volatile("" : "+v"(tid));
        const int lane = tid & 63, wid = tid >> 6, wr = wid >> 2, wc = wid & 3, fr = lane & 15, fq = lane >> 4;
#pragma unroll
        for (int ai = 0; ai < 2; ++ai)
#pragma unroll
            for (int m = 0; m < 4; ++m) {
                const int p = rt * 256 + ai * 128 + wr * 64 + m * 16 + fr;
                if (p < cnt) {
                    bf16_t* orow = HID + (size_t)(s_start[e] + p) * EH + n0 + wc * 32 + fq * 8;
                    uint4 o;
                    { const f32x4 gt = acc[ai][0][m][0], up = acc[ai][1][m][0]; o.x = pack2(siluf(gt[0]) * up[0], siluf(gt[1]) * up[1]); o.y = pack2(siluf(gt[2]) * up[2], siluf(gt[3]) * up[3]); }
                    { const f32x4 gt = acc[ai][0][m][1], up = acc[ai][1][m][1]; o.z = pack2(siluf(gt[0]) * up[0], siluf(gt[1]) * up[1]); o.w = pack2(siluf(gt[2]) * up[2], siluf(gt[3]) * up[3]); }
                    *(uint4*)orow = o;
                }
            }
    }
}

__device__ __forceinline__ void phase_moe2(const Args& a, int l, unsigned char* lds) {
    int* s_start = (int*)(lds + G_LDS); int* s_cnt = s_start + 64; int* s_tile = s_cnt + 64;
    moe_offsets(a, l, s_start, s_cnt);
    if (threadIdx.x == 0) { int s = 0; for (int e = 0; e < 32; ++e) { s_tile[e] = s; s += (s_cnt[e] + 255) >> 8; } s_tile[32] = s; }
    __syncthreads();
    const int TOTAL = s_tile[32] * 4, CS = (TOTAL + 7) >> 3;
    bf16_t* YD = (bf16_t*)(a.ws + WS_BIG + BIG_YD);
    const int xcd = blockIdx.x & 7, j0 = blockIdx.x >> 3;
    auto unit_fn = [=](int i, unsigned& aB, unsigned& bB, int& tag) -> bool {
        const int k = j0 + 32 * i; if (k >= CS) return false;
        const int w = xcd * CS + k; if (w >= TOTAL) return false;
        const int rt_g = w >> 2, ntile = w & 3;
        int e = 0; while (s_tile[e + 1] <= rt_g) ++e;
        const int rt = rt_g - s_tile[e];
        aB = (unsigned)(WS_BIG + BIG_HID + (size_t)(s_start[e] + rt * 256) * (EH * 2)); bB = (unsigned)(WS_BIG + BIG_WED + ((size_t)e * 1024 + ntile * 256) * (EH * 2));
        tag = (e << 16) | (rt << 2) | ntile; return true;
    };
    auto epi = [=](const f32x4 (&acc)[2][2][4][2], int tag) {
        const int e = tag >> 16, rt = (tag >> 2) & 0x3FFF, n0 = (tag & 3) * 256, cnt = s_cnt[e], st0 = s_start[e];
        int tid = threadIdx.x; asm volatile("" : "+v"(tid));
        const int lane = tid & 63, wid = tid >> 6, wr = wid >> 2, wc = wid & 3, fr = lane & 15, fq = lane >> 4;
#pragma unroll
        for (int ai = 0; ai < 2; ++ai)
#pragma unroll
            for (int m = 0; m < 4; ++m) {
                const int p = rt * 256 + ai * 128 + wr * 64 + m * 16 + fr;
                if (p < cnt) {
                    bf16_t* orow = YD + (size_t)(st0 + p) * 1024 + n0 + wc * 32 + fq * 8;
#pragma unroll
                    for (int bj = 0; bj < 2; ++bj) {
                        uint4 o; o.x = pack2(acc[ai][bj][m][0][0], acc[ai][bj][m][0][1]); o.y = pack2(acc[ai][bj][m][0][2], acc[ai][bj][m][0][3]);
                        o.z = pack2(acc[ai][bj][m][1][0], acc[ai][bj][m][1][1]); o.w = pack2(acc[ai][bj][m][1][2], acc[ai][bj][m][1][3]);
                        *(uint4*)(orow + bj * 128) = o;
                    }
                }
            }
    };
    gemm8s(unit_fn, (unsigned)(EH * 2), (unsigned)(EH * 2), EH, epi, lds, a.ws);
    __syncthreads();
}

__device__ __forceinline__ void phase_s5params(const Args& a, int l) {
    float2* abar = (float2*)(a.ws + WS_S5P);
    float2* bbar = abar + 2 * 16 * 64;
    for (int i = blockIdx.x * NTHREADS + threadIdx.x; i < 2 * 16 * 64 * 16; i += gridDim.x * NTHREADS) {
        const int c = i & 15, p = (i >> 4) & 63, g = (i >> 10) & 15, d = i >> 14;
        const float lre = a.in[27][((l * 2 + d) * 16 + g) * 64 + p], lim = a.in[28][((l * 2 + d) * 16 + g) * 64 + p];
        const float dt = __expf(a.in[29][(l * 2 + d) * 16 + g]);
        const float mag = __expf(lre * dt); float sn, cs; sincosf(lim * dt, &sn, &cs);
        const float are = mag * cs, aim = mag * sn;
        if (c == 0) abar[(d * 16 + g) * 64 + p] = make_float2(are, aim);
        { float2* PW = (float2*)(a.ws + WS_S5PW); const float fl = (float)c; const float mg = __expf(lre * dt * fl); float s2, c2; sincosf(lim * dt * fl, &s2, &c2); PW[((d * 16 + g) * 64 + p) * 17 + c] = make_float2(mg * c2, mg * s2);
          if (c == 0) { const float m16 = __expf(lre * dt * 16.f); sincosf(lim * dt * 16.f, &s2, &c2); PW[((d * 16 + g) * 64 + p) * 17 + 16] = make_float2(m16 * c2, m16 * s2); } }
        const float nre = are - 1.f, nim = aim, den = lre * lre + lim * lim;
        const float qre = (nre * lre + nim * lim) / den, qim = (nim * lre - nre * lim) / den;
        const float bre = a.in[30][((l * 16 + g) * 64 + p) * 16 + c], bim = a.in[31][((l * 16 + g) * 64 + p) * 16 + c];
        bbar[i] = make_float2(qre * bre - qim * bim, qre * bim + qim * bre);
    }
}

__device__ __forceinline__ void phase_g1(const Args& a, unsigned char* lds) {
    bf16_t* U = (bf16_t*)(a.ws + WS_BIG + BIG_U); bf16_t* AC = (bf16_t*)(a.ws + WS_BIG + T_AC);
    constexpr int TOTAL = (NLAT / 256) * 10, CS = TOTAL / 8;
    static_assert(TOTAL == 5 * 256 && UW == 2592 && NCTX == 2048, "G1 unit map");
    const int xcd = blockIdx.x & 7, j0 = blockIdx.x >> 3;
    auto unit_fn = [=](int i, unsigned& aB, unsigned& bB, int& tag) -> bool {
        const int k = j0 + 32 * i; if (k >= CS) return false;
        const int w = xcd * CS + k;
        const int mt = w / 10, ntl = w % 10;
        aB = (unsigned)(WS_H + (size_t)mt * 256 * 2048); bB = (unsigned)(WS_WIN + (size_t)ntl * 256 * 2048); tag = w; return true;
    };
    auto store_u = [=](int row, int col, uint2 o) {
        if (col >= U_S5 && col < U_S5 + 256) {
            const int cc = col - U_S5, g = cc >> 4, c = cc & 15;
            const int b = (row < NLAT) ? (row >> 12) : ((row - NLAT) >> 8), pos = (row < NLAT) ? (256 + (row & 4095)) : ((row - NLAT) & 255);
            *(uint2*)(AC + (((size_t)g * 2176 + b * 272 + (pos >> 4)) * 512 + (pos & 15) * 16 + c)) = o;
        } else *(uint2*)(U + (size_t)row * UW + col) = o;
    };
    auto store_u8 = [=](int row, int col, uint4 o) {
        if (col >= U_S5 && col < U_S5 + 256) {
            const int cc = col - U_S5, g = cc >> 4, c = cc & 15;
            const int b = (row < NLAT) ? (row >> 12) : ((row - NLAT) >> 8), pos = (row < NLAT) ? (256 + (row & 4095)) : ((row - NLAT) & 255);
            *(uint4*)(AC + (((size_t)g * 2176 + b * 272 + (pos >> 4)) * 512 + (pos & 15) * 16 + c)) = o;
        } else *(uint4*)(U + (size_t)row * UW + col) = o;
    };
    auto epi = [=](const f32x4 (&acc)[2][2][4][2], int w) {
        const int r0 = (w / 10) * 256, n0 = (w % 10) * 256;
        int tid = threadIdx.x; asm volatile("" : "+v"(tid));
        const int lane = tid & 63, wid = tid >> 6, wr = wid >> 2, wc = wid & 3, fr = lane & 15, fq = lane >> 4;
#pragma unroll
        for (int ai = 0; ai < 2; ++ai)
#pragma unroll
            for (int m = 0; m < 4; ++m) {
                const int row = r0 + ai * 128 + wr * 64 + m * 16 + fr;
#pragma unroll
                for (int bj = 0; bj < 2; ++bj) {
                    const int col = n0 + bj * 128 + wc * 32 + fq * 8;
                    uint4 o; o.x = pack2(acc[ai][bj][m][0][0], acc[ai][bj][m][0][1]); o.y = pack2(acc[ai][bj][m][0][2], acc[ai][bj][m][0][3]);
                    o.z = pack2(acc[ai][bj][m][1][0], acc[ai][bj][m][1][1]); o.w = pack2(acc[ai][bj][m][1][2], acc[ai][bj][m][1][3]);
                    store_u8(row, col, o);
                }
            }
    };
    const bool tail_first = ((blockIdx.x >> 3) & 1) != 0;
    auto tail_fn = [&]() {
    const int bid = blockIdx.x;
    if (bid < 160) {
        const int r0 = NLAT + (bid / 20) * 256, n0 = (bid % 20) * 128;
        f32x4 acc[4][4];
#pragma unroll
        for (int m = 0; m < 4; ++m)
#pragma unroll
            for (int n = 0; n < 4; ++n) acc[m][n] = (f32x4){0.f, 0.f, 0.f, 0.f};
        gemm_pipe<4>(acc, [=](int r) -> unsigned { return (unsigned)(WS_H + (size_t)(r0 + r) * 2048); }, [=](int r) -> unsigned { return (unsigned)(WS_WIN + (size_t)(n0 + r) * 2048); }, 1024, lds, a.ws);
        int tid = threadIdx.x; asm volatile("" : "+v"(tid));
        const int lane = tid & 63, wid = tid >> 6, wr = wid >> 1, wc = wid & 1, fr = lane & 15, fq = lane >> 4;
#pragma unroll
        for (int m = 0; m < 4; ++m)
#pragma unroll
            for (int n = 0; n < 4; ++n) {
                uint2 o; o.x = pack2(acc[m][n][0], acc[m][n][1]); o.y = pack2(acc[m][n][2], acc[m][n][3]);
                store_u(r0 + wr * 64 + m * 16 + fr, n0 + wc * 64 + n * 16 + fq * 4, o);
            }
    } else {
#pragma unroll 1
        for (int p = bid - 160; p < NROW / 256; p += 96) {
            const int r0 = p * 256;
            f32x4 acc[4][2];
#pragma unroll
            for (int m = 0; m < 4; ++m)
#pragma unroll
                for (int n = 0; n < 2; ++n) acc[m][n] = (f32x4){0.f, 0.f, 0.f, 0.f};
            gemm_pipe<2>(acc, [=](int r) -> unsigned { return (unsigned)(WS_H + (size_t)(r0 + r) * 2048); }, [=](int r) -> unsigned { return (unsigned)(WS_WIN + (size_t)(2560 + r) * 2048); }, 1024, lds, a.ws);
            int tid = threadIdx.x; asm volatile("" : "+v"(tid));
            const int lane = tid & 63, wid = tid >> 6, wr = wid >> 1, wc = wid & 1, fr = lane & 15, fq = lane >> 4;
            if (wc == 0) {
#pragma unroll
                for (int m = 0; m < 4; ++m)
#pragma unroll
                    for (int n = 0; n < 2; ++n) {
                        uint2 o; o.x = pack2(acc[m][n][0], acc[m][n][1]); o.y = pack2(acc[m][n][2], acc[m][n][3]);
                        *(uint2*)(U + (size_t)(r0 + wr * 64 + m * 16 + fr) * UW + 2560 + n * 16 + fq * 4) = o;
                    }
            }
        }
    }
    };
    if (tail_first) { tail_fn(); __syncthreads(); }
    gemm8s(unit_fn, 2048u, 2048u, 1024, epi, lds, a.ws);
    __syncthreads();
    if (!tail_first) { tail_fn(); }
    __syncthreads();
}

__device__ __forceinline__ int prm32(int r) { const int p = r & 31; return (r & ~31) | (((p & 15) >> 2) * 8 + (p >> 4) * 4 + (p & 3)); }
template <int NT>
__device__ __forceinline__ void merge_tile(const Args& a, int r0, int n0, unsigned char* lds) {
    bf16_t* MG = (bf16_t*)(a.ws + WS_BIG + BIG_MRG);
    uint2 accm[4][NT];
#pragma unroll
    for (int m = 0; m < 4; ++m)
#pragma unroll
        for (int n = 0; n < NT; ++n) accm[m][n] = make_uint2(0u, 0u);
    auto seg = [&](int i, f32x4 (&ag)[4][NT], uint2 (&pp)[4][NT], int mode) {
        gemm_pipe_seg<NT>(ag,
            [=](int r) -> unsigned { return (unsigned)(WS_BIG + BIG_Y + ((size_t)(r0 + r) * 1024 + 256 * i) * 2); }, [=](int r) -> unsigned { return (unsigned)(WS_WBR + (size_t)(i * 1024 + n0 + prm32(r)) * 512); }, 256,
            [=](int r) -> unsigned { return (unsigned)(WS_H + (size_t)(r0 + r) * 2048); }, [=](int r) -> unsigned { return (unsigned)(WS_WIN + (size_t)(UW + i * 1024 + n0 + prm32(r)) * 2048); }, 1024,
            [&](f32x4 (&acc)[4][NT]) {
#pragma unroll
                for (int m = 0; m < 4; ++m)
#pragma unroll
                    for (int n = 0; n < NT; ++n) { pp[m][n].x = pack2(acc[m][n][0], acc[m][n][1]); pp[m][n].y = pack2(acc[m][n][2], acc[m][n][3]); acc[m][n] = (f32x4){0.f, 0.f, 0.f, 0.f}; }
            }, lds, a.ws, mode);
    };
    {
        f32x4 dz[4][NT]; uint2 dp[4][NT];
        seg(0, dz, dp, 1);
    }
#pragma unroll 1
    for (int i = 0; i < 4; ++i) {
        uint2 pp[4][NT];
        f32x4 ag[4][NT];
#pragma unroll
        for (int m = 0; m < 4; ++m)
#pragma unroll
            for (int n = 0; n < NT; ++n) ag[m][n] = (f32x4){0.f, 0.f, 0.f, 0.f};
        seg(i, ag, pp, 2);
        if (i + 1 < 4) { f32x4 dz[4][NT]; uint2 dp[4][NT]; seg(i + 1, dz, dp, 1); }
#pragma unroll
        for (int m = 0; m < 4; ++m)
#pragma unroll
            for (int n = 0; n < NT; ++n) {
                const float m0 = bf2f((bf16_t)(accm[m][n].x & 0xFFFF)) + sigmf(ag[m][n][0]) * bf2f((bf16_t)(pp[m][n].x & 0xFFFF)), m1 = bf2f((bf16_t)(accm[m][n].x >> 16)) + sigmf(ag[m][n][1]) * bf2f((bf16_t)(pp[m][n].x >> 16));
                const float m2 = bf2f((bf16_t)(accm[m][n].y & 0xFFFF)) + sigmf(ag[m][n][2]) * bf2f((bf16_t)(pp[m][n].y & 0xFFFF)), m3 = bf2f((bf16_t)(accm[m][n].y >> 16)) + sigmf(ag[m][n][3]) * bf2f((bf16_t)(pp[m][n].y >> 16));
                accm[m][n].x = pack2(m0, m1); accm[m][n].y = pack2(m2, m3);
            }
    }
    int tq = threadIdx.x; asm volatile("" : "+v"(tq));
    const int lane = tq & 63, wid = tq >> 6, wr = wid >> 1, wc = wid & 1, fr = lane & 15, fq = lane >> 4;
#pragma unroll
    for (int m = 0; m < 4; ++m) {
        const int row = r0 + wr * 64 + m * 16 + fr;
#pragma unroll
        for (int np = 0; np < NT / 2; ++np) {
            const int col = n0 + wc * 16 * NT + np * 32 + fq * 8;
            *(uint4*)(MG + (size_t)row * 1024 + col) = make_uint4(accm[m][2 * np].x, accm[m][2 * np].y, accm[m][2 * np + 1].x, accm[m][2 * np + 1].y);
        }
    }
}

__device__ __forceinline__ void phase_merge(const Args& a, int l, unsigned char* lds) {
    XCD_UNITS(w, (NLAT / 256) * 8) merge_tile<4>(a, (w >> 3) * 256, (w & 7) * 128, lds);
    if (l == 0) {
        for (int w = blockIdx.x; w < (NCTX / 256) * 16; w += gridDim.x) merge_tile<2>(a, NLAT + (w >> 4) * 256, (w & 15) * 64, lds);
    }
}

__device__ __forceinline__ void phase_g3(const Args& a, int l, unsigned char* lds) {
    const float* mods = (const float*)(a.ws + WS_MODS) + (size_t)l * 9 * 6144;
    float* XC = (float*)(a.ws + WS_XC);
    constexpr int TOTAL = (NLAT / 256) * 4, CS = TOTAL / 8;
    const int xcd = blockIdx.x & 7, j0 = blockIdx.x >> 3;
    auto unit_fn = [=](int i, unsigned& aB, unsigned& bB, int& tag) -> bool {
        const int k = j0 + 32 * i; if (k >= CS) return false;
        const int w = xcd * CS + k;
        aB = (unsigned)(WS_BIG + BIG_MRG + (size_t)(w >> 2) * 256 * 2048); bB = (unsigned)(WS_WOUT + (size_t)(w & 3) * 256 * 2048); tag = w; return true;
    };
    auto epi = [=](const f32x4 (&acc)[2][2][4][2], int w) {
        const int r0 = (w >> 2) * 256, n0 = (w & 3) * 256;
        int tid = threadIdx.x; asm volatile("" : "+v"(tid));
        const int lane = tid & 63, wid = tid >> 6, wr = wid >> 2, wc = wid & 3, fr = lane & 15, fq = lane >> 4;
        const bool odd = (fr & 1) != 0;
#pragma unroll
        for (int ai = 0; ai < 2; ++ai)
#pragma unroll
            for (int m = 0; m < 4; ++m) {
                const int rowA = r0 + ai * 128 + wr * 64 + m * 16 + (fr & ~1);
                const int b = rowA >> 12;
                const float* xo = ((l == 0) ? a.in[0] : a.out) + (size_t)rowA * 1024;
                float* xn = a.out + (size_t)rowA * 1024;
                const float* m2 = mods + (size_t)b * 6144 + 2 * 1024;
#pragma unroll
                for (int bj = 0; bj < 2; ++bj) {
                    const int col = n0 + bj * 128 + wc * 32 + (2 * fq + (odd ? 1 : 0)) * 4;
                    const f32x4 v0 = acc[ai][bj][m][0], v1 = acc[ai][bj][m][1];
                    f32x4 snd, rcv;
#pragma unroll
                    for (int j = 0; j < 4; ++j) snd[j] = odd ? v0[j] : v1[j];
#pragma unroll
                    for (int j = 0; j < 4; ++j) rcv[j] = __int_as_float(__builtin_amdgcn_update_dpp(0, __float_as_int(snd[j]), 0xB1, 0xF, 0xF, false));
                    f32x4 ka, kb;
#pragma unroll
                    for (int j = 0; j < 4; ++j) { ka[j] = odd ? rcv[j] : v0[j]; kb[j] = odd ? v1[j] : rcv[j]; }
                    const float4 mv = *(const float4*)(m2 + col);
                    float4 xa = *(const float4*)(xo + col), xb = *(const float4*)(xo + 1024 + col);
                    xa.x += mv.x * ka[0]; xa.y += mv.y * ka[1]; xa.z += mv.z * ka[2]; xa.w += mv.w * ka[3];
                    xb.x += mv.x * kb[0]; xb.y += mv.y * kb[1]; xb.z += mv.z * kb[2]; xb.w += mv.w * kb[3];
                    *(float4*)(xn + col) = xa; *(float4*)(xn + 1024 + col) = xb;
                }
            }
    };
    gemm8s(unit_fn, 2048u, 2048u, 1024, epi, lds, a.ws);
    __syncthreads();
    if (l == 0 && blockIdx.x < (NCTX / 256) * 16) {
        const int r0 = NLAT + (blockIdx.x >> 4) * 256, n0 = (blockIdx.x & 15) * 64;
        f32x4 acc[4][2];
#pragma unroll
        for (int m = 0; m < 4; ++m)
#pragma unroll
            for (int n = 0; n < 2; ++n) acc[m][n] = (f32x4){0.f, 0.f, 0.f, 0.f};
        gemm_pipe<2>(acc, [=](int r) -> unsigned { return (unsigned)(WS_BIG + BIG_MRG + (size_t)(r0 + r) * 2048); }, [=](int r) -> unsigned { return (unsigned)(WS_WOUT + (size_t)(n0 + r) * 2048); }, 1024, lds, a.ws);
        int tid = threadIdx.x; asm volatile("" : "+v"(tid));
        const int lane = tid & 63, wid = tid >> 6, wr = wid >> 1, wc = wid & 1, fr = lane & 15, fq = lane >> 4;
        const float* m2 = mods + (size_t)8 * 6144 + 2 * 1024;
#pragma unroll
        for (int m = 0; m < 4; ++m) {
            const int row = r0 + wr * 64 + m * 16 + fr - NLAT;
#pragma unroll
            for (int n = 0; n < 2; ++n) {
                const int col = n0 + wc * 32 + n * 16 + fq * 4;
                float4 xv = *(const float4*)(a.in[2] + (size_t)row * 1024 + col); const float4 mv = *(const float4*)(m2 + col);
                xv.x += mv.x * acc[m][n][0]; xv.y += mv.y * acc[m][n][1]; xv.z += mv.z * acc[m][n][2]; xv.w += mv.w * acc[m][n][3];
                *(float4*)(XC + (size_t)row * 1024 + col) = xv;
            }
        }
    }
    __syncthreads();
}


__device__ __forceinline__ void phase_prep(const Args& a, int l, unsigned char* lds) {
    const int tid = threadIdx.x, lane = tid & 63, wv = tid >> 6, fr = lane & 15, fq = lane >> 4;
    bf16_t* U = (bf16_t*)(a.ws + WS_BIG + BIG_U);
    bf16_t* MIX = (bf16_t*)(a.ws + WS_BIG + T_MIX); bf16_t* EXT = (bf16_t*)(a.ws + WS_BIG + T_EXT);
    const bf16_t* R1 = (const bf16_t*)(a.ws + WS_RW1); const bf16_t* R2 = (const bf16_t*)(a.ws + WS_RW2);
    constexpr int TR = 136, MT = 9;
    unsigned char* xa_l = lds;
    unsigned char* t1_l = lds + 144 * 528;
    const float* mu = a.in[10] + (size_t)l * 1024;
    const float* w0 = a.in[11] + (size_t)l * 512; const float* a0 = a.in[14] + (size_t)l * 512;
    const float* kkp = a.in[17] + (size_t)l * 256;
    for (int tile = blockIdx.x; tile < NROW / TR; tile += gridDim.x) {
        const int r0 = tile * TR;
        {
            const int rw0 = r0 + wv * 17;
            uint2 prv[4], cur[4], nxt[4];
            const int rhd = lane >> 3, rii = (lane & 7) * 4;
            const bool ract = lane < 48;
            uint2 rq1 = make_uint2(0u, 0u), rq2 = make_uint2(0u, 0u), rn1, rn2;
            float rinv[4];
#pragma unroll
            for (int j = 0; j < 4; ++j) rinv[j] = __expf(-(float)((rii + j) & 15) * (9.210340371976184f / 16.0f)) * 0.15915494309189535f;
            if (ract) { const bf16_t* ua0 = U + (size_t)rw0 * UW + U_ATT + rhd * 64 + rii; rq1 = *(const uint2*)ua0; rq2 = *(const uint2*)(ua0 + 32); }
#pragma unroll
            for (int sec = 0; sec < 4; ++sec) { prv[sec] = make_uint2(0u, 0u); cur[sec] = *(const uint2*)(U + (size_t)rw0 * UW + sec * 256 + lane * 4); }
            if (rw0 > 0) {
#pragma unroll
                for (int sec = 0; sec < 4; ++sec) prv[sec] = *(const uint2*)(U + (size_t)(rw0 - 1) * UW + sec * 256 + lane * 4);
            }
            float4 mu4[4];
#pragma unroll
            for (int sec = 0; sec < 4; ++sec) mu4[sec] = *(const float4*)(mu + sec * 256 + lane * 4);
            const float4 kp4 = *(const float4*)(kkp + lane * 4);
#pragma unroll 1
            for (int i = 0; i < 17; ++i) {
                const int rl = wv * 17 + i, r = r0 + rl;
                const bool lat = r < NLAT;
                const int rnx = min(r + 1, NROW - 1);
                const bool more = (r + 1) < NROW;
#pragma unroll
                for (int sec = 0; sec < 4; ++sec) nxt[sec] = *(const uint2*)(U + (size_t)rnx * UW + sec * 256 + lane * 4);
                {
                    const bf16_t* uan = U + (size_t)rnx * UW + U_ATT + (ract ? rhd * 64 + rii : 0);
                    rn1 = *(const uint2*)uan; rn2 = *(const uint2*)(uan + 32);
                }
                if (!more) {
#pragma unroll
                    for (int sec = 0; sec < 4; ++sec) nxt[sec] = make_uint2(0u, 0u);
                }
                if (ract) {
                    bf16_t* ua = U + (size_t)r * UW + U_ATT + rhd * 64 + rii;
                    const float x1[4] = {bf2f((bf16_t)(rq1.x & 0xFFFF)), bf2f((bf16_t)(rq1.x >> 16)), bf2f((bf16_t)(rq1.y & 0xFFFF)), bf2f((bf16_t)(rq1.y >> 16))};
                    const float x2[4] = {bf2f((bf16_t)(rq2.x & 0xFFFF)), bf2f((bf16_t)(rq2.x >> 16)), bf2f((bf16_t)(rq2.y & 0xFFFF)), bf2f((bf16_t)(rq2.y >> 16))};
                    const float sc = (rhd < 4) ? 0.125f : 1.0f;
                    float o1[4], o2[4];
                    if (lat) {
                        const int t = r & 4095; const float prow = (float)(t >> 6), pcol = (float)(t & 63);
                        const float pp = (rii < 16) ? prow : pcol;
#pragma unroll
                        for (int j = 0; j < 4; ++j) {
                            const float ang = pp * rinv[j]; const float sn = __builtin_amdgcn_sinf(ang), cs = __builtin_amdgcn_cosf(ang);
                            o1[j] = (x1[j] * cs - x2[j] * sn) * sc; o2[j] = (x1[j] * sn + x2[j] * cs) * sc;
                        }
                    } else {
#pragma unroll
                        for (int j = 0; j < 4; ++j) { o1[j] = x1[j] * sc; o2[j] = x2[j] * sc; }
                    }
                    st4bf(ua, o1[0], o1[1], o1[2], o1[3]); st4bf(ua + 32, o2[0], o2[1], o2[2], o2[3]);
                }
                rq1 = rn1; rq2 = rn2;
                bool hp, hn;
                if (lat) { const int t = r & 4095; hp = t > 0; hn = t < 4095; } else { const int s = (r - NLAT) & 255; hp = s > 0; hn = s < 255; }
                float mx[4][4];
#pragma unroll
                for (int sec = 0; sec < 4; ++sec) {
                    const int c = sec * 256 + lane * 4;
                    const uint2 qc = cur[sec], qp = hp ? prv[sec] : make_uint2(0u, 0u), qn = hn ? nxt[sec] : make_uint2(0u, 0u);
                    const float u0[4] = {bf2f((bf16_t)(qc.x & 0xFFFF)), bf2f((bf16_t)(qc.x >> 16)), bf2f((bf16_t)(qc.y & 0xFFFF)), bf2f((bf16_t)(qc.y >> 16))};
                    const float up[4] = {bf2f((bf16_t)(qp.x & 0xFFFF)), bf2f((bf16_t)(qp.x >> 16)), bf2f((bf16_t)(qp.y & 0xFFFF)), bf2f((bf16_t)(qp.y >> 16))};
                    const float un[4] = {bf2f((bf16_t)(qn.x & 0xFFFF)), bf2f((bf16_t)(qn.x >> 16)), bf2f((bf16_t)(qn.y & 0xFFFF)), bf2f((bf16_t)(qn.y >> 16))};
                    const float4 m4 = mu4[sec];
                    mx[sec][0] = u0[0] + (0.5f * (up[0] + un[0]) - u0[0]) * m4.x; mx[sec][1] = u0[1] + (0.5f * (up[1] + un[1]) - u0[1]) * m4.y;
                    mx[sec][2] = u0[2] + (0.5f * (up[2] + un[2]) - u0[2]) * m4.z; mx[sec][3] = u0[3] + (0.5f * (up[3] + un[3]) - u0[3]) * m4.w;
                }
                float kkv[4];
                {
                    const float4 kp = kp4;
                    kkv[0] = mx[1][0] * kp.x; kkv[1] = mx[1][1] * kp.y; kkv[2] = mx[1][2] * kp.z; kkv[3] = mx[1][3] * kp.w;
                    float ss = kkv[0] * kkv[0] + kkv[1] * kkv[1] + kkv[2] * kkv[2] + kkv[3] * kkv[3];
                    ss += __shfl_xor(ss, 1); ss += __shfl_xor(ss, 2); ss += __shfl_xor(ss, 4); ss += __shfl_xor(ss, 8);
                    const float rn = rsqrtf(ss + 1e-6f);
                    kkv[0] *= rn; kkv[1] *= rn; kkv[2] *= rn; kkv[3] *= rn;
                }
                { uint2 w; w.x = pack2(mx[3][0], mx[3][1]); w.y = pack2(mx[3][2], mx[3][3]); *(uint2*)(xa_l + rl * 528 + lane * 8) = w; }
                bf16_t* mr = MIX + (size_t)r * 768 + lane * 4; bf16_t* er = EXT + (size_t)r * 1536 + lane * 4;
                st4bf(mr, mx[0][0], mx[0][1], mx[0][2], mx[0][3]); st4bf(mr + 256, mx[1][0], mx[1][1], mx[1][2], mx[1][3]); st4bf(mr + 512, mx[2][0], mx[2][1], mx[2][2], mx[2][3]);
                st4bf(er, kkv[0], kkv[1], kkv[2], kkv[3]);
#pragma unroll
                for (int sec = 0; sec < 4; ++sec) { prv[sec] = cur[sec]; cur[sec] = nxt[sec]; }
            }
        }
        __syncthreads();
#pragma unroll 1
        for (int pass = 0; pass < 2; ++pass) {
            const int nt = wv + 8 * pass;
            if (nt < 12) {
                bf16x8 bfr[8];
#pragma unroll
                for (int ks = 0; ks < 8; ++ks) bfr[ks] = *(const bf16x8*)(R1 + (size_t)(16 * nt + fr) * 256 + 32 * ks + 8 * fq);
                f32x4 acc[MT];
#pragma unroll
                for (int m = 0; m < MT; ++m) acc[m] = (f32x4){0.f, 0.f, 0.f, 0.f};
#pragma unroll
                for (int ks = 0; ks < 8; ++ks)
#pragma unroll
                    for (int m = 0; m < MT; ++m) {
                        const bf16x8 af = *(const bf16x8*)(xa_l + (16 * m + fr) * 528 + (32 * ks + 8 * fq) * 2);
                        acc[m] = __builtin_amdgcn_mfma_f32_16x16x32_bf16(bfr[ks], af, acc[m], 0, 0, 0);
                    }
#pragma unroll
                for (int m = 0; m < MT; ++m) {
                    float o[4];
#pragma unroll
                    for (int j = 0; j < 4; ++j) { const float x = acc[m][j]; o[j] = (nt < 4) ? tanhf(x) : ((nt < 8) ? x : sigmf(x)); }
                    uint2 w; w.x = pack2(o[0], o[1]); w.y = pack2(o[2], o[3]);
                    *(uint2*)(t1_l + (16 * m + fr) * 400 + (16 * nt + 4 * fq) * 2) = w;
                }
            }
        }
        __syncthreads();
#pragma unroll 1
        for (int q2 = 0; q2 < 5; ++q2) {
            const int nt = wv * 10 + 2 * q2, blk = nt >> 4, n0 = (nt & 15) * 16;
            f32x4 acc[2][MT];
#pragma unroll
            for (int t2 = 0; t2 < 2; ++t2)
#pragma unroll
                for (int m = 0; m < MT; ++m) acc[t2][m] = (f32x4){0.f, 0.f, 0.f, 0.f};
            const int br0 = n0 + ((fr >> 2) * 8 + (fr & 3)), br1 = br0 + 4;
            if (blk < 4) {
                const bf16x8 b0 = *(const bf16x8*)(R2 + ((size_t)blk * 256 + br0) * 32 + 8 * fq), b1 = *(const bf16x8*)(R2 + ((size_t)blk * 256 + br1) * 32 + 8 * fq);
#pragma unroll
                for (int m = 0; m < MT; ++m) {
                    const bf16x8 af = *(const bf16x8*)(t1_l + (16 * m + fr) * 400 + (32 * blk + 8 * fq) * 2);
                    acc[0][m] = __builtin_amdgcn_mfma_f32_16x16x32_bf16(b0, af, acc[0][m], 0, 0, 0);
                    acc[1][m] = __builtin_amdgcn_mfma_f32_16x16x32_bf16(b1, af, acc[1][m], 0, 0, 0);
                }
            } else {
#pragma unroll
                for (int ks = 0; ks < 2; ++ks) {
                    const bf16x8 b0 = *(const bf16x8*)(R2 + 4 * 256 * 32 + (size_t)br0 * 64 + 32 * ks + 8 * fq), b1 = *(const bf16x8*)(R2 + 4 * 256 * 32 + (size_t)br1 * 64 + 32 * ks + 8 * fq);
#pragma unroll
                    for (int m = 0; m < MT; ++m) {
                        const bf16x8 af = *(const bf16x8*)(t1_l + (16 * m + fr) * 400 + (128 + 32 * ks + 8 * fq) * 2);
                        acc[0][m] = __builtin_amdgcn_mfma_f32_16x16x32_bf16(b0, af, acc[0][m], 0, 0, 0);
                        acc[1][m] = __builtin_amdgcn_mfma_f32_16x16x32_bf16(b1, af, acc[1][m], 0, 0, 0);
                    }
                }
            }
            const int c = n0 + 8 * fq;
            float4 bia0 = make_float4(0.f, 0.f, 0.f, 0.f), bia1 = bia0;
            if (blk < 2) { bia0 = *(const float4*)(w0 + blk * 256 + c); bia1 = *(const float4*)(w0 + blk * 256 + c + 4); }
            else if (blk < 4) { bia0 = *(const float4*)(a0 + (blk - 2) * 256 + c); bia1 = *(const float4*)(a0 + (blk - 2) * 256 + c + 4); }
            const int ecol = (blk < 2) ? (256 + blk * 256) : ((blk < 4) ? (768 + (blk - 2) * 256) : 1280);
#pragma unroll
            for (int m = 0; m < MT; ++m) {
                if (16 * m + fr >= TR) continue;
                const int r = r0 + 16 * m + fr;
                float o[8] = {acc[0][m][0] + bia0.x, acc[0][m][1] + bia0.y, acc[0][m][2] + bia0.z, acc[0][m][3] + bia0.w,
                              acc[1][m][0] + bia1.x, acc[1][m][1] + bia1.y, acc[1][m][2] + bia1.z, acc[1][m][3] + bia1.w};
                if (blk < 2) {
#pragma unroll
                    for (int j = 0; j < 8; ++j) o[j] = -sigmf(o[j]) * 0.6065306597f;
                } else if (blk < 4) {
#pragma unroll
                    for (int j = 0; j < 8; ++j) o[j] = sigmf(o[j]);
                }
                *(uint4*)(EXT + (size_t)r * 1536 + ecol + c) = make_uint4(pack2(o[0], o[1]), pack2(o[2], o[3]), pack2(o[4], o[5]), pack2(o[6], o[7]));
            }
        }
        __syncthreads();
    }
}

__device__ __forceinline__ int seq_row(int b, int d, int pos) {
    if (pos < 256) { const int s = d ? 255 - pos : pos; return NLAT + b * 256 + s; }
    int t = pos - 256; if (d) t = 4095 - t; return b * 4096 + t;
}

__device__ __forceinline__ float2 cmul(float2 x, float2 y) { return make_float2(x.x * y.x - x.y * y.y, x.x * y.y + x.y * y.x); }

__device__ __forceinline__ void phase_s5ktab(const Args& a, int l) {
    float* KT = (float*)(a.ws + WS_S5KT);
    for (int i = blockIdx.x * NTHREADS + threadIdx.x; i < 2 * 16 * 16 * 256; i += gridDim.x * NTHREADS) {
        const int c2 = i & 15, c = (i >> 4) & 15, lag = (i >> 8) & 15, g = (i >> 12) & 15, d = i >> 16;
        const float dt = __expf(a.in[29][(l * 2 + d) * 16 + g]);
        const float* lre_p = a.in[27] + ((size_t)(l * 2 + d) * 16 + g) * 64; const float* lim_p = a.in[28] + ((size_t)(l * 2 + d) * 16 + g) * 64;
        const float* cre = a.in[32] + (((size_t)(l * 2 + d) * 16 + g) * 16 + c) * 64; const float* cim = a.in[33] + (((size_t)(l * 2 + d) * 16 + g) * 16 + c) * 64;
        const float* bre = a.in[30] + ((size_t)(l * 16 + g) * 64) * 16 + c2; const float* bim = a.in[31] + ((size_t)(l * 16 + g) * 64) * 16 + c2;
        float v = 0.f;
#pragma unroll 4
        for (int p = 0; p < 64; ++p) {
            const float lre = lre_p[p], lim = lim_p[p];
            const float mag = __expf(lre * dt); float sn, cs; sincosf(lim * dt, &sn, &cs);
            const float nre = mag * cs - 1.f, nim = mag * sn, den = lre * lre + lim * lim;
            const float2 qd = make_float2((nre * lre + nim * lim) / den, (nim * lre - nre * lim) / den);
            const float2 bb = cmul(qd, make_float2(bre[p * 16], bim[p * 16]));
            const float ml = __expf(lre * dt * (float)lag); float s2, c2_; sincosf(lim * dt * (float)lag, &s2, &c2_);
            const float2 w = cmul(make_float2(ml * c2_, ml * s2), bb);
            v += cre[p] * w.x - cim[p] * w.y;
        }
        KT[i] = v;
    }
}

__device__ __forceinline__ void phase_s5setup(const Args& a, int l) {
    const float2* bbar = (const float2*)(a.ws + WS_S5P) + 2 * 16 * 64;
    const float2* PW = (const float2*)(a.ws + WS_S5PW);
    bf16_t* KF = (bf16_t*)(a.ws + WS_S5KF); bf16_t* E = (bf16_t*)(a.ws + WS_S5E); const float* KT = (const float*)(a.ws + WS_S5KT);
    const float* cre = a.in[32] + (size_t)l * 2 * 16 * 16 * 64; const float* cim = a.in[33] + (size_t)l * 2 * 16 * 16 * 64;
    const int gsz = gridDim.x * NTHREADS, gid = blockIdx.x * NTHREADS + threadIdx.x;
    for (int i = gid; i < 16 * 256 * 512; i += gsz) {
        const int k = i & 511, n = (i >> 9) & 255, g = i >> 17, t = n >> 4, c = n & 15;
        float v = 0.f;
        if (k < 256) {
            const int s = k >> 4, c2 = k & 15;
            if (s <= t) v += KT[(((0 * 16 + g) * 16 + (t - s)) * 16 + c) * 16 + c2];
            if (s >= t) v += KT[(((1 * 16 + g) * 16 + (s - t)) * 16 + c) * 16 + c2];
            if (s == t && c2 == c) v += a.in[34][(size_t)l * 256 + g * 16 + c];
        } else {
            const int d = (k - 256) >> 7, pp = (k - 256) & 127, p = pp & 63;
            const int lag = d ? (16 - t) : (t + 1);
            const float2 cc = make_float2(cre[((d * 16 + g) * 16 + c) * 64 + p], cim[((d * 16 + g) * 16 + c) * 64 + p]);
            const float2 w = cmul(cc, PW[((d * 16 + g) * 64 + p) * 17 + lag]);
            v = (pp < 64) ? w.x : -w.y;
        }
        KF[i] = f2bf(v);
    }
    for (int i = gid; i < 16 * 2 * 128 * 256; i += gsz) {
        const int k = i & 255, n = (i >> 8) & 127, d = (i >> 15) & 1, g = i >> 16, s = k >> 4, c2 = k & 15, p = n & 63;
        const int lag = d ? s : (15 - s);
        const float2 w = cmul(PW[((d * 16 + g) * 64 + p) * 17 + lag], bbar[((size_t)(d * 16 + g) * 64 + p) * 16 + c2]);
        E[i] = f2bf((n < 64) ? w.x : w.y);
    }
}

__device__ __forceinline__ void phase_s5g1(const Args& a, unsigned char* lds) {
    const int tid = threadIdx.x, lane = tid & 63, wid = tid >> 6, wr = wid >> 1, wc = wid & 1, fr = lane & 15, fq = lane >> 4;
    const bf16_t* AC = (const bf16_t*)(a.ws + WS_BIG + T_AC); const bf16_t* E = (const bf16_t*)(a.ws + WS_S5E);
    bf16_t* XE = (bf16_t*)(a.ws + WS_BIG + T_XE);
    for (int w = blockIdx.x; w < 16 * 2 * 9; w += gridDim.x) {
        const int mt = w % 9, gd = w / 9, g = gd >> 1;
        f32x4 acc[4][4];
#pragma unroll
        for (int m = 0; m < 4; ++m)
#pragma unroll
            for (int n = 0; n < 4; ++n) acc[m][n] = (f32x4){0.f, 0.f, 0.f, 0.f};
        gemm_pipe<4>(acc, [=](int r) -> unsigned { int R = mt * 256 + r; if (R > 2175) R = 2175; return (unsigned)(WS_BIG + T_AC + ((size_t)g * 2176 + R) * 1024); },
                     [=](int r) -> unsigned { return (unsigned)(WS_S5E + ((size_t)gd * 128 + r) * 512); }, 256, lds, a.ws);
#pragma unroll
        for (int m = 0; m < 4; ++m) {
            const int R = mt * 256 + wr * 64 + m * 16 + fr;
            if (R < 2176) {
#pragma unroll
                for (int n = 0; n < 4; ++n) st4bf(XE + ((size_t)gd * 2176 + R) * 128 + wc * 64 + n * 16 + fq * 4, acc[m][n][0], acc[m][n][1], acc[m][n][2], acc[m][n][3]);
            }
        }
    }
}

__device__ __forceinline__ void s5_carry(const Args& a, int chain) {
    const int lane = threadIdx.x & 63;
    const int b = chain >> 5, g = (chain >> 1) & 15, d = chain & 1;
    const float2* PW = (const float2*)(a.ws + WS_S5PW);
    const float2 a16 = PW[((d * 16 + g) * 64 + lane) * 17 + 16];
    const bf16_t* XE = (const bf16_t*)(a.ws + WS_BIG + T_XE) + ((size_t)(g * 2 + d) * 2176 + b * 272) * 128;
    bf16_t* AC = (bf16_t*)(a.ws + WS_BIG + T_AC) + ((size_t)g * 2176 + b * 272) * 512 + 256 + d * 128;
    float xr = 0.f, xi = 0.f;
    auto jof = [=](int step) -> int { return d ? ((step < 16) ? (15 - step) : (271 - (step - 16))) : step; };
    float nr[4], ni[4];
#pragma unroll
    for (int u = 0; u < 4; ++u) { const int j = jof(u); nr[u] = bf2f(XE[(size_t)j * 128 + lane]); ni[u] = bf2f(XE[(size_t)j * 128 + 64 + lane]); }
    for (int s0 = 0; s0 < 272; s0 += 4) {
        float cr[4], ci[4];
#pragma unroll
        for (int u = 0; u < 4; ++u) { cr[u] = nr[u]; ci[u] = ni[u]; }
        if (s0 + 4 < 272) {
#pragma unroll
            for (int u = 0; u < 4; ++u) { const int j = jof(s0 + 4 + u); nr[u] = bf2f(XE[(size_t)j * 128 + lane]); ni[u] = bf2f(XE[(size_t)j * 128 + 64 + lane]); }
        }
#pragma unroll
        for (int u = 0; u < 4; ++u) {
            const int j = jof(s0 + u);
            AC[(size_t)j * 512 + lane] = f2bf(xr); AC[(size_t)j * 512 + 64 + lane] = f2bf(xi);
            const float tr_ = a16.x * xr - a16.y * xi + cr[u], ti_ = a16.x * xi + a16.y * xr + ci[u];
            xr = tr_; xi = ti_;
        }
    }
}

__device__ __forceinline__ float gelu_tanh(float x) { return 0.5f * x * (1.f + tanhf(0.7978845608028654f * (x + 0.044715f * x * x * x))); }

__device__ __forceinline__ void phase_s5g2(const Args& a, unsigned char* lds, int bidx, int nblk) {
    const int tid = threadIdx.x, lane = tid & 63, wid = tid >> 6, wr = wid >> 1, wc = wid & 1, fr = lane & 15, fq = lane >> 4;
    const bf16_t* AC = (const bf16_t*)(a.ws + WS_BIG + T_AC); const bf16_t* KF = (const bf16_t*)(a.ws + WS_S5KF);
    bf16_t* YG = (bf16_t*)(a.ws + WS_BIG + T_XE);
    for (int w = bidx; w < 16 * 9 * 2; w += nblk) {
        const int nt2 = w & 1, mt = (w >> 1) % 9, g = (w >> 1) / 9;
        f32x4 acc[4][4];
#pragma unroll
        for (int m = 0; m < 4; ++m)
#pragma unroll
            for (int n = 0; n < 4; ++n) acc[m][n] = (f32x4){0.f, 0.f, 0.f, 0.f};
        gemm_pipe<4>(acc, [=](int r) -> unsigned { int R = mt * 256 + r; if (R > 2175) R = 2175; return (unsigned)(WS_BIG + T_AC + ((size_t)g * 2176 + R) * 1024); },
                     [=](int r) -> unsigned { return (unsigned)(WS_S5KF + ((size_t)g * 256 + nt2 * 128 + r) * 1024); }, 512, lds, a.ws);
#pragma unroll
        for (int m = 0; m < 4; ++m) {
            const int R = mt * 256 + wr * 64 + m * 16 + fr;
            if (R < 2176) {
                const int b = R / 272, j = R % 272;
#pragma unroll
                for (int n = 0; n < 4; ++n) {
                    const int nn = nt2 * 128 + wc * 64 + n * 16 + fq * 4, t = nn >> 4, c = nn & 15, pos = 16 * j + t;
                    const int row = (pos < 256) ? (NLAT + b * 256 + pos) : (b * 4096 + pos - 256);
                    st4bf(YG + (size_t)row * 256 + g * 16 + c, gelu_tanh(acc[m][n][0]), gelu_tanh(acc[m][n][1]), gelu_tanh(acc[m][n][2]), gelu_tanh(acc[m][n][3]));
                }
            }
        }
    }
}

__device__ __forceinline__ void phase_s5glu(const Args& a, int l, unsigned char* lds, int bidx, int nblk) {
    const int tid = threadIdx.x, lane = tid & 63, wid = tid >> 6, wr = wid >> 1, wc = wid & 1, fr = lane & 15, fq = lane >> 4;
    const bf16_t* YG = (const bf16_t*)(a.ws + WS_BIG + T_XE); const bf16_t* WG = (const bf16_t*)(a.ws + WS_WGLU);
    bf16_t* Y = (bf16_t*)(a.ws + WS_BIG + BIG_Y);
    const float* bgl = a.in[36] + (size_t)l * 256;
    const int nrows = (l == 0) ? NROW : NLAT;
    for (int w = bidx; w < (nrows / 256) * 2; w += nblk) {
        const int nt2 = w & 1, r0 = (w >> 1) * 256;
        f32x4 acc[4][4];
#pragma unroll
        for (int m = 0; m < 4; ++m)
#pragma unroll
            for (int n = 0; n < 4; ++n) acc[m][n] = (f32x4){0.f, 0.f, 0.f, 0.f};
        gemm_pipe<4>(acc, [=](int r) -> unsigned { return (unsigned)(WS_BIG + T_XE + (size_t)(r0 + r) * 512); }, [=](int r) -> unsigned { return (unsigned)(WS_WGLU + (size_t)(nt2 * 128 + r) * 512); }, 256, lds, a.ws);
#pragma unroll
        for (int m = 0; m < 4; ++m) {
            const int row = r0 + wr * 64 + m * 16 + fr;
#pragma unroll
            for (int n = 0; n < 4; ++n) {
                const int col = nt2 * 128 + wc * 64 + n * 16 + fq * 4;
                float yv[4]; ld4bf(YG + (size_t)row * 256 + col, yv);
                const float4 b4 = *(const float4*)(bgl + col);
                st4bf(Y + (size_t)row * 1024 + 768 + col, yv[0] * sigmf(acc[m][n][0] + b4.x), yv[1] * sigmf(acc[m][n][1] + b4.y), yv[2] * sigmf(acc[m][n][2] + b4.z), yv[3] * sigmf(acc[m][n][3] + b4.w));
            }
        }
    }
}

typedef float f32x16 __attribute__((ext_vector_type(16)));
typedef short s16x4 __attribute__((ext_vector_type(4)));
__device__ __forceinline__ unsigned lds_addr(const void* p) { return (unsigned)(size_t)(__attribute__((address_space(3))) const char*)p; }
template <int O0, int O1, int O2, int O3>
__device__ __forceinline__ void tr_read4(unsigned addr, s16x4& r0, s16x4& r1, s16x4& r2, s16x4& r3) {
    asm volatile("ds_read_b64_tr_b16 %0, %4 offset:%5\n\tds_read_b64_tr_b16 %1, %4 offset:%6\n\tds_read_b64_tr_b16 %2, %4 offset:%7\n\tds_read_b64_tr_b16 %3, %4 offset:%8\n\ts_waitcnt lgkmcnt(0)"
                 : "=&v"(r0), "=&v"(r1), "=&v"(r2), "=&v"(r3) : "v"(addr), "i"(O0), "i"(O1), "i"(O2), "i"(O3) : "memory");
}
__device__ __forceinline__ s16x4 tr_read1(unsigned addr) { s16x4 r; asm volatile("ds_read_b64_tr_b16 %0, %1\n\ts_waitcnt lgkmcnt(0)" : "=&v"(r) : "v"(addr) : "memory"); return r; }
template <int N> __device__ __forceinline__ float dpp_shr(float x) { return __int_as_float(__builtin_amdgcn_update_dpp(0, __float_as_int(x), 0x110 + N, 0xF, 0xF, true)); }
__device__ __forceinline__ s16x4 cvt4(const f32x4& x) { uint2 u; u.x = pack2(x[0], x[1]); u.y = pack2(x[2], x[3]); return __builtin_bit_cast(s16x4, u); }
__device__ __forceinline__ bf16x8 cat8(const s16x4& lo, const s16x4& hi) { bf16x8 r; r[0] = lo[0]; r[1] = lo[1]; r[2] = lo[2]; r[3] = lo[3]; r[4] = hi[0]; r[5] = hi[1]; r[6] = hi[2]; r[7] = hi[3]; return r; }
__device__ __forceinline__ f32x4 mm16(const f32x4& xa, const f32x4& yb) {
    return __builtin_amdgcn_mfma_f32_16x16x16bf16_1k(cvt4(xa), cvt4(yb), (f32x4){0.f, 0.f, 0.f, 0.f}, 0, 0, 0);
}
__device__ __forceinline__ f32x4 mm16b(const f32x4& xa, const s16x4& yb) {
    return __builtin_amdgcn_mfma_f32_16x16x16bf16_1k(cvt4(xa), yb, (f32x4){0.f, 0.f, 0.f, 0.f}, 0, 0, 0);
}
__device__ __forceinline__ void ld16bf(const bf16_t* p, float (&o)[16]) {
    const uint4 q0 = *(const uint4*)p, q1 = *(const uint4*)(p + 8);
    const unsigned w[8] = {q0.x, q0.y, q0.z, q0.w, q1.x, q1.y, q1.z, q1.w};
#pragma unroll
    for (int i = 0; i < 8; ++i) { o[2 * i] = bf2f((bf16_t)(w[i] & 0xFFFF)); o[2 * i + 1] = bf2f((bf16_t)(w[i] >> 16)); }
}
__device__ __forceinline__ void attn_mfma(const Args& a, int l, int aw, int naw, unsigned char* ldsw  ) {
    const int lane = threadIdx.x & 63, c = lane & 31, h2 = lane >> 5;
    const bf16_t* U = (const bf16_t*)(a.ws + WS_BIG + BIG_U);
    bf16_t* Y = (bf16_t*)(a.ws + WS_BIG + BIG_Y);
    bf16_t* vt = (bf16_t*)ldsw;
    const unsigned vtr = (unsigned)(size_t)(__attribute__((address_space(3))) const char*)ldsw + (4 * h2 + ((lane & 15) >> 2)) * 136 + (16 * ((lane >> 4) & 1) + (lane & 3) * 4) * 2;
    const int ntask = 4096 + ((l == 0) ? 256 : 0);
    for (int task = aw; task < ntask; task += naw) {
        int b, qt, h, qrow0; bool lat;
        if (task < 4096) { b = task >> 9; qt = (task >> 2) & 127; h = task & 3; qrow0 = b * 4096 + qt * 32; lat = true; }
        else { const int t2 = task - 4096; b = t2 >> 5; qt = (t2 >> 2) & 7; h = t2 & 3; qrow0 = NLAT + b * 256 + qt * 32; lat = false; }
        const int kvh = h >> 1;
        const int ti_lo = lat ? max(0, 4 - qt) : 0, nwin = lat ? (min(8, 131 - qt) - ti_lo + 1) : 0, ntile = nwin + 8;
        auto tile_row = [=](int n) -> int { return (n < nwin) ? (b * 4096 + (qt + ti_lo + n - 4) * 32) : (NLAT + b * 256 + (n - nwin) * 32); };
        bf16x8 qf[4];
        {
            const bf16_t* qp = U + (size_t)(qrow0 + c) * UW + U_ATT + h * 64 + 8 * h2;
#pragma unroll
            for (int s = 0; s < 4; ++s) qf[s] = *(const bf16x8*)(qp + 16 * s);
        }
        bf16x8 kfn[4]; uint4 vn[4];
        auto load_tile = [&](int n) {
            const int krow0 = tile_row(n);
            const bf16_t* kp = U + (size_t)(krow0 + c) * UW + U_ATT + 256 + kvh * 64 + 8 * h2;
#pragma unroll
            for (int s = 0; s < 4; ++s) kfn[s] = *(const bf16x8*)(kp + 16 * s);
#pragma unroll
            for (int i = 0; i < 4; ++i) {
                const int ch = lane + 64 * i, key = ch >> 3, dc = ch & 7;
                vn[i] = *(const uint4*)(U + (size_t)(krow0 + key) * UW + U_ATT + 384 + kvh * 64 + dc * 8);
            }
        };
        load_tile(0);
        f32x16 o0, o1;
#pragma unroll
        for (int r = 0; r < 16; ++r) { o0[r] = 0.f; o1[r] = 0.f; }
        float m = a.in[26][l * 4 + h];
        float lsum = (h2 == 0) ? 1.0f : 0.0f;
#pragma unroll 1
        for (int n = 0; n < ntile; ++n) {
            const int ti = ti_lo + n;
            const int mtype = (n < nwin) ? ((ti == 0) ? 1 : ((ti == 8) ? 2 : 0)) : 0;
            bf16x8 kf[4];
#pragma unroll
            for (int s = 0; s < 4; ++s) kf[s] = kfn[s];
#pragma unroll
            for (int i = 0; i < 4; ++i) {
                const int ch = lane + 64 * i, key = ch >> 3, dc = ch & 7;
                *(uint2*)(vt + key * 68 + dc * 8) = make_uint2(vn[i].x, vn[i].y);
                *(uint2*)(vt + key * 68 + dc * 8 + 4) = make_uint2(vn[i].z, vn[i].w);
            }
            if (n + 1 < ntile) load_tile(n + 1);
            f32x16 s;
#pragma unroll
            for (int r = 0; r < 16; ++r) s[r] = 0.f;
#pragma unroll
            for (int k4 = 0; k4 < 4; ++k4) s = __builtin_amdgcn_mfma_f32_32x32x16_bf16(kf[k4], qf[k4], s, 0, 0, 0);
            if (mtype != 0) {
#pragma unroll
                for (int r = 0; r < 16; ++r) {
                    const int j = (r & 3) + 8 * (r >> 2) + 4 * h2;
                    if ((mtype == 1 && j < c) || (mtype == 2 && j > c)) s[r] = -1.0e30f;
                }
            }
            float mx = s[0];
#pragma unroll
            for (int r = 1; r < 16; ++r) mx = fmaxf(mx, s[r]);
            mx = fmaxf(mx, __shfl_xor(mx, 32));
            const float mn = fmaxf(m, mx);
            const float alpha = __expf(m - mn);
            m = mn;
            float ps = 0.f;
#pragma unroll
            for (int r = 0; r < 16; ++r) { s[r] = __expf(s[r] - mn); ps += s[r]; }
            lsum = lsum * alpha + ps;
#pragma unroll
            for (int r = 0; r < 16; ++r) { o0[r] *= alpha; o1[r] *= alpha; }
            __builtin_amdgcn_wave_barrier();
#pragma unroll
            for (int ks = 0; ks < 2; ++ks) {
                bf16x8 pb;
                {
                    unsigned w0 = pack2(s[8 * ks], s[8 * ks + 1]), w1 = pack2(s[8 * ks + 2], s[8 * ks + 3]), w2 = pack2(s[8 * ks + 4], s[8 * ks + 5]), w3 = pack2(s[8 * ks + 6], s[8 * ks + 7]);
                    uint4 t4 = make_uint4(w0, w1, w2, w3); pb = __builtin_bit_cast(bf16x8, t4);
                }
                s16x4 a0, a1, b0, b1;
                if (ks == 0) tr_read4<0, 8 * 136, 64, 8 * 136 + 64>(vtr, a0, a1, b0, b1);
                else tr_read4<16 * 136, 24 * 136, 16 * 136 + 64, 24 * 136 + 64>(vtr, a0, a1, b0, b1);
                o0 = __builtin_amdgcn_mfma_f32_32x32x16_bf16(cat8(a0, a1), pb, o0, 0, 0, 0);
                o1 = __builtin_amdgcn_mfma_f32_32x32x16_bf16(cat8(b0, b1), pb, o1, 0, 0, 0);
            }
            __builtin_amdgcn_wave_barrier();
        }
        const float ltot = lsum + __shfl_xor(lsum, 32);
        const float inv = 1.0f / ltot;
        bf16_t* yo = Y + (size_t)(qrow0 + c) * 1024 + 512 + h * 64 + 4 * h2;
#pragma unroll
        for (int g = 0; g < 4; ++g) {
            st4bf(yo + 8 * g, o0[4 * g] * inv, o0[4 * g + 1] * inv, o0[4 * g + 2] * inv, o0[4 * g + 3] * inv);
            st4bf(yo + 32 + 8 * g, o1[4 * g] * inv, o1[4 * g + 1] * inv, o1[4 * g + 2] * inv, o1[4 * g + 3] * inv);
        }
    }
}

constexpr int RC_WA = 0, RC_BK = 2048, RC_V = 6144, RC_R = 8192, RC_U0 = 10240  , RC_AA = 12288, RC_PC = 13312, RC_SIZE = 13568;

struct RwRaw { uint4 q[12]; };
__device__ __forceinline__ void rwkv_load_raw(const Args& a, int b, int h, int d, int chunk, RwRaw& raw) {
    const int lane = threadIdx.x & 63, t = lane & 15, qp = lane >> 4;
    const bf16_t* MIX = (const bf16_t*)(a.ws + WS_BIG + T_MIX); const bf16_t* EXT = (const bf16_t*)(a.ws + WS_BIG + T_EXT);
    const int row = seq_row(b, d, chunk * 16 + t);
    const bf16_t* e0 = EXT + (size_t)row * 1536 + h * 64 + 16 * qp; const bf16_t* m0 = MIX + (size_t)row * 768 + h * 64 + 16 * qp;
    raw.q[0] = *(const uint4*)(e0 + 256 + d * 256); raw.q[1] = *(const uint4*)(e0 + 256 + d * 256 + 8);
    raw.q[2] = *(const uint4*)(e0); raw.q[3] = *(const uint4*)(e0 + 8);
    raw.q[4] = *(const uint4*)(e0 + 768 + d * 256); raw.q[5] = *(const uint4*)(e0 + 768 + d * 256 + 8);
    raw.q[6] = *(const uint4*)(m0); raw.q[7] = *(const uint4*)(m0 + 8);
    raw.q[8] = *(const uint4*)(m0 + 256); raw.q[9] = *(const uint4*)(m0 + 256 + 8);
    raw.q[10] = *(const uint4*)(m0 + 512); raw.q[11] = *(const uint4*)(m0 + 512 + 8);
}
__device__ __forceinline__ void un16(const uint4& q0, const uint4& q1, float (&o)[16]) {
    const unsigned w[8] = {q0.x, q0.y, q0.z, q0.w, q1.x, q1.y, q1.z, q1.w};
#pragma unroll
    for (int i = 0; i < 8; ++i) { o[2 * i] = bf2f((bf16_t)(w[i] & 0xFFFF)); o[2 * i + 1] = bf2f((bf16_t)(w[i] >> 16)); }
}
__device__ __forceinline__ void rwkv_chunkA(const RwRaw& raw, unsigned char* cl, const float (&ka)[16]) {
    const int lane = threadIdx.x & 63, t = lane & 15, qp = lane >> 4;
    unsigned pa[8], pr[8], pb[8], pk[8];
    {
        float L[16], lw[16];
        un16(raw.q[0], raw.q[1], lw);
#pragma unroll
        for (int e = 0; e < 16; ++e) {
            float x = lw[e];
            x += dpp_shr<1>(x); x += dpp_shr<2>(x); x += dpp_shr<4>(x); x += dpp_shr<8>(x);
            L[e] = x;
        }
        float kk[16], ic[16], rr[16], kx[16], vv[16];
        un16(raw.q[2], raw.q[3], kk); un16(raw.q[4], raw.q[5], ic); un16(raw.q[6], raw.q[7], rr); un16(raw.q[8], raw.q[9], kx); un16(raw.q[10], raw.q[11], vv);
        float eL[16];
#pragma unroll
        for (int e = 0; e < 16; ++e) eL[e] = __expf(L[e]);
        if (t == 15) {
            float* pcp = (float*)(cl + RC_PC) + 16 * qp;
#pragma unroll
            for (int e4 = 0; e4 < 4; ++e4) *(float4*)(pcp + 4 * e4) = make_float4(eL[4 * e4], eL[4 * e4 + 1], eL[4 * e4 + 2], eL[4 * e4 + 3]);
        }
        __builtin_amdgcn_wave_barrier();
        float pc[16];
        {
            const float* pcp = (const float*)(cl + RC_PC) + 16 * qp;
#pragma unroll
            for (int e4 = 0; e4 < 4; ++e4) { const float4 p4 = *(const float4*)(pcp + 4 * e4); pc[4 * e4] = p4.x; pc[4 * e4 + 1] = p4.y; pc[4 * e4 + 2] = p4.z; pc[4 * e4 + 3] = p4.w; }
        }
        unsigned pBh[8], pKh[8], pv[8];
#pragma unroll
        for (int e2 = 0; e2 < 8; ++e2) {
            float at[2], rt[2], bt[2], kt[2], Bh[2], Kh[2];
#pragma unroll
            for (int u = 0; u < 2; ++u) {
                const int e = 2 * e2 + u;
                const float aa = -kk[e], bb = kk[e] * ic[e], ke = kx[e] * (1.f + (ic[e] - 1.f) * ka[e]);
                const float sh = dpp_shr<1>(eL[e]);
                const float ePrev = (t == 0) ? 1.0f : sh, inv = __builtin_amdgcn_rcpf(eL[e]), eC = pc[e] * inv;
                at[u] = aa * ePrev; rt[u] = rr[e] * eL[e]; bt[u] = bb * inv; kt[u] = ke * inv; Bh[u] = bb * eC; Kh[u] = ke * eC;
            }
            pa[e2] = pack2(at[0], at[1]); pr[e2] = pack2(rt[0], rt[1]); pb[e2] = pack2(bt[0], bt[1]); pk[e2] = pack2(kt[0], kt[1]);
            pBh[e2] = pack2(Bh[0], Bh[1]); pKh[e2] = pack2(Kh[0], Kh[1]); pv[e2] = pack2(vv[2 * e2], vv[2 * e2 + 1]);
        }
        unsigned char* wp = cl + t * 128 + qp * 32;
        *(uint4*)(wp + RC_WA) = make_uint4(pa[0], pa[1], pa[2], pa[3]); *(uint4*)(wp + RC_WA + 16) = make_uint4(pa[4], pa[5], pa[6], pa[7]);
        *(uint4*)(wp + RC_BK) = make_uint4(pBh[0], pBh[1], pBh[2], pBh[3]); *(uint4*)(wp + RC_BK + 16) = make_uint4(pBh[4], pBh[5], pBh[6], pBh[7]);
        *(uint4*)(wp + RC_BK + 2048) = make_uint4(pKh[0], pKh[1], pKh[2], pKh[3]); *(uint4*)(wp + RC_BK + 2048 + 16) = make_uint4(pKh[4], pKh[5], pKh[6], pKh[7]);
        *(uint4*)(wp + RC_V) = make_uint4(pv[0], pv[1], pv[2], pv[3]); *(uint4*)(wp + RC_V + 16) = make_uint4(pv[4], pv[5], pv[6], pv[7]);
        *(uint4*)(wp + RC_R) = make_uint4(pr[0], pr[1], pr[2], pr[3]); *(uint4*)(wp + RC_R + 16) = make_uint4(pr[4], pr[5], pr[6], pr[7]);
    }
    bf16x8 fa[2], frr[2], fb[2], fk[2];
#pragma unroll
    for (int s = 0; s < 2; ++s) {
        fa[s] = __builtin_bit_cast(bf16x8, make_uint4(pa[4 * s], pa[4 * s + 1], pa[4 * s + 2], pa[4 * s + 3]));
        frr[s] = __builtin_bit_cast(bf16x8, make_uint4(pr[4 * s], pr[4 * s + 1], pr[4 * s + 2], pr[4 * s + 3]));
        fb[s] = __builtin_bit_cast(bf16x8, make_uint4(pb[4 * s], pb[4 * s + 1], pb[4 * s + 2], pb[4 * s + 3]));
        fk[s] = __builtin_bit_cast(bf16x8, make_uint4(pk[4 * s], pk[4 * s + 1], pk[4 * s + 2], pk[4 * s + 3]));
    }
    const f32x4 z4 = (f32x4){0.f, 0.f, 0.f, 0.f};
    auto mm2 = [&](const bf16x8 (&x)[2], const bf16x8 (&y)[2]) -> f32x4 {
        f32x4 r = __builtin_amdgcn_mfma_f32_16x16x32_bf16(x[0], y[0], z4, 0, 0, 0);
        return __builtin_amdgcn_mfma_f32_16x16x32_bf16(x[1], y[1], r, 0, 0, 0);
    };
    const int c = t, q = qp;
    f32x4 N = mm2(fa, fb), NT = mm2(fb, fa), AkT = mm2(fk, fa), ArbT = mm2(fb, frr), ArkT = mm2(fk, frr);
#pragma unroll
    for (int j = 0; j < 4; ++j) {
        const int rw = 4 * q + j;
        if (!(c < rw)) N[j] = 0.f;
        if (!(rw < c)) { NT[j] = 0.f; AkT[j] = 0.f; }
        if (!(rw <= c)) { ArbT[j] = 0.f; ArkT[j] = 0.f; }
    }
    f32x4 eye;
#pragma unroll
    for (int j = 0; j < 4; ++j) eye[j] = (4 * q + j == c) ? 1.f : 0.f;
    const f32x4 N2 = mm16(NT, N), N2T = mm16(N, NT);
    const f32x4 N4 = mm16(N2T, N2), N4T = mm16(N2, N2T);
    const f32x4 N8T = mm16(N4, N4T);
    f32x4 TT = N8T + eye;
    TT = mm16(N4 + eye, TT); TT = mm16(N2 + eye, TT); TT = mm16(N + eye, TT);
    const unsigned abase = lds_addr(cl) + (4 * q + (c >> 2)) * 128 + (c & 3) * 8;
    s16x4 ac[4], vc[4], bc[4], kc[4];
    tr_read4<RC_WA, RC_WA + 32, RC_WA + 64, RC_WA + 96>(abase, ac[0], ac[1], ac[2], ac[3]);
    tr_read4<RC_V, RC_V + 32, RC_V + 64, RC_V + 96>(abase, vc[0], vc[1], vc[2], vc[3]);
    tr_read4<RC_BK, RC_BK + 32, RC_BK + 64, RC_BK + 96>(abase, bc[0], bc[1], bc[2], bc[3]);
    tr_read4<RC_BK + 2048, RC_BK + 2048 + 32, RC_BK + 2048 + 64, RC_BK + 2048 + 96>(abase, kc[0], kc[1], kc[2], kc[3]);
#pragma unroll
    for (int nb = 0; nb < 4; ++nb) {
        const f32x4 wa = mm16b(TT, ac[nb]);
        const f32x4 g = mm16b(AkT, vc[nb]);
        const f32x4 u0 = mm16(TT, g);
        *(s16x4*)(cl + RC_WA + ((16 * nb + c) * 16 + 4 * q) * 2) = cvt4(wa);
        *(s16x4*)(cl + RC_U0 + ((16 * nb + c) * 16 + 4 * q) * 2) = cvt4(u0);
        *(bf16x8*)(cl + RC_BK + ((16 * nb + c) * 4 + q) * 16) = cat8(bc[nb], kc[nb]);
    }
    *(bf16x8*)(cl + RC_AA + (c * 4 + q) * 16) = cat8(cvt4(ArbT), cvt4(ArkT));
}

struct RwOps { s16x4 w0, w1, w2, w3, r0, r1, r2, r3, vcol[2], u0[2]; bf16x8 aa; bf16x8 bk[4]; float4 pc[4]; };
__device__ __forceinline__ void rwkv_ldops(const unsigned char* cl, int vh, RwOps& o) {
    const int lane = threadIdx.x & 63, c = lane & 15, q = lane >> 4;
    const unsigned base = lds_addr(cl);
    asm volatile("ds_read_b64_tr_b16 %0, %6\n\tds_read_b64_tr_b16 %1, %6 offset:512\n\tds_read_b64_tr_b16 %2, %6 offset:1024\n\tds_read_b64_tr_b16 %3, %6 offset:1536\n\tds_read_b64_tr_b16 %4, %7\n\tds_read_b64_tr_b16 %5, %7 offset:32"
                 : "=&v"(o.w0), "=&v"(o.w1), "=&v"(o.w2), "=&v"(o.w3), "=&v"(o.vcol[0]), "=&v"(o.vcol[1])
                 : "v"(base + RC_WA + (4 * q + (c >> 2)) * 32 + (c & 3) * 8), "v"(base + RC_V + (4 * q + (c >> 2)) * 128 + (vh * 32 + 4 * (c & 3)) * 2) : "memory");
    o.u0[0] = *(const s16x4*)(cl + RC_U0 + ((vh * 32 + c) * 16 + 4 * q) * 2); o.u0[1] = *(const s16x4*)(cl + RC_U0 + ((vh * 32 + 16 + c) * 16 + 4 * q) * 2);
    o.r0 = *(const s16x4*)(cl + RC_R + c * 128 + (4 * q) * 2); o.r1 = *(const s16x4*)(cl + RC_R + c * 128 + (16 + 4 * q) * 2);
    o.r2 = *(const s16x4*)(cl + RC_R + c * 128 + (32 + 4 * q) * 2); o.r3 = *(const s16x4*)(cl + RC_R + c * 128 + (48 + 4 * q) * 2);
    o.aa = *(const bf16x8*)(cl + RC_AA + (c * 4 + q) * 16);
#pragma unroll
    for (int i = 0; i < 4; ++i) { o.bk[i] = *(const bf16x8*)(cl + RC_BK + ((16 * i + c) * 4 + q) * 16); o.pc[i] = *(const float4*)(cl + RC_PC + (16 * i + 4 * q) * 4); }
}
__device__ __forceinline__ void rwkv_chunkB(int b, int h, int d, int chunk, RwOps& o, const unsigned char* nxt_cl, RwOps& on, int vh, f32x4 (&st)[2][4], bf16_t* YO) {
    const int lane = threadIdx.x & 63, c = lane & 15, q = lane >> 4;
    asm volatile("s_waitcnt lgkmcnt(0)" : "+v"(o.w0), "+v"(o.w1), "+v"(o.w2), "+v"(o.w3), "+v"(o.vcol[0]), "+v"(o.vcol[1]) :: "memory");
    float4 pc[4];
#pragma unroll
    for (int i = 0; i < 4; ++i) pc[i] = o.pc[i];
    if (nxt_cl) rwkv_ldops(nxt_cl, vh, on);
    const bf16x8 wa0 = cat8(o.w0, o.w1), wa1 = cat8(o.w2, o.w3), ra0 = cat8(o.r0, o.r1), ra1 = cat8(o.r2, o.r3);
    bf16_t* yrow = YO + (size_t)seq_row(b, d, chunk * 16 + c) * 256 + h * 64 + vh * 32 + 4 * q;
#pragma unroll
    for (int u2 = 0; u2 < 2; ++u2) {
        const bf16x8 sf0 = cat8(cvt4(st[u2][0]), cvt4(st[u2][1])), sf1 = cat8(cvt4(st[u2][2]), cvt4(st[u2][3]));
        f32x4 u;
        { const uint2 t = __builtin_bit_cast(uint2, o.u0[u2]); u = (f32x4){bf2f((bf16_t)(t.x & 0xFFFF)), bf2f((bf16_t)(t.x >> 16)), bf2f((bf16_t)(t.y & 0xFFFF)), bf2f((bf16_t)(t.y >> 16))}; }
        u = __builtin_amdgcn_mfma_f32_16x16x32_bf16(wa0, sf0, u, 0, 0, 0);
        u = __builtin_amdgcn_mfma_f32_16x16x32_bf16(wa1, sf1, u, 0, 0, 0);
        f32x4 y = __builtin_amdgcn_mfma_f32_16x16x32_bf16(sf0, ra0, (f32x4){0.f, 0.f, 0.f, 0.f}, 0, 0, 0);
        y = __builtin_amdgcn_mfma_f32_16x16x32_bf16(sf1, ra1, y, 0, 0, 0);
        const bf16x8 uv = cat8(cvt4(u), o.vcol[u2]);
#pragma unroll
        for (int i = 0; i < 4; ++i) {
            f32x4 cin = st[u2][i]; cin[0] *= pc[i].x; cin[1] *= pc[i].y; cin[2] *= pc[i].z; cin[3] *= pc[i].w;
            st[u2][i] = __builtin_amdgcn_mfma_f32_16x16x32_bf16(o.bk[i], uv, cin, 0, 0, 0);
        }
        y = __builtin_amdgcn_mfma_f32_16x16x32_bf16(uv, o.aa, y, 0, 0, 0);
        st4bf(yrow + u2 * 16, y[0], y[1], y[2], y[3]);
    }
}

#define RW_STEP_BARRIER() do { asm volatile("s_waitcnt lgkmcnt(0)" ::: "memory"); __builtin_amdgcn_s_barrier(); asm volatile("" ::: "memory"); } while (0)
__device__ __forceinline__ void scan_rwkv_chunked(const Args& a, int l, int chain, unsigned char* lds) {
    const int lane = threadIdx.x & 63, wv = threadIdx.x >> 6;
    const int b = chain >> 3, h = (chain >> 1) & 3, d = chain & 1;
    bf16_t* YO = (bf16_t*)(a.ws + WS_BIG + T_YRW) + (size_t)d * NROW * 256;
    constexpr int NCH = 272, SW = 6, NSTEP = (NCH + SW - 1) / SW;
    if (wv >= 2) {
        const int aw = wv - 2;
        float ka[16];
        {
            const float* kp = a.in[18] + (size_t)l * 256 + h * 64 + 16 * (lane >> 4);
#pragma unroll
            for (int e = 0; e < 16; ++e) ka[e] = kp[e];
        }
        RwRaw raw0, raw1;
        rwkv_load_raw(a, b, h, d, aw, raw0);
        rwkv_chunkA(raw0, lds + aw * RC_SIZE, ka);
        rwkv_load_raw(a, b, h, d, min(SW + aw, NCH - 1), raw0);
        rwkv_load_raw(a, b, h, d, min(2 * SW + aw, NCH - 1), raw1);
        RW_STEP_BARRIER();
        static_assert(NSTEP % 2 == 0, "step loop is unrolled by two");
#pragma unroll 1
        for (int step = 0; step < NSTEP; step += 2) {
            {
                const int cn = (step + 1) * SW + aw;
                if (step + 1 < NSTEP && cn < NCH) rwkv_chunkA(raw0, lds + (((step + 1) & 1) * SW + aw) * RC_SIZE, ka);
                rwkv_load_raw(a, b, h, d, min(cn + 2 * SW, NCH - 1), raw0);
            }
            RW_STEP_BARRIER();
            {
                const int cn = (step + 2) * SW + aw;
                if (step + 2 < NSTEP && cn < NCH) rwkv_chunkA(raw1, lds + (((step + 2) & 1) * SW + aw) * RC_SIZE, ka);
                rwkv_load_raw(a, b, h, d, min(cn + 2 * SW, NCH - 1), raw1);
            }
            RW_STEP_BARRIER();
        }
    } else {
        __builtin_amdgcn_s_setprio(3);
        f32x4 st[2][4];
#pragma unroll
        for (int u2 = 0; u2 < 2; ++u2)
#pragma unroll
            for (int i = 0; i < 4; ++i) st[u2][i] = (f32x4){0.f, 0.f, 0.f, 0.f};
        RW_STEP_BARRIER();
        for (int step = 0; step < NSTEP; ++step) {
            const unsigned char* bl = lds + ((step & 1) * SW) * RC_SIZE;
            const int n = min(SW, NCH - step * SW);
            RwOps o0, o1;
            rwkv_ldops(bl, wv, o0);
#pragma unroll 1
            for (int cc = 0; cc < n; cc += 2) {
                rwkv_chunkB(b, h, d, step * SW + cc, o0, bl + (cc + 1) * RC_SIZE, o1, wv, st, YO);
                rwkv_chunkB(b, h, d, step * SW + cc + 1, o1, (cc + 2 < n) ? bl + (cc + 2) * RC_SIZE : (const unsigned char*)nullptr, o0, wv, st, YO);
            }
            RW_STEP_BARRIER();
        }
        __builtin_amdgcn_s_setprio(0);
    }
}

#undef RW_STEP_BARRIER
template <int N> __device__ __forceinline__ float dpp_shl(float x) { return __int_as_float(__builtin_amdgcn_update_dpp(0, __float_as_int(x), 0x100 + N, 0xF, 0xF, true)); }
__device__ __forceinline__ f32x4 mfma16(const s16x4& a_, const s16x4& b_, const f32x4& c_) { return __builtin_amdgcn_mfma_f32_16x16x16bf16_1k(a_, b_, c_, 0, 0, 0); }
__device__ __forceinline__ float logsigf(float x) { return -__logf(1.0f + __expf(-x)); }

struct GlaBlk { int rowbase; };
__device__ __forceinline__ int gla_rowbase(int b, int tb) { return (tb < 4) ? (NLAT + b * 256 + tb * 64) : (b * 4096 + (tb - 4) * 64); }
__device__ __forceinline__ int gla_tb_of_chunk(int d, int cidx) { return d ? ((cidx < 4) ? (3 - cidx) : (4 + 63 - (cidx - 4))) : cidx; }

__device__ __forceinline__ void gla_logdecay(const bf16_t* U, int rowbase, int l, int h, int d, const float* A2, const float* AB, float (&la)[4][2][4], float (&P)[4][2][4], float (&tot)[2][4]) {
    const int lane = threadIdx.x & 63, t = lane & 15, q = lane >> 4;
    s16x4 a2t[2]; f32x4 bias[2];
#pragma unroll
    for (int kt = 0; kt < 2; ++kt) {
        uint2 w; w.x = pack2(A2[(4 * q) * 128 + h * 32 + 16 * kt + t], A2[(4 * q + 1) * 128 + h * 32 + 16 * kt + t]);
        w.y = pack2(A2[(4 * q + 2) * 128 + h * 32 + 16 * kt + t], A2[(4 * q + 3) * 128 + h * 32 + 16 * kt + t]);
        a2t[kt] = __builtin_bit_cast(s16x4, w);
        const float4 b4 = *(const float4*)(AB + h * 32 + 16 * kt + 4 * q);
        bias[kt] = (f32x4){b4.x, b4.y, b4.z, b4.w};
    }
    float run[2][4];
#pragma unroll
    for (int kt = 0; kt < 2; ++kt)
#pragma unroll
        for (int j = 0; j < 4; ++j) run[kt][j] = 0.f;
#pragma unroll
    for (int tt = 0; tt < 4; ++tt) {
        const s16x4 al = *(const s16x4*)(U + (size_t)(rowbase + 16 * tt + t) * UW + U_GLA + 768 + d * 16 + 4 * q);
#pragma unroll
        for (int kt = 0; kt < 2; ++kt) {
            const f32x4 x = mfma16(a2t[kt], al, bias[kt]);
#pragma unroll
            for (int j = 0; j < 4; ++j) {
                const float v = logsigf(x[j]) * (1.0f / 16.0f);
                la[tt][kt][j] = v;
                float s = v;
                s += dpp_shr<1>(s); s += dpp_shr<2>(s); s += dpp_shr<4>(s); s += dpp_shr<8>(s);
                P[tt][kt][j] = s + run[kt][j];
                run[kt][j] += __shfl(s, (lane & 48) | 15);
            }
        }
    }
#pragma unroll
    for (int kt = 0; kt < 2; ++kt)
#pragma unroll
        for (int j = 0; j < 4; ++j) tot[kt][j] = run[kt][j];
}

__device__ __forceinline__ void gla_stage_v(const bf16_t* U, int rowbase, int h, unsigned char* vl) {
    const int lane = threadIdx.x & 63;
#pragma unroll
    for (int i = 0; i < 8; ++i) {
        const int ch = lane + 64 * i, tok = ch >> 3, dc = ch & 7;
        *(uint4*)(vl + tok * 128 + dc * 16) = *(const uint4*)(U + (size_t)(rowbase + tok) * UW + U_GLA + 256 + h * 64 + dc * 8);
    }
}

__device__ __forceinline__ void gla_qk(const bf16_t* U, int rowbase, int h, int d, const float* A2, const float* AB, s16x4 (&qd)[4][2], s16x4 (&ki)[4][2]) {
    const int lane = threadIdx.x & 63, t = lane & 15, q = lane >> 4;
    s16x4 a2t[2]; f32x4 bias[2];
#pragma unroll
    for (int kt = 0; kt < 2; ++kt) {
        uint2 w; w.x = pack2(A2[(4 * q) * 128 + h * 32 + 16 * kt + t], A2[(4 * q + 1) * 128 + h * 32 + 16 * kt + t]);
        w.y = pack2(A2[(4 * q + 2) * 128 + h * 32 + 16 * kt + t], A2[(4 * q + 3) * 128 + h * 32 + 16 * kt + t]);
        a2t[kt] = __builtin_bit_cast(s16x4, w);
        const float4 b4 = *(const float4*)(AB + h * 32 + 16 * kt + 4 * q);
        bias[kt] = (f32x4){b4.x, b4.y, b4.z, b4.w};
    }
    float tot[2][4];
#pragma unroll
    for (int kt = 0; kt < 2; ++kt)
#pragma unroll
        for (int j = 0; j < 4; ++j) tot[kt][j] = 0.f;
    if (d) {
#pragma unroll
        for (int tt = 0; tt < 4; ++tt) {
            const s16x4 al = *(const s16x4*)(U + (size_t)(rowbase + 16 * tt + t) * UW + U_GLA + 768 + d * 16 + 4 * q);
#pragma unroll
            for (int kt = 0; kt < 2; ++kt) {
                const f32x4 x = mfma16(a2t[kt], al, bias[kt]);
#pragma unroll
                for (int j = 0; j < 4; ++j) tot[kt][j] += logsigf(x[j]) * (1.0f / 16.0f);
            }
        }
#pragma unroll
        for (int kt = 0; kt < 2; ++kt)
#pragma unroll
            for (int j = 0; j < 4; ++j) { float v = tot[kt][j]; v += __shfl_xor(v, 1); v += __shfl_xor(v, 2); v += __shfl_xor(v, 4); v += __shfl_xor(v, 8); tot[kt][j] = v; }
    }
    float run[2][4];
#pragma unroll
    for (int kt = 0; kt < 2; ++kt)
#pragma unroll
        for (int j = 0; j < 4; ++j) run[kt][j] = 0.f;
#pragma unroll
    for (int tt = 0; tt < 4; ++tt) {
        asm volatile("" ::: "memory");
        const s16x4 al = *(const s16x4*)(U + (size_t)(rowbase + 16 * tt + t) * UW + U_GLA + 768 + d * 16 + 4 * q);
#pragma unroll
        for (int kt = 0; kt < 2; ++kt) {
            const f32x4 x = mfma16(a2t[kt], al, bias[kt]);
            float qv[4], kv[4];
            ld4bf(U + (size_t)(rowbase + 16 * tt + t) * UW + U_GLA + h * 32 + 16 * kt + 4 * q, qv);
            ld4bf(U + (size_t)(rowbase + 16 * tt + t) * UW + U_GLA + 128 + h * 32 + 16 * kt + 4 * q, kv);
            float eq[4], ek[4];
#pragma unroll
            for (int j = 0; j < 4; ++j) {
                const float v = logsigf(x[j]) * (1.0f / 16.0f);
                float s = v;
                s += dpp_shr<1>(s); s += dpp_shr<2>(s); s += dpp_shr<4>(s); s += dpp_shr<8>(s);
                const float P = s + run[kt][j];
                run[kt][j] += __shfl(s, (lane & 48) | 15);
                const float cum = d ? (tot[kt][j] - P + v) : P;
                eq[j] = qv[j] * __expf(cum) * 0.17677669529663687f; ek[j] = kv[j] * __expf(-cum);
            }
            uint2 w; w.x = pack2(eq[0], eq[1]); w.y = pack2(eq[2], eq[3]); qd[tt][kt] = __builtin_bit_cast(s16x4, w);
            w.x = pack2(ek[0], ek[1]); w.y = pack2(ek[2], ek[3]); ki[tt][kt] = __builtin_bit_cast(s16x4, w);
        }
    }
}

__device__ __forceinline__ void gla_phaseA(const Args& a, int l, unsigned char* lds) {
    const int lane = threadIdx.x & 63, wv = threadIdx.x >> 6, t = lane & 15, q = lane >> 4;
    const bf16_t* U = (const bf16_t*)(a.ws + WS_BIG + BIG_U);
    f32x4* GD = (f32x4*)(a.ws + WS_BIG + T_GD); float* GDEC = (float*)(a.ws + WS_BIG + T_GDEC);
    unsigned char* vl = lds + wv * 12288; unsigned char* kl = vl + 8192;
    for (int task = blockIdx.x * 8 + wv; task < 64 * 68; task += gridDim.x * 8) {
        const int chain = task / 68, cidx = task % 68;
        const int b = chain >> 3, h = (chain >> 1) & 3, d = chain & 1;
        const int rowbase = gla_rowbase(b, gla_tb_of_chunk(d, cidx));
        const float* A2 = a.in[23] + ((size_t)l * 2 + d) * 16 * 128; const float* AB = a.in[24] + ((size_t)l * 2 + d) * 128;
        float la[4][2][4], P[4][2][4], tot[2][4];
        gla_logdecay(U, rowbase, l, h, d, A2, AB, la, P, tot);
        gla_stage_v(U, rowbase, h, vl);
#pragma unroll
        for (int tt = 0; tt < 4; ++tt)
#pragma unroll
            for (int kt = 0; kt < 2; ++kt) {
                float kv[4]; ld4bf(U + (size_t)(rowbase + 16 * tt + t) * UW + U_GLA + 128 + h * 32 + 16 * kt + 4 * q, kv);
                float e[4];
#pragma unroll
                for (int j = 0; j < 4; ++j) e[j] = kv[j] * __expf(d ? (P[tt][kt][j] - la[tt][kt][j]) : (tot[kt][j] - P[tt][kt][j]));
                uint2 w; w.x = pack2(e[0], e[1]); w.y = pack2(e[2], e[3]);
                *(uint2*)(kl + (16 * tt + t) * 64 + (16 * kt + 4 * q) * 2) = w;
            }
        if (t == 0) {
#pragma unroll
            for (int kt = 0; kt < 2; ++kt) *(float4*)(GDEC + (size_t)task * 32 + 16 * kt + 4 * q) = make_float4(__expf(tot[kt][0]), __expf(tot[kt][1]), __expf(tot[kt][2]), __expf(tot[kt][3]));
        }
        __builtin_amdgcn_wave_barrier();
        const unsigned kbase = lds_addr(kl) + (4 * q + (t >> 2)) * 64 + (t & 3) * 8;
        const unsigned vbase = lds_addr(vl) + (4 * q + (t >> 2)) * 128 + (t & 3) * 8;
        f32x4 acc[2][4];
#pragma unroll
        for (int kt = 0; kt < 2; ++kt)
#pragma unroll
            for (int dvt = 0; dvt < 4; ++dvt) acc[kt][dvt] = (f32x4){0.f, 0.f, 0.f, 0.f};
#pragma unroll
        for (int tt = 0; tt < 4; ++tt) {
            s16x4 k0 = tr_read1(kbase + tt * 1024), k1 = tr_read1(kbase + tt * 1024 + 32);
            s16x4 v0, v1, v2, v3;
            tr_read4<0, 32, 64, 96>(vbase + tt * 2048, v0, v1, v2, v3);
            acc[0][0] = mfma16(k0, v0, acc[0][0]); acc[0][1] = mfma16(k0, v1, acc[0][1]); acc[0][2] = mfma16(k0, v2, acc[0][2]); acc[0][3] = mfma16(k0, v3, acc[0][3]);
            acc[1][0] = mfma16(k1, v0, acc[1][0]); acc[1][1] = mfma16(k1, v1, acc[1][1]); acc[1][2] = mfma16(k1, v2, acc[1][2]); acc[1][3] = mfma16(k1, v3, acc[1][3]);
        }
#pragma unroll
        for (int kt = 0; kt < 2; ++kt)
#pragma unroll
            for (int dvt = 0; dvt < 4; ++dvt) GD[((size_t)task * 8 + kt * 4 + dvt) * 64 + lane] = acc[kt][dvt];
        __builtin_amdgcn_wave_barrier();
    }
}

__device__ __forceinline__ void gla_phaseB(const Args& a, int task) {
    const int lane = threadIdx.x & 63, q = lane >> 4, chain = task >> 1, hf = task & 1;
    f32x4* GD = (f32x4*)(a.ws + WS_BIG + T_GD) + (size_t)chain * 68 * 8 * 64 + hf * 4 * 64 + lane;
    const float* GDEC = (const float*)(a.ws + WS_BIG + T_GDEC) + (size_t)chain * 68 * 32 + hf * 16 + 4 * q;
    f32x4 s[4];
#pragma unroll
    for (int i = 0; i < 4; ++i) s[i] = (f32x4){0.f, 0.f, 0.f, 0.f};
    f32x4 nx[4][4]; float4 ndc[4];
#pragma unroll
    for (int p = 0; p < 4; ++p) {
#pragma unroll
        for (int i = 0; i < 4; ++i) nx[p][i] = GD[((size_t)p * 8 + i) * 64];
        ndc[p] = *(const float4*)(GDEC + p * 32);
    }
#pragma unroll 1
    for (int c = 0; c < 68; c += 4) {
#pragma unroll
        for (int u = 0; u < 4; ++u) {
            f32x4 dl[4];
#pragma unroll
            for (int i = 0; i < 4; ++i) dl[i] = nx[u][i];
            const float4 dd = ndc[u];
            if (c + u + 4 < 68) {
#pragma unroll
                for (int i = 0; i < 4; ++i) nx[u][i] = GD[((size_t)(c + u + 4) * 8 + i) * 64];
                ndc[u] = *(const float4*)(GDEC + (c + u + 4) * 32);
            }
#pragma unroll
            for (int i = 0; i < 4; ++i) {
                GD[((size_t)(c + u) * 8 + i) * 64] = s[i];
                s[i][0] = s[i][0] * dd.x + dl[i][0]; s[i][1] = s[i][1] * dd.y + dl[i][1]; s[i][2] = s[i][2] * dd.z + dl[i][2]; s[i][3] = s[i][3] * dd.w + dl[i][3];
            }
        }
    }
}

__device__ __forceinline__ void gla_phaseC(const Args& a, int l, unsigned char* lds, int bidx, int nblk) {
    const int lane = threadIdx.x & 63, wv = threadIdx.x >> 6, t = lane & 15, q = lane >> 4;
    const bf16_t* U = (const bf16_t*)(a.ws + WS_BIG + BIG_U);
    const f32x4* GD = (const f32x4*)(a.ws + WS_BIG + T_GD);
    bf16_t* Y = (bf16_t*)(a.ws + WS_BIG + BIG_Y);
    unsigned char* vl = lds + wv * 8192;
    const int tb0 = (l == 0) ? 0 : 4;
    const int ntb = 68 - tb0;
    for (int task = bidx * 8 + wv; task < 8 * 4 * ntb * 2; task += nblk * 8) {
        const int half = task & 1, tk = task >> 1;
        const int b = tk / (4 * ntb), rem = tk % (4 * ntb), h = rem / ntb, tb = tb0 + rem % ntb;
        const int rowbase = gla_rowbase(b, tb);
        gla_stage_v(U, rowbase, h, vl);
        __builtin_amdgcn_wave_barrier();
        const unsigned vbase = lds_addr(vl) + (4 * q + (t >> 2)) * 128 + (t & 3) * 8;
        f32x4 o[4][2];
#pragma unroll
        for (int dvt = 0; dvt < 4; ++dvt)
#pragma unroll
            for (int i2 = 0; i2 < 2; ++i2) o[dvt][i2] = (f32x4){0.f, 0.f, 0.f, 0.f};
#pragma unroll 1
        for (int d = 0; d < 2; ++d) {
            const float* A2 = a.in[23] + ((size_t)l * 2 + d) * 16 * 128; const float* AB = a.in[24] + ((size_t)l * 2 + d) * 128;
            const int cidx = d ? ((tb < 4) ? (3 - tb) : (4 + 63 - (tb - 4))) : tb;
            const int chain = (b * 4 + h) * 2 + d;
            const f32x4* sg = GD + ((size_t)chain * 68 + cidx) * 8 * 64 + lane;
            f32x4 sra[4], srb[4];
#pragma unroll
            for (int i8 = 0; i8 < 4; ++i8) sra[i8] = sg[i8 * 64];
            asm volatile("" ::: "memory");
            s16x4 qall[4][2], ki[4][2];
            gla_qk(U, rowbase, h, d, A2, AB, qall, ki);
            s16x4 qd[2][2];
#pragma unroll
            for (int i2 = 0; i2 < 2; ++i2)
#pragma unroll
                for (int kt = 0; kt < 2; ++kt)
#pragma unroll
                    for (int e = 0; e < 4; ++e) qd[i2][kt][e] = half ? qall[2 + i2][kt][e] : qall[i2][kt][e];
#pragma unroll
            for (int i2 = 0; i2 < 2; ++i2) {
                const int it = 2 * half + i2;
#pragma unroll
                for (int jt = 0; jt < 4; ++jt) {
                    if (d == 0 ? (jt > it) : (jt < it)) continue;
                    f32x4 p = mfma16(ki[jt][0], qd[i2][0], (f32x4){0.f, 0.f, 0.f, 0.f});
                    p = mfma16(ki[jt][1], qd[i2][1], p);
                    if (jt == it) {
#pragma unroll
                        for (int j = 0; j < 4; ++j) { const int jj = 4 * q + j; if (d == 0 ? (jj > t) : (jj < t)) p[j] = 0.f; }
                    }
                    const s16x4 pb = cvt4(p);
                    s16x4 v0, v1, v2, v3;
                    tr_read4<0, 32, 64, 96>(vbase + jt * 2048, v0, v1, v2, v3);
                    o[0][i2] = mfma16(v0, pb, o[0][i2]); o[1][i2] = mfma16(v1, pb, o[1][i2]); o[2][i2] = mfma16(v2, pb, o[2][i2]); o[3][i2] = mfma16(v3, pb, o[3][i2]);
                }
            }
#pragma unroll
            for (int i8 = 0; i8 < 4; ++i8) srb[i8] = sg[(4 + i8) * 64];
            asm volatile("" ::: "memory");
#pragma unroll
            for (int kt = 0; kt < 2; ++kt)
#pragma unroll
                for (int dvt = 0; dvt < 4; ++dvt) {
                    const s16x4 sa = cvt4(kt ? srb[dvt] : sra[dvt]);
                    o[dvt][0] = mfma16(sa, qd[0][kt], o[dvt][0]); o[dvt][1] = mfma16(sa, qd[1][kt], o[dvt][1]);
                }
        }
#pragma unroll
        for (int i2 = 0; i2 < 2; ++i2) {
            float ss = 0.f;
#pragma unroll
            for (int dvt = 0; dvt < 4; ++dvt)
#pragma unroll
                for (int j = 0; j < 4; ++j) ss += o[dvt][i2][j] * o[dvt][i2][j];
            ss += __shfl_xor(ss, 16); ss += __shfl_xor(ss, 32);
            const float rn = rsqrtf(ss * (1.0f / 64.0f) + 1e-6f);
            const int row = rowbase + 16 * (2 * half + i2) + t;
#pragma unroll
            for (int dvt = 0; dvt < 4; ++dvt) {
                const int c0 = h * 64 + 16 * dvt + 4 * q;
                float rr[4]; ld4bf(U + (size_t)row * UW + U_GLA + 512 + c0, rr);
                const float4 g4 = *(const float4*)(a.in[25] + (size_t)l * 256 + c0);
                st4bf(Y + (size_t)row * 1024 + 256 + c0, o[dvt][i2][0] * rn * g4.x * siluf(rr[0]), o[dvt][i2][1] * rn * g4.y * siluf(rr[1]),
                      o[dvt][i2][2] * rn * g4.z * siluf(rr[2]), o[dvt][i2][3] * rn * g4.w * siluf(rr[3]));
            }
        }
        __builtin_amdgcn_wave_barrier();
    }
}

__device__ __forceinline__ void sub_barrier(unsigned* cnt, unsigned target) {
    asm volatile("s_waitcnt vmcnt(0)" ::: "memory");
    __syncthreads();
    if (threadIdx.x == 0) {
        __builtin_amdgcn_fence(__ATOMIC_RELEASE, "agent");
        asm volatile("s_waitcnt vmcnt(0)" ::: "memory");
        (void)__hip_atomic_fetch_add(cnt, 1u, __ATOMIC_RELAXED, __HIP_MEMORY_SCOPE_AGENT);
        unsigned sp = 0;
        while (__hip_atomic_load(cnt, __ATOMIC_RELAXED, __HIP_MEMORY_SCOPE_AGENT) < target) { __builtin_amdgcn_s_sleep(2); if (++sp > (1u << 22)) break; }
        __builtin_amdgcn_fence(__ATOMIC_ACQUIRE, "agent");
        asm volatile("s_waitcnt vmcnt(0)" ::: "memory");
    }
    __syncthreads();
}

__device__ __forceinline__ void phase_scan(const Args& a, int l, unsigned char* lds) {
    const int wv = threadIdx.x >> 6;
    unsigned char* ldsw = lds + wv * 12288;
    const int bid = blockIdx.x;
    if (bid < 64) { scan_rwkv_chunked(a, l, bid, lds); return; }
    if (bid < 80) gla_phaseB(a, (bid - 64) * 8 + wv);
    else if (bid < 112) s5_carry(a, (bid - 80) * 8 + wv);
    else attn_mfma(a, l, (bid - 112) * 8 + wv, (gridDim.x - 112) * 8, ldsw);
    unsigned* sc = (unsigned*)(a.ws + WS_CNT) + 256 + l * 128;
    const unsigned nsub = gridDim.x - 64;
    sub_barrier(sc, nsub);
    gla_phaseC(a, l, lds, bid - 64, (int)nsub);
    __syncthreads();
    phase_s5g2(a, lds, bid - 64, (int)nsub);
    sub_barrier(sc + 64, nsub);
    phase_s5glu(a, l, lds, bid - 64, (int)nsub);
    phase_convert(a, l, lds, false, true, bid - 64, (int)nsub);
}

__device__ __forceinline__ void phase_fin(const Args& a, int l, unsigned char* lds) {
    const int lane = threadIdx.x & 63, wv = threadIdx.x >> 6;
    const int gw = blockIdx.x * 8 + wv, nw = gridDim.x * 8;
    const bf16_t* U = (const bf16_t*)(a.ws + WS_BIG + BIG_U);
    const bf16_t* MIX = (const bf16_t*)(a.ws + WS_BIG + T_MIX); const bf16_t* EXT = (const bf16_t*)(a.ws + WS_BIG + T_EXT);
    const bf16_t* YRW = (const bf16_t*)(a.ws + WS_BIG + T_YRW);
    bf16_t* Y = (bf16_t*)(a.ws + WS_BIG + BIG_Y);
    const int nrows = (l == 0) ? NROW : NLAT;
    const int c = lane * 4;
    const float4 rk4 = *(const float4*)(a.in[19] + (size_t)l * 256 + c), lng = *(const float4*)(a.in[22] + (size_t)l * 256 + c);
    for (int r = gw; r < nrows; r += nw) {
        {
            float y0[4], y1[4], rr[4], kk[4], vv[4], gg[4];
            ld4bf(YRW + (size_t)r * 256 + c, y0); ld4bf(YRW + (size_t)(NROW + r) * 256 + c, y1);
            ld4bf(MIX + (size_t)r * 768 + c, rr); ld4bf(MIX + (size_t)r * 768 + 256 + c, kk); ld4bf(MIX + (size_t)r * 768 + 512 + c, vv);
            ld4bf(EXT + (size_t)r * 1536 + 1280 + c, gg);
            float y[4] = {y0[0] + y1[0], y0[1] + y1[1], y0[2] + y1[2], y0[3] + y1[3]};
            float sm = y[0] + y[1] + y[2] + y[3];
            sm += __shfl_xor(sm, 1); sm += __shfl_xor(sm, 2); sm += __shfl_xor(sm, 4); sm += __shfl_xor(sm, 8);
            const float mu = sm * (1.0f / 64.0f);
            float vs = (y[0] - mu) * (y[0] - mu) + (y[1] - mu) * (y[1] - mu) + (y[2] - mu) * (y[2] - mu) + (y[3] - mu) * (y[3] - mu);
            vs += __shfl_xor(vs, 1); vs += __shfl_xor(vs, 2); vs += __shfl_xor(vs, 4); vs += __shfl_xor(vs, 8);
            const float rsd = rsqrtf(vs * (1.0f / 64.0f) + 64e-5f);
            float bs = rr[0] * kk[0] * rk4.x + rr[1] * kk[1] * rk4.y + rr[2] * kk[2] * rk4.z + rr[3] * kk[3] * rk4.w;
            bs += __shfl_xor(bs, 1); bs += __shfl_xor(bs, 2); bs += __shfl_xor(bs, 4); bs += __shfl_xor(bs, 8);
            st4bf(Y + (size_t)r * 1024 + c,
                  ((y[0] - mu) * rsd * lng.x + bs * vv[0]) * gg[0], ((y[1] - mu) * rsd * lng.y + bs * vv[1]) * gg[1],
                  ((y[2] - mu) * rsd * lng.z + bs * vv[2]) * gg[2], ((y[3] - mu) * rsd * lng.w + bs * vv[3]) * gg[3]);
        }
    }
}

constexpr int LDS_BYTES = 160 * 1024;
enum { PH_PRO = 0, PH_N1, PH_G1, PH_PREP, PH_SCAN, PH_FIN, PH_MERGE, PH_G3, PH_N2, PH_M1, PH_M2, PH_PER_LAYER };
constexpr int PH_FINAL = 2 * PH_PER_LAYER, PH_COUNT = PH_FINAL + 1;

__global__ void __launch_bounds__(NTHREADS, 2) mega(Args a) {
    extern __shared__ __attribute__((aligned(16))) unsigned char lds[];
    if (threadIdx.x == 0) *(uint4*)(lds + LDS_BYTES - 16) = make_uint4(0u, 0u, 0u, 0u);
    __syncthreads();
    XcdBarrier bar = xcd_barrier_post((unsigned*)(a.ws + WS_BAR), (volatile LAS unsigned*)(lds + LDS_BYTES - 16));
#define IN(p) ((p) >= a.ph_lo && (p) < a.ph_hi)
#define SEAM(p) if (IN(p) && IN((p) + 1)) xcd_barrier(bar);
#define LAYER(l) { constexpr int base = (l) * PH_PER_LAYER; \
        if ((l) == 0) { if (IN(base + PH_PRO)) { phase_convert(a, 0, lds, true, false, blockIdx.x, gridDim.x); phase_ada(a, lds); phase_s5params(a, 0); phase_s5ktab(a, 0); } \
        SEAM(base + PH_PRO) } \
        if (IN(base + PH_N1)) { phase_norm1(a, l, lds); phase_s5setup(a, l); } \
        SEAM(base + PH_N1) \
        if (IN(base + PH_G1)) phase_g1(a, lds); \
        SEAM(base + PH_G1) \
        if (IN(base + PH_PREP)) { phase_prep(a, l, lds); __syncthreads(); gla_phaseA(a, l, lds); __syncthreads(); phase_s5g1(a, lds); } \
        SEAM(base + PH_PREP) \
        if (IN(base + PH_SCAN)) phase_scan(a, l, lds); \
        SEAM(base + PH_SCAN) \
        if (IN(base + PH_FIN)) phase_fin(a, l, lds); \
        SEAM(base + PH_FIN) \
        if (IN(base + PH_MERGE)) phase_merge(a, l, lds); \
        SEAM(base + PH_MERGE) \
        if (IN(base + PH_G3)) phase_g3(a, l, lds); \
        SEAM(base + PH_G3) \
        if (IN(base + PH_N2)) phase_norm2(a, l, lds); \
        SEAM(base + PH_N2) \
        if (IN(base + PH_M1)) phase_moe1(a, l, lds); \
        SEAM(base + PH_M1) \
        if (IN(base + PH_M2)) { phase_moe2(a, l, lds); if ((l) == 0) { __syncthreads(); phase_convert(a, 1, lds, true, false, blockIdx.x, gridDim.x); phase_s5params(a, 1); phase_s5ktab(a, 1); } } \
        if ((l) == 0) { if (IN(base + PH_M2) && IN(PH_PER_LAYER + PH_N1)) xcd_barrier(bar); } else { SEAM(base + PH_M2) } }
    LAYER(0)
    LAYER(1)
#undef LAYER
    if (IN(PH_FINAL)) phase_norm1(a, 2, lds);
#undef IN
}

extern "C" void kernel_launch(void* const* d_in, const int* in_sizes, int n_in, void* d_out, int out_size, void* d_ws, size_t ws_size, hipStream_t stream) {
    static int inited = 0;
    if (!inited) {
        if (n_in != 46 || ws_size < WS_END) { fprintf(stderr, "kernel_launch: bad sizes n_in %d ws %zu need %zu\n", n_in, ws_size, (size_t)WS_END); inited = -1; return; }
        if (hipFuncSetAttribute((const void*)mega, hipFuncAttributeMaxDynamicSharedMemorySize, LDS_BYTES) != hipSuccess) { fprintf(stderr, "hipFuncSetAttribute failed\n"); inited = -1; return; }
        int per_cu = 0;
        if (hipOccupancyMaxActiveBlocksPerMultiprocessor(&per_cu, (const void*)mega, NTHREADS, LDS_BYTES) != hipSuccess || per_cu < 1) { fprintf(stderr, "occupancy query says %d blocks per CU\n", per_cu); }
        (void)hipGetLastError();
        inited = 1;
    }
    if (inited < 0) return;
    (void)hipMemsetAsync((char*)d_ws, 0, 32768, stream);
    Args a{};
    for (int i = 0; i < 46; ++i) a.in[i] = (const float*)d_in[i];
    a.out = (float*)d_out; a.ws = (unsigned char*)d_ws;
    a.ph_lo = 0; a.ph_hi = PH_COUNT;
    hipLaunchKernelGGL(mega, dim3(256), dim3(NTHREADS), LDS_BYTES, stream, a);
}
```

```cpp
#include <hip/hip_runtime.h>
#include <stdint.h>
#include <stdio.h>

constexpr int D = 1024, NBATCH = 8, SEQ = 4096, CTXL = 256;
constexpr int NLAT = NBATCH * SEQ;
constexpr int NCTX = NBATCH * CTXL;
constexpr int NROW = NLAT + NCTX;
constexpr int PIN = 6688;
constexpr int UW = 2592;
constexpr int NEXP = 32, EH = 512;
constexpr int NTHREADS = 512;
constexpr int MOE_CAP = NROW;

constexpr int U_RWKV = 0, U_ATT = 1024, U_S5 = 1536, U_GLA = 1792;

typedef unsigned short bf16_t;
typedef short bf16x8 __attribute__((ext_vector_type(8)));
typedef float f32x4 __attribute__((ext_vector_type(4)));
#define LDSP(p) ((__attribute__((address_space(3))) unsigned*)(p))

constexpr size_t AL(size_t x) { return (x + 255) & ~(size_t)255; }
constexpr size_t WS_BAR   = 0;
constexpr size_t WS_CNT   = 16384;
constexpr size_t WS_MODS  = 32768;
constexpr size_t WS_WRT   = AL(WS_MODS + (size_t)2 * 9 * 6144 * 4);
constexpr size_t WS_WIN   = AL(WS_WRT + (size_t)36 * 1024 * 4);
constexpr size_t WS_WBR   = AL(WS_WIN + (size_t)PIN * 1024 * 2);
constexpr size_t WS_WOUT  = AL(WS_WBR + (size_t)4 * 1024 * 256 * 2);
constexpr size_t WS_H     = AL(WS_WOUT + (size_t)1024 * 1024 * 2);
constexpr size_t WS_XC    = AL(WS_H + (size_t)NROW * 1024 * 2);
constexpr size_t WS_STOK  = AL(WS_XC + (size_t)NCTX * 1024 * 4);
constexpr size_t WS_TINFO = AL(WS_STOK + (size_t)NEXP * MOE_CAP * 4);
constexpr size_t WS_S5P   = AL(WS_TINFO + (size_t)NROW * 16);
constexpr size_t WS_S5PW  = AL(WS_S5P + (size_t)2 * 16 * 64 * 8 + (size_t)2 * 16 * 64 * 16 * 8);
constexpr size_t WS_S5KF  = AL(WS_S5PW + (size_t)2 * 16 * 64 * 17 * 8);
constexpr size_t WS_S5E   = AL(WS_S5KF + (size_t)16 * 256 * 512 * 2);
constexpr size_t WS_WGLU  = AL(WS_S5E + (size_t)16 * 2 * 128 * 256 * 2);
constexpr size_t WS_RW1   = AL(WS_WGLU + (size_t)256 * 256 * 2);
constexpr size_t WS_RW2   = AL(WS_RW1 + (size_t)192 * 256 * 2);
constexpr size_t WS_S5KT  = AL(WS_RW2 + (size_t)(4 * 256 * 32 + 256 * 64) * 2);
constexpr size_t WS_BIG   = AL(WS_S5KT + (size_t)2 * 16 * 16 * 256 * 4);
constexpr size_t BIG_U    = 0;
constexpr size_t BIG_MRG  = 0;
constexpr size_t BIG_HID  = 0;
constexpr size_t BIG_WEG  = AL((size_t)NROW * 1024 * 2);
constexpr size_t BIG_WEU  = BIG_WEG + (size_t)NEXP * EH * 1024 * 2;
constexpr size_t BIG_WED  = BIG_WEU + (size_t)NEXP * EH * 1024 * 2;
constexpr size_t BIG_Y    = AL((size_t)NROW * UW * 2);
constexpr size_t BIG_T    = BIG_Y + AL((size_t)NROW * 1024 * 2);
constexpr size_t T_MIX    = BIG_T;
constexpr size_t T_EXT    = T_MIX + AL((size_t)NROW * 768 * 2);
constexpr size_t T_YRW    = T_EXT + AL((size_t)NROW * 1536 * 2);
constexpr size_t T_GD     = T_YRW + AL((size_t)2 * NROW * 256 * 2);
constexpr size_t T_GDEC   = T_GD + AL((size_t)64 * 68 * 8192);
constexpr size_t T_AC     = T_GDEC + AL((size_t)64 * 68 * 128);
constexpr size_t T_XE     = T_AC + AL((size_t)16 * 2176 * 512 * 2);
constexpr size_t T_END    = T_XE + AL((size_t)NROW * 256 * 2);
constexpr size_t BIG_YD   = BIG_T;
static_assert(BIG_WED + (size_t)NEXP * 1024 * EH * 2 <= BIG_Y, "experts must fit in U tail");
static_assert(BIG_YD + (size_t)2 * NROW * 1024 * 2 <= T_END, "YD must fit in T");
constexpr size_t WS_END   = WS_BIG + T_END;

struct Args {
    const float* in[46];
    float* out;
    unsigned char* ws;
    int ph_lo, ph_hi;
};

#define XB_TMO      128
#define XB_XCNT(j)  (256  + 64 * (j))
#define XB_XSUB(j)  (1280 + 64 * (j))
#define XB_XGEN(j)  (2304 + 64 * (j))
#define XB_TOP      3328
#define XB_TOPGEN   3392
#define XCD_BAR_WORDS 3456
#define XB_SPIN_CAP (1u << 18)
#define LAS __attribute__((address_space(3)))

__device__ __forceinline__ unsigned xb_ld(unsigned* p)              { return __hip_atomic_load(p, __ATOMIC_RELAXED, __HIP_MEMORY_SCOPE_AGENT); }
__device__ __forceinline__ unsigned xb_add(unsigned* p, unsigned v) { return __hip_atomic_fetch_add(p, v, __ATOMIC_RELAXED, __HIP_MEMORY_SCOPE_AGENT); }
__device__ __forceinline__ unsigned xb_xcc_id() { return (unsigned)__builtin_amdgcn_s_getreg((3 << 11) | 20) & 0xFu; }
#define XB_SPIN(cond, bar) do { unsigned _sp = 0; while (cond) { __builtin_amdgcn_s_sleep(1); \
    if ((++_sp & 255u) == 0u) { if (xb_ld(&(bar)[XB_TMO])) break; if (_sp > XB_SPIN_CAP) { atomicAdd(&(bar)[XB_TMO], 1u); break; } } } } while (0)

struct XcdBarrier {
    unsigned* bar; unsigned x;
    volatile LAS unsigned* st;
};

__device__ __forceinline__ XcdBarrier xcd_barrier_post(unsigned* bar, volatile LAS unsigned* st) {
    XcdBarrier b; b.bar = bar; b.x = xb_xcc_id(); b.st = st;
    if (threadIdx.x == 0) (void)xb_add(&bar[XB_XCNT(b.x)], 1u);
    return b;
}
__device__ __forceinline__ void xcd_barrier_complete(unsigned* bar, unsigned x, unsigned& nloc, unsigned& nx) {
    const unsigned G = gridDim.x * gridDim.y * gridDim.z;
    unsigned sum, cnt, mine, sp = 0u;
    for (;;) {
        sum = 0u; cnt = 0u; mine = 0u;
#pragma unroll
        for (unsigned j = 0; j < 16; ++j) { const unsigned c = xb_ld(&bar[XB_XCNT(j)]); sum += c; cnt += (c > 0u) ? 1u : 0u; mine = (j == x) ? c : mine; }
        if (sum == G) break;
        __builtin_amdgcn_s_sleep(1);
        if ((++sp & 255u) == 0u) { if (xb_ld(&bar[XB_TMO])) break; if (sp > XB_SPIN_CAP) { atomicAdd(&bar[XB_TMO], 1u); break; } }
    }
    nloc = mine > 0u ? mine : 1u; nx = cnt > 0u ? cnt : 1u;
}

__device__ __forceinline__ void xcd_barrier(const XcdBarrier& b) {
    asm volatile("s_waitcnt vmcnt(0)" ::: "memory");
    __syncthreads();
    if (threadIdx.x == 0) {
        unsigned* bar = b.bar;
        __builtin_amdgcn_s_waitcnt(0);
        unsigned nloc = b.st[0], nx = b.st[1];
        if (nloc == 0u) { xcd_barrier_complete(bar, b.x, nloc, nx); b.st[0] = nloc; b.st[1] = nx; }
        const unsigned old = xb_add(&bar[XB_XSUB(b.x)], 1u);
        const unsigned gen = old / nloc;
        if (old + 1u == (gen + 1u) * nloc) {
            __builtin_amdgcn_fence(__ATOMIC_RELEASE, "agent");
            asm volatile("s_waitcnt vmcnt(0)" ::: "memory");
            const unsigned og = xb_add(&bar[XB_TOP], 1u);
            const unsigned tg = og / nx;
            if (og + 1u == (tg + 1u) * nx) xb_add(&bar[XB_TOPGEN], 1u);
            else XB_SPIN(xb_ld(&bar[XB_TOPGEN]) == tg, bar);
            __builtin_amdgcn_fence(__ATOMIC_ACQUIRE, "agent");
            xb_add(&bar[XB_XGEN(b.x)], 1u);
            asm volatile("s_waitcnt vmcnt(0)" ::: "memory");
        } else {
            XB_SPIN(xb_ld(&bar[XB_XGEN(b.x)]) == gen, bar);
            __builtin_amdgcn_fence(__ATOMIC_ACQUIRE, "agent");
            asm volatile("s_waitcnt vmcnt(0)" ::: "memory");
        }
    }
    __syncthreads();
}

__device__ __forceinline__ bf16_t f2bf(float f) { unsigned u = __float_as_uint(f); u += 0x7FFFu + ((u >> 16) & 1u); return (bf16_t)(u >> 16); }
__device__ __forceinline__ float bf2f(bf16_t h) { return __uint_as_float(((unsigned)h) << 16); }
typedef __bf16 bf2_t __attribute__((ext_vector_type(2)));
typedef float f2_t __attribute__((ext_vector_type(2)));
__device__ __forceinline__ unsigned pack2(float a, float b) { f2_t v = {a, b}; bf2_t h = __builtin_convertvector(v, bf2_t); return __builtin_bit_cast(unsigned, h); }
__device__ __forceinline__ float siluf(float x) { return x * __builtin_amdgcn_rcpf(1.0f + __expf(-x)); }
__device__ __forceinline__ float sigmf(float x) { return __builtin_amdgcn_rcpf(1.0f + __expf(-x)); }
__device__ __forceinline__ float tanh_fast(float x) { return 1.0f - 2.0f * __builtin_amdgcn_rcpf(1.0f + __expf(2.0f * x)); }
__device__ __forceinline__ float wave_sum(float v) {
#define WS_DPP(x, ctrl, rmask) __int_as_float(__builtin_amdgcn_update_dpp(0, __float_as_int(x), ctrl, rmask, 0xF, false))
    v += WS_DPP(v, 0xB1, 0xF);
    v += WS_DPP(v, 0x4E, 0xF);
    v += WS_DPP(v, 0x141, 0xF);
    v += WS_DPP(v, 0x140, 0xF);
    v += WS_DPP(v, 0x142, 0xA);
    v += WS_DPP(v, 0x143, 0xC);
#undef WS_DPP
    return __int_as_float(__builtin_amdgcn_readlane(__float_as_int(v), 63));
}

__device__ __forceinline__ void ld4bf(const bf16_t* p, float (&o)[4]) { uint2 q = *(const uint2*)p; o[0] = bf2f((bf16_t)(q.x & 0xFFFF)); o[1] = bf2f((bf16_t)(q.x >> 16)); o[2] = bf2f((bf16_t)(q.y & 0xFFFF)); o[3] = bf2f((bf16_t)(q.y >> 16)); }
__device__ __forceinline__ void st4bf(bf16_t* p, float a0, float a1, float a2, float a3) { uint2 q; q.x = pack2(a0, a1); q.y = pack2(a2, a3); *(uint2*)p = q; }

__device__ __forceinline__ void cvt_tile(const float* __restrict__ src, int ldS, int k0, int sc0, bf16_t* __restrict__ dst, int ldD, int dr0, unsigned char* lds) {
    bf16_t* t = (bf16_t*)lds;
    const int tid = threadIdx.x;
    float4 v[2];
#pragma unroll
    for (int i = 0; i < 2; ++i) v[i] = *(const float4*)(src + (size_t)(k0 + (tid >> 3) + 64 * i) * ldS + sc0 + (tid & 7) * 4);
#pragma unroll
    for (int i = 0; i < 2; ++i) {
        const int k = (tid >> 3) + 64 * i, n = (tid & 7) * 4;
        t[(n + 0) * 136 + k] = f2bf(v[i].x); t[(n + 1) * 136 + k] = f2bf(v[i].y); t[(n + 2) * 136 + k] = f2bf(v[i].z); t[(n + 3) * 136 + k] = f2bf(v[i].w);
    }
    __syncthreads();
    {
        const int n = tid >> 4, k8 = (tid & 15) * 8;
        *(uint4*)(dst + (size_t)(dr0 + n) * ldD + k0 + k8) = *(const uint4*)(t + n * 136 + k8);
    }
    __syncthreads();
}

template <class TF>
__device__ __forceinline__ void cvt_stream(int total, int b0, int nb, TF tf, unsigned char* lds) {
    const int tid = threadIdx.x;
    int w = b0; if (w >= total) return;
    const float* sp; int ldS; bf16_t* dp; int ldD;
    tf(w, sp, ldS, dp, ldD);
    float4 v0 = *(const float4*)(sp + (size_t)(tid >> 3) * ldS + (tid & 7) * 4), v1 = *(const float4*)(sp + (size_t)((tid >> 3) + 64) * ldS + (tid & 7) * 4);
    int buf = 0;
    for (; w < total; w += nb) {
        bf16_t* dcur = dp; const int ldc = ldD;
        const float4 c0 = v0, c1 = v1;
        if (w + nb < total) {
            tf(w + nb, sp, ldS, dp, ldD);
            v0 = *(const float4*)(sp + (size_t)(tid >> 3) * ldS + (tid & 7) * 4); v1 = *(const float4*)(sp + (size_t)((tid >> 3) + 64) * ldS + (tid & 7) * 4);
        }
        bf16_t* t = (bf16_t*)(lds + buf * 8704);
        {
            const int k = tid >> 3, n = (tid & 7) * 4;
            t[(n + 0) * 136 + k] = f2bf(c0.x); t[(n + 1) * 136 + k] = f2bf(c0.y); t[(n + 2) * 136 + k] = f2bf(c0.z); t[(n + 3) * 136 + k] = f2bf(c0.w);
            t[(n + 0) * 136 + k + 64] = f2bf(c1.x); t[(n + 1) * 136 + k + 64] = f2bf(c1.y); t[(n + 2) * 136 + k + 64] = f2bf(c1.z); t[(n + 3) * 136 + k + 64] = f2bf(c1.w);
        }
        __syncthreads();
        {
            const int n = tid >> 4, k8 = (tid & 15) * 8;
            *(uint4*)(dcur + (size_t)n * ldc + k8) = *(const uint4*)(t + n * 136 + k8);
        }
        buf ^= 1;
    }
    __syncthreads();
}

constexpr int ECONV_L0_TAIL = 8192;
__device__ __forceinline__ int win_src_col(int n) {
    if (n < 1024) return n;
    if (n < 1536) return 1824 + (n - 1024);
    if (n < 1792) return 2336 + (n - 1536);
    if (n < 2592) return 1024 + (n - 1792);
    return n;
}

__device__ __forceinline__ void phase_convert(const Args& a, int l, unsigned char* lds, bool do_main, bool do_experts, int b0, int nb, int elo = 0, int ehi = 3 * 4096) {
    unsigned char* ws = a.ws;
    if (do_main) {
        {
            const float* src = a.in[9] + (size_t)l * 1024 * PIN;
            bf16_t* dst = (bf16_t*)(ws + WS_WIN);
            cvt_stream(8 * 209, b0, nb, [=](int w, const float*& sp, int& ldS, bf16_t*& dp, int& ldD) {
                const int kt = w & 7, nt = w >> 3; sp = src + (size_t)(kt * 128) * PIN + win_src_col(nt * 32); ldS = PIN; dp = dst + (size_t)(nt * 32) * 1024 + kt * 128; ldD = 1024; }, lds);
        }
        for (int w4 = b0; w4 < 4 * 2 * 32; w4 += nb) {
            const int i = w4 >> 6, w = w4 & 63;
            const float* src = a.in[37] + ((size_t)l * 4 + i) * 256 * 1024;
            bf16_t* dst = (bf16_t*)(ws + WS_WBR) + (size_t)i * 1024 * 256;
            const int kt = w & 1, nt = w >> 1; cvt_tile(src, 1024, kt * 128, nt * 32, dst, 256, nt * 32, lds);
        }
        {
            const float* src = a.in[38] + (size_t)l * 1024 * 1024;
            bf16_t* dst = (bf16_t*)(ws + WS_WOUT);
            for (int w = b0; w < 8 * 32; w += nb) { int kt = w & 7, nt = w >> 3; cvt_tile(src, 1024, kt * 128, nt * 32, dst, 1024, nt * 32, lds); }
        }
        {
            bf16_t* r1 = (bf16_t*)(ws + WS_RW1); bf16_t* r2 = (bf16_t*)(ws + WS_RW2);
            const float* w1 = a.in[12] + (size_t)l * 2 * 256 * 32; const float* a1 = a.in[15] + (size_t)l * 2 * 256 * 32; const float* g1 = a.in[20] + (size_t)l * 256 * 64;
            const float* w2 = a.in[13] + (size_t)l * 2 * 32 * 256; const float* a2 = a.in[16] + (size_t)l * 2 * 32 * 256; const float* g2 = a.in[21] + (size_t)l * 64 * 256;
            for (int i = b0 * NTHREADS + threadIdx.x; i < 192 * 256; i += nb * NTHREADS) {
                const int k = i & 255, n = i >> 8; float v;
                if (n < 64) v = w1[((n >> 5) * 256 + k) * 32 + (n & 31)]; else if (n < 128) v = a1[(((n - 64) >> 5) * 256 + k) * 32 + (n & 31)]; else v = g1[k * 64 + (n - 128)];
                r1[i] = f2bf(v);
            }
            for (int i = b0 * NTHREADS + threadIdx.x; i < 4 * 256 * 32; i += nb * NTHREADS) {
                const int k = i & 31, n = (i >> 5) & 255, blk = i >> 13;
                const float v = (blk < 2) ? w2[(blk * 32 + k) * 256 + n] : a2[((blk - 2) * 32 + k) * 256 + n];
                r2[i] = f2bf(v);
            }
            for (int i = b0 * NTHREADS + threadIdx.x; i < 256 * 64; i += nb * NTHREADS) { const int k = i & 63, n = i >> 6; r2[4 * 256 * 32 + i] = f2bf(g2[k * 256 + n]); }
        }
        {
            const float* src = a.in[35] + (size_t)l * 256 * 256;
            bf16_t* dst = (bf16_t*)(ws + WS_WGLU);
            for (int w = b0; w < 2 * 8; w += nb) { int kt = w & 1, nt = w >> 1; cvt_tile(src, 256, kt * 128, nt * 32, dst, 256, nt * 32, lds); }
        }
        {
            float* dst = (float*)(ws + WS_WRT);
            const float* wg = a.in[39] + (size_t)l * 1024 * 4;
            const float* we = a.in[41] + (size_t)l * 1024 * 32;
            for (int i = b0 * NTHREADS + threadIdx.x; i < 36 * 1024; i += nb * NTHREADS) {
                int o = i >> 10, k = i & 1023;
                dst[i] = (o < 4) ? wg[k * 4 + o] : we[k * 32 + (o - 4)];
            }
        }
    }
    if (do_experts) {
        const float* g0 = a.in[43] + (size_t)l * NEXP * 1024 * EH; const float* u0 = a.in[44] + (size_t)l * NEXP * 1024 * EH; const float* d0 = a.in[45] + (size_t)l * NEXP * EH * 1024;
        bf16_t* dg = (bf16_t*)(ws + WS_BIG + BIG_WEG); bf16_t* du = (bf16_t*)(ws + WS_BIG + BIG_WEU); bf16_t* dd = (bf16_t*)(ws + WS_BIG + BIG_WED);
        cvt_stream(ehi - elo, b0, nb, [=](int w0, const float*& sp, int& ldS, bf16_t*& dp, int& ldD) {
            const int w = w0 + elo;
            const int which = w >> 12, r2 = w & 4095, e = r2 >> 7, r = r2 & 127;
            if (which < 2) { const int kt = r & 7, nt = r >> 3; sp = (which ? u0 : g0) + (size_t)e * 1024 * EH + (size_t)(kt * 128) * EH + nt * 32; ldS = EH;
                             dp = (which ? du : dg) + (size_t)e * EH * 1024 + (size_t)(nt * 32) * 1024 + kt * 128; ldD = 1024; }
            else { const int kt = r & 3, nt = r >> 2; sp = d0 + (size_t)e * EH * 1024 + (size_t)(kt * 128) * 1024 + nt * 32; ldS = 1024;
                   dp = dd + (size_t)e * 1024 * EH + (size_t)(nt * 32) * EH + kt * 128; ldD = EH; }
        }, lds);
    }
}

__device__ __forceinline__ void phase_ada(const Args& a, unsigned char* lds) {
    float* sil = (float*)lds;
    float* red = (float*)(lds + 9 * 1024 * 4);
    const int tid = threadIdx.x;
    for (int i = tid; i < 9 * 1024; i += NTHREADS) {
        int v = i >> 10, k = i & 1023;
        float x = (v < 8) ? a.in[1][v * 1024 + k] : a.in[3][k];
        sil[i] = siluf(x);
    }
    __syncthreads();
    float* mods = (float*)(a.ws + WS_MODS);
    const int tx = tid & 15, ty = tid >> 4;
    for (int w = blockIdx.x; w < 2 * 96; w += gridDim.x) {
        const int l = w / 96, n0 = (w % 96) * 64;
        const float* wa = a.in[7] + (size_t)l * 1024 * 6144 + n0 + 4 * tx;
        float acc[9][4];
#pragma unroll
        for (int v = 0; v < 9; ++v) { acc[v][0] = 0.f; acc[v][1] = 0.f; acc[v][2] = 0.f; acc[v][3] = 0.f; }
#pragma unroll 4
        for (int kk = 0; kk < 32; ++kk) {
            const int k = ty * 32 + kk;
            const float4 wv = *(const float4*)(wa + (size_t)k * 6144);
#pragma unroll
            for (int v = 0; v < 9; ++v) { const float sv = sil[v * 1024 + k]; acc[v][0] += sv * wv.x; acc[v][1] += sv * wv.y; acc[v][2] += sv * wv.z; acc[v][3] += sv * wv.w; }
        }
#pragma unroll
        for (int v = 0; v < 9; ++v) *(float4*)(red + (ty * 9 + v) * 64 + 4 * tx) = make_float4(acc[v][0], acc[v][1], acc[v][2], acc[v][3]);
        __syncthreads();
        for (int i = tid; i < 9 * 64; i += NTHREADS) {
            const int v = i >> 6, x = i & 63; float sacc = 0.f;
            for (int y = 0; y < 32; ++y) sacc += red[(y * 9 + v) * 64 + x];
            mods[((size_t)l * 9 + v) * 6144 + n0 + x] = sacc + a.in[8][(size_t)l * 6144 + n0 + x];
        }
        __syncthreads();
    }
}

__device__ __forceinline__ void moe_offsets(const Args& a, int l, int* s_start  , int* s_cnt  ) {
    const unsigned* cnt = (const unsigned*)(a.ws + WS_CNT) + l * 64;
    if (threadIdx.x < 32) s_cnt[threadIdx.x] = (int)cnt[threadIdx.x];
    __syncthreads();
    if (threadIdx.x == 0) { int s = 0; for (int e = 0; e < 32; ++e) { s_start[e] = s; s += s_cnt[e]; } s_start[32] = s; }
    __syncthreads();
}

__device__ __forceinline__ void phase_norm1(const Args& a, int mode, unsigned char* lds) {
    int* s_start = (int*)lds; int* s_cnt = s_start + 64;
    if (mode > 0) moe_offsets(a, mode - 1, s_start, s_cnt);
    int tid = threadIdx.x; asm volatile("" : "+v"(tid));
    const int lane = tid & 63, wv = tid >> 6;
    const int l = (mode == 2) ? 1 : mode;
    const float* mods = (const float*)(a.ws + WS_MODS) + (size_t)l * 9 * 6144;
    const float* pmods = (const float*)(a.ws + WS_MODS) + (size_t)(mode > 0 ? mode - 1 : 0) * 9 * 6144;
    const float* g = (mode == 2) ? a.in[6] : a.in[4] + (size_t)l * 1024;
    bf16_t* H = (bf16_t*)(a.ws + WS_H);
    const bf16_t* YD = (const bf16_t*)(a.ws + WS_BIG + BIG_YD);
    const uint4* tinfo = (const uint4*)(a.ws + WS_TINFO);
    float* XC = (float*)(a.ws + WS_XC);
    const int nrows = (mode == 2) ? NLAT : NROW;
    const int gw = blockIdx.x * 8 + wv, nw = gridDim.x * 8;
    float* M5 = (float*)(lds + 1024);
    float* GS = M5 + 9 * 1024;
    float* SHV = GS + 9 * 1024;
    for (int i = tid; i < 9 * 1024; i += NTHREADS) {
        const int c = i & 1023, b = i >> 10;
        if (mode > 0) M5[i] = pmods[(size_t)b * 6144 + 5 * 1024 + c];
        if (mode == 2) GS[i] = g[c];
        else { GS[i] = g[c] * (1.f + mods[(size_t)b * 6144 + 1024 + c]); SHV[i] = mods[(size_t)b * 6144 + c]; }
    }
    __syncthreads();
    auto xsrc = [&](int r) -> const float* {
        if (r < NLAT) return (mode == 0) ? a.in[0] + (size_t)r * 1024 : a.out + (size_t)r * 1024;
        return (mode == 0) ? a.in[2] + (size_t)(r - NLAT) * 1024 : XC + (size_t)(r - NLAT) * 1024;
    };
    float4 nv[4]; uint4 nti = make_uint4(0u, 0u, 0u, 0u);
    if (gw < nrows) {
        const float* xr0 = xsrc(gw);
#pragma unroll
        for (int i = 0; i < 2; ++i) { nv[2 * i] = ((const float4*)xr0)[(lane + 64 * i) * 2]; nv[2 * i + 1] = ((const float4*)xr0)[(lane + 64 * i) * 2 + 1]; }
        if (mode > 0) nti = tinfo[gw];
    }
#pragma unroll 1
    for (int r = gw; r < nrows; r += nw) {
        const bool lat = r < NLAT;
        const int bj = lat ? (r >> 12) : 8;
        float* xw = lat ? a.out + (size_t)r * 1024 : XC + (size_t)(r - NLAT) * 1024;
        float4 v[4];
#pragma unroll
        for (int i = 0; i < 4; ++i) v[i] = nv[i];
        const uint4 ti_cur = nti;
        {
            const int rn = min(r + nw, nrows - 1);
            const float* xrn = xsrc(rn);
#pragma unroll
            for (int i = 0; i < 2; ++i) { nv[2 * i] = ((const float4*)xrn)[(lane + 64 * i) * 2]; nv[2 * i + 1] = ((const float4*)xrn)[(lane + 64 * i) * 2 + 1]; }
            if (mode > 0) nti = tinfo[rn];
        }
        if (mode > 0) {
            const uint4 ti = ti_cur;
            const int e0 = ti.x >> 24, p0 = ti.x & 0xFFFFFF, e1 = ti.z >> 24, p1 = ti.z & 0xFFFFFF;
            const float w0 = __uint_as_float(ti.y), w1 = __uint_as_float(ti.w);
            const bf16_t* y0 = YD + (size_t)(s_start[e0] + p0) * 1024;
            const bf16_t* y1 = YD + (size_t)(s_start[e1] + p1) * 1024;
            const float* m5 = M5 + bj * 1024;
#pragma unroll
            for (int i = 0; i < 2; ++i) {
                const int c = (lane + 64 * i) * 8;
                const uint4 q0 = *(const uint4*)(y0 + c), q1 = *(const uint4*)(y1 + c);
                const float4 ma = *(const float4*)(m5 + c), mb = *(const float4*)(m5 + c + 4);
                v[2 * i].x += ma.x * (w0 * bf2f((bf16_t)(q0.x & 0xFFFF)) + w1 * bf2f((bf16_t)(q1.x & 0xFFFF)));
                v[2 * i].y += ma.y * (w0 * bf2f((bf16_t)(q0.x >> 16)) + w1 * bf2f((bf16_t)(q1.x >> 16)));
                v[2 * i].z += ma.z * (w0 * bf2f((bf16_t)(q0.y & 0xFFFF)) + w1 * bf2f((bf16_t)(q1.y & 0xFFFF)));
                v[2 * i].w += ma.w * (w0 * bf2f((bf16_t)(q0.y >> 16)) + w1 * bf2f((bf16_t)(q1.y >> 16)));
                v[2 * i + 1].x += mb.x * (w0 * bf2f((bf16_t)(q0.z & 0xFFFF)) + w1 * bf2f((bf16_t)(q1.z & 0xFFFF)));
                v[2 * i + 1].y += mb.y * (w0 * bf2f((bf16_t)(q0.z >> 16)) + w1 * bf2f((bf16_t)(q1.z >> 16)));
                v[2 * i + 1].z += mb.z * (w0 * bf2f((bf16_t)(q0.w & 0xFFFF)) + w1 * bf2f((bf16_t)(q1.w & 0xFFFF)));
                v[2 * i + 1].w += mb.w * (w0 * bf2f((bf16_t)(q0.w >> 16)) + w1 * bf2f((bf16_t)(q1.w >> 16)));
            }
            if (mode == 1) {
#pragma unroll
                for (int i = 0; i < 2; ++i) { ((float4*)xw)[(lane + 64 * i) * 2] = v[2 * i]; ((float4*)xw)[(lane + 64 * i) * 2 + 1] = v[2 * i + 1]; }
            }
        }
        float ss = 0.f;
#pragma unroll
        for (int i = 0; i < 4; ++i) ss += v[i].x * v[i].x + v[i].y * v[i].y + v[i].z * v[i].z + v[i].w * v[i].w;
        ss = wave_sum(ss);
        const float rs = rsqrtf(ss * (1.0f / 1024.0f) + 1e-6f);
        const float* gsp = GS + bj * 1024;
        if (mode == 2) {
#pragma unroll
            for (int i = 0; i < 2; ++i) {
                const int c = (lane + 64 * i) * 8;
                const float4 ga = *(const float4*)(gsp + c), gb = *(const float4*)(gsp + c + 4);
                float4 oa, ob;
                oa.x = v[2 * i].x * rs * ga.x; oa.y = v[2 * i].y * rs * ga.y; oa.z = v[2 * i].z * rs * ga.z; oa.w = v[2 * i].w * rs * ga.w;
                ob.x = v[2 * i + 1].x * rs * gb.x; ob.y = v[2 * i + 1].y * rs * gb.y; ob.z = v[2 * i + 1].z * rs * gb.z; ob.w = v[2 * i + 1].w * rs * gb.w;
                ((float4*)xw)[(lane + 64 * i) * 2] = oa; ((float4*)xw)[(lane + 64 * i) * 2 + 1] = ob;
            }
        } else {
            const float* shp = SHV + bj * 1024;
#pragma unroll
            for (int i = 0; i < 2; ++i) {
                const int c = (lane + 64 * i) * 8;
                const float4 ga = *(const float4*)(gsp + c), gb = *(const float4*)(gsp + c + 4), sa = *(const float4*)(shp + c), sb = *(const float4*)(shp + c + 4);
                uint4 w;
                w.x = pack2(v[2 * i].x * rs * ga.x + sa.x, v[2 * i].y * rs * ga.y + sa.y); w.y = pack2(v[2 * i].z * rs * ga.z + sa.z, v[2 * i].w * rs * ga.w + sa.w);
                w.z = pack2(v[2 * i + 1].x * rs * gb.x + sb.x, v[2 * i + 1].y * rs * gb.y + sb.y); w.w = pack2(v[2 * i + 1].z * rs * gb.z + sb.z, v[2 * i + 1].w * rs * gb.w + sb.w);
                *(uint4*)(H + (size_t)r * 1024 + c) = w;
            }
        }
    }
}

__device__ __forceinline__ unsigned char* hist_base_bytes(unsigned char* lds) { return lds + 112 * 1024; }
__device__ __forceinline__ void phase_norm2(const Args& a, int l, unsigned char* lds) {
    int tid = threadIdx.x; asm volatile("" : "+v"(tid));
    const int lane = tid & 63, wv = tid >> 6, fr = lane & 15, fq = lane >> 4;
    const int nrows = (l == 0) ? NROW : NLAT;
    const int per = nrows / 256;
    const int rbase = blockIdx.x * per;
    constexpr int HP = 1026;
    float* HT = (float*)lds;
    float* PART = (float*)(lds + 16 * HP * 4);
    float* LOG = PART + 8 * 16 * 48;
    int* PKE = (int*)(LOG + 16 * 40);
    float* PKW = (float*)(PKE + 272);
    const float* mods = (const float*)(a.ws + WS_MODS) + (size_t)l * 9 * 6144;
    const float* g = a.in[5] + (size_t)l * 1024;
    const float* wrt = (const float*)(a.ws + WS_WRT);
    const float* bg = a.in[40] + l * 4; const float* be = a.in[42] + l * 32;
    bf16_t* H = (bf16_t*)(a.ws + WS_H);
    const float* XC = (const float*)(a.ws + WS_XC);
    float bw[32][3];
#pragma unroll
    for (int nt = 0; nt < 3; ++nt) {
        const int o = 16 * nt + fr;
#pragma unroll
        for (int k4 = 0; k4 < 8; ++k4) {
            const float4 w4 = *(const float4*)(wrt + (size_t)min(o, 35) * 1024 + 128 * wv + 32 * fq + 4 * k4);
            const float zk = (o < 36) ? 1.0f : 0.0f;
            bw[4 * k4][nt] = w4.x * zk; bw[4 * k4 + 1][nt] = w4.y * zk; bw[4 * k4 + 2][nt] = w4.z * zk; bw[4 * k4 + 3][nt] = w4.w * zk;
        }
    }
    float* GS = (float*)(hist_base_bytes(lds));
    float* SHV = GS + 2048;
    float* M2V = SHV + 2048;
    const int b_lo = (rbase < NLAT) ? (rbase >> 12) : 8;
    for (int i = tid; i < 2048; i += NTHREADS) {
        const int j = i >> 10, c = i & 1023, b = min(b_lo + j, 8);
        GS[i] = g[c] * (1.f + mods[(size_t)b * 6144 + 4 * 1024 + c]); SHV[i] = mods[(size_t)b * 6144 + 3 * 1024 + c]; M2V[i] = mods[(size_t)b * 6144 + 2 * 1024 + c];
    }
    __syncthreads();
    const bf16_t* DLT = (const bf16_t*)(a.ws + WS_BIG + BIG_Y);
    float* XCw = (float*)(a.ws + WS_XC);
    auto xsrc = [=](int r) -> const float* { return (r < NLAT) ? ((l == 0) ? a.in[0] : a.out) + (size_t)r * 1024 : ((l == 0) ? a.in[2] : XC) + (size_t)(r - NLAT) * 1024; };
    const int ntile = (per + 15) / 16;
    float4 xv[2][4]; uint2 dv[2][4];
#pragma unroll
    for (int u = 0; u < 2; ++u) {
        const int ri = 2 * wv + u;
        const int r = rbase + ri;
        const float* xr = xsrc(r);
#pragma unroll
        for (int i = 0; i < 4; ++i) { xv[u][i] = ((const float4*)xr)[lane + 64 * i]; dv[u][i] = *(const uint2*)(DLT + (size_t)r * 1024 + (lane + 64 * i) * 4); }
    }
#pragma unroll 1
    for (int tile = 0; tile < ntile; ++tile) {
#pragma unroll
        for (int u = 0; u < 2; ++u) {
            const int rl = 2 * wv + u, ri = tile * 16 + rl;
            if (ri < per) {
                const int r = rbase + ri;
                const bool lat = r < NLAT; const int b = lat ? (r >> 12) : 8;
                float4 v[4]; float ss = 0.f;
                const float* m2p = M2V + (b - b_lo) * 1024;
                float* xw = lat ? a.out + (size_t)r * 1024 : XCw + (size_t)(r - NLAT) * 1024;
#pragma unroll
                for (int i = 0; i < 4; ++i) {
                    const float4 mv = *(const float4*)(m2p + (lane + 64 * i) * 4); const uint2 dq = dv[u][i];
                    v[i] = xv[u][i];
                    v[i].x += mv.x * bf2f((bf16_t)(dq.x & 0xFFFF)); v[i].y += mv.y * bf2f((bf16_t)(dq.x >> 16));
                    v[i].z += mv.z * bf2f((bf16_t)(dq.y & 0xFFFF)); v[i].w += mv.w * bf2f((bf16_t)(dq.y >> 16));
                    ((float4*)xw)[lane + 64 * i] = v[i];
                    ss += v[i].x * v[i].x + v[i].y * v[i].y + v[i].z * v[i].z + v[i].w * v[i].w;
                }
                ss = wave_sum(ss);
                const float rs = rsqrtf(ss * (1.0f / 1024.0f) + 1e-6f);
                const float* gsp = GS + (b - b_lo) * 1024; const float* shp = SHV + (b - b_lo) * 1024;
#pragma unroll
                for (int i = 0; i < 4; ++i) {
                    const int c = (lane + 64 * i) * 4;
                    const float4 gg = *(const float4*)(gsp + c), s4 = *(const float4*)(shp + c);
                    const float o0 = v[i].x * rs * gg.x + s4.x, o1 = v[i].y * rs * gg.y + s4.y;
                    const float o2 = v[i].z * rs * gg.z + s4.z, o3 = v[i].w * rs * gg.w + s4.w;
                    uint2 w; w.x = pack2(o0, o1); w.y = pack2(o2, o3);
                    *(uint2*)(H + (size_t)r * 1024 + c) = w;
                    *(float2*)(HT + rl * HP + c) = make_float2(o0, o1); *(float2*)(HT + rl * HP + c + 2) = make_float2(o2, o3);
                }
            }
        }
        __syncthreads();
#pragma unroll
        for (int u = 0; u < 2; ++u) {
            const int ri = (tile + 1) * 16 + 2 * wv + u;
            if (ri < per) {
                const int r = rbase + ri;
                const float* xr = xsrc(r);
#pragma unroll
                for (int i = 0; i < 4; ++i) { xv[u][i] = ((const float4*)xr)[lane + 64 * i]; dv[u][i] = *(const uint2*)(DLT + (size_t)r * 1024 + (lane + 64 * i) * 4); }
            }
        }
        {
            f32x4 acc[3];
#pragma unroll
            for (int nt = 0; nt < 3; ++nt) acc[nt] = (f32x4){0.f, 0.f, 0.f, 0.f};
            const float* hp = HT + fr * HP + 128 * wv + 32 * fq;
#pragma unroll
            for (int k2 = 0; k2 < 16; ++k2) {
                if ((k2 & 3) == 0) asm volatile("" ::: "memory");
                const float2 a2 = *(const float2*)(hp + 2 * k2);
#pragma unroll
                for (int nt = 0; nt < 3; ++nt) acc[nt] = __builtin_amdgcn_mfma_f32_16x16x4f32(a2.x, bw[2 * k2][nt], acc[nt], 0, 0, 0);
#pragma unroll
                for (int nt = 0; nt < 3; ++nt) acc[nt] = __builtin_amdgcn_mfma_f32_16x16x4f32(a2.y, bw[2 * k2 + 1][nt], acc[nt], 0, 0, 0);
            }
#pragma unroll
            for (int nt = 0; nt < 3; ++nt)
#pragma unroll
                for (int j = 0; j < 4; ++j) PART[(wv * 16 + 4 * fq + j) * 48 + 16 * nt + fr] = acc[nt][j];
        }
        __syncthreads();
#pragma unroll
        for (int u = 0; u < 2; ++u) {
            const int rl = 2 * wv + u;
            float lg = -3.0e38f;
            if (lane < 36) {
                float sacc = (lane < 4) ? bg[lane] : be[lane - 4];
#pragma unroll
                for (int w = 0; w < 8; ++w) sacc += PART[(w * 16 + rl) * 48 + lane];
                lg = sacc;
            }
            const float l0 = __shfl(lg, 0), l1 = __shfl(lg, 1), l2 = __shfl(lg, 2), l3 = __shfl(lg, 3);
            float g0 = l0; int gs = 0;
            if (l1 > g0) { g0 = l1; gs = 1; }
            if (l2 > g0) { g0 = l2; gs = 2; }
            if (l3 > g0) { g0 = l3; gs = 3; }
            const float den = __expf(l0 - g0) + __expf(l1 - g0) + __expf(l2 - g0) + __expf(l3 - g0);
            const float gwgt = 1.0f / den;
            const float ev = __shfl(lg, 4 + gs * 8 + (lane & 7));
            float el[8];
#pragma unroll
            for (int i = 0; i < 8; ++i) el[i] = __shfl(ev, i);
            int i0 = 0; float v0 = el[0];
#pragma unroll
            for (int i = 1; i < 8; ++i) if (el[i] > v0) { v0 = el[i]; i0 = i; }
            int i1 = -1; float v1 = -3.0e38f;
#pragma unroll
            for (int i = 0; i < 8; ++i) if (i != i0 && el[i] > v1) { v1 = el[i]; i1 = i; }
            const float e1 = __expf(v1 - v0);
            const int ri = tile * 16 + rl;
            if (lane == 0 && ri < per) {
                PKE[ri * 2] = gs * 8 + i0; PKW[ri * 2] = gwgt / (1.f + e1);
                PKE[ri * 2 + 1] = gs * 8 + i1; PKW[ri * 2 + 1] = gwgt * e1 / (1.f + e1);
            }
        }
    }
    __syncthreads();
    unsigned* cnt = (unsigned*)(a.ws + WS_CNT) + l * 64;
    int* stok = (int*)(a.ws + WS_STOK);
    unsigned* tinfo = (unsigned*)(a.ws + WS_TINFO);
    unsigned* hist = (unsigned*)(PKW + 272);
    static_assert(NEXP <= 64, "slot histogram");
    if (tid < 64) hist[tid] = 0u;
    __syncthreads();
    const bool has = tid < per * 2;
    int e = 0; unsigned lr = 0u;
    if (has) { e = PKE[tid]; lr = atomicAdd(&hist[e], 1u); }
    __syncthreads();
    if (tid < NEXP) { const unsigned c = hist[tid]; hist[tid] = c ? atomicAdd(&cnt[tid], c) : 0u; }
    __syncthreads();
    if (has) {
        const int r = rbase + (tid >> 1);
        const unsigned p = hist[e] + lr;
        stok[(size_t)e * MOE_CAP + p] = r;
        tinfo[(size_t)r * 4 + (tid & 1) * 2 + 0] = ((unsigned)e << 24) | p;
        tinfo[(size_t)r * 4 + (tid & 1) * 2 + 1] = __float_as_uint(PKW[tid]);
    }
}

#define XCD_UNITS(w, total) for (int _cs = ((total) + 7) >> 3, _i = (int)(blockIdx.x >> 3), w = (int)(blockIdx.x & 7) * _cs + _i; _i < _cs; _i += 32, w += 32) if (w < (total))
constexpr int G_ASZ = 256 * 128;
template <int NT> struct GemmCfg { static constexpr int BN = 32 * NT, BSZ = BN * 128, STAGE = G_ASZ + BSZ, NLD = 4 + NT / 2; };
constexpr int G_LDS = 3 * GemmCfg<4>::STAGE;

template <int NT, class AF, class BF>
__device__ __forceinline__ void gemm_pipe(f32x4 (&acc)[4][NT], AF aofn, BF bofn, int K, unsigned char* lds, const unsigned char* wsbase) {
    constexpr int STAGE = GemmCfg<NT>::STAGE;
    const int tid = threadIdx.x, lane = tid & 63, wid = tid >> 6, wr = wid >> 1, wc = wid & 1, fr = lane & 15, fq = lane >> 4;
    const int nt = K / 64;
    const int srow = tid >> 3; const unsigned schunk = ((tid & 7) ^ (srow & 7)) * 16;
    const unsigned ap0 = aofn(srow) + schunk, ap1 = aofn(srow + 64) + schunk, ap2 = aofn(srow + 128) + schunk, ap3 = aofn(srow + 192) + schunk;
    const unsigned bp0 = bofn(srow) + schunk, bp1 = (NT == 4) ? bofn(srow + 64) + schunk : bp0;
    auto stage = [&](int t, int buf) {
        unsigned char* base = lds + buf * STAGE + tid * 16;
        const unsigned char* gb = wsbase + (size_t)t * 128;
        __builtin_amdgcn_global_load_lds((const unsigned*)(gb + ap0), LDSP(base), 16, 0, 0);
        __builtin_amdgcn_global_load_lds((const unsigned*)(gb + ap1), LDSP(base + 8192), 16, 0, 0);
        __builtin_amdgcn_global_load_lds((const unsigned*)(gb + ap2), LDSP(base + 16384), 16, 0, 0);
        __builtin_amdgcn_global_load_lds((const unsigned*)(gb + ap3), LDSP(base + 24576), 16, 0, 0);
        __builtin_amdgcn_global_load_lds((const unsigned*)(gb + bp0), LDSP(base + G_ASZ), 16, 0, 0);
        if (NT == 4) __builtin_amdgcn_global_load_lds((const unsigned*)(gb + bp1), LDSP(base + G_ASZ + 8192), 16, 0, 0);
    };
    stage(0, 0);
    if (nt > 1) stage(1, 1);
    const int aoff = (wr * 64 + fr) * 128, boff = G_ASZ + (wc * 16 * NT + fr) * 128, sw = fr & 7;
    int buf = 0;
    for (int t = 0; t < nt; ++t) {
        if (t + 1 < nt) { if (NT == 4) asm volatile("s_waitcnt vmcnt(6)" ::: "memory"); else asm volatile("s_waitcnt vmcnt(5)" ::: "memory"); }
        else asm volatile("s_waitcnt vmcnt(0)" ::: "memory");
        __builtin_amdgcn_s_barrier();
        asm volatile("" ::: "memory");
        if (t + 2 < nt) { int nb = buf + 2; if (nb >= 3) nb -= 3; stage(t + 2, nb); }
        const unsigned char* base = lds + buf * STAGE;
#pragma unroll
        for (int kh = 0; kh < 2; ++kh) {
            bf16x8 af[4], bfr[NT];
            const int ch = ((kh * 4 + fq) ^ sw) * 16;
#pragma unroll
            for (int m = 0; m < 4; ++m) af[m] = *(const bf16x8*)(base + aoff + m * 2048 + ch);
#pragma unroll
            for (int n = 0; n < NT; ++n) bfr[n] = *(const bf16x8*)(base + boff + n * 2048 + ch);
            __builtin_amdgcn_s_setprio(1);
#pragma unroll
            for (int m = 0; m < 4; ++m)
#pragma unroll
                for (int n = 0; n < NT; ++n) acc[m][n] = __builtin_amdgcn_mfma_f32_16x16x32_bf16(bfr[n], af[m], acc[m][n], 0, 0, 0);
            __builtin_amdgcn_s_setprio(0);
        }
        ++buf; if (buf == 3) buf = 0;
    }
    __builtin_amdgcn_s_barrier();
    asm volatile("" ::: "memory");
}

template <int NT, class AF1, class BF1, class AF2, class BF2, class SW>
__device__ __forceinline__ void gemm_pipe_seg(f32x4 (&acc)[4][NT], AF1 a1, BF1 b1, int K1, AF2 a2, BF2 b2, int K2, SW on_switch, unsigned char* lds, const unsigned char* wsbase, int koff1 = 0, int koff2 = 0) {
    constexpr int STAGE = GemmCfg<NT>::STAGE;
    const int tid = threadIdx.x, lane = tid & 63, wid = tid >> 6, wr = wid >> 1, wc = wid & 1, fr = lane & 15, fq = lane >> 4;
    const int nt1 = K1 / 64, nt = nt1 + K2 / 64;
    const int srow = tid >> 3; const unsigned schunk = ((tid & 7) ^ (srow & 7)) * 16;
    const unsigned p1[6] = {a1(srow) + schunk, a1(srow + 64) + schunk, a1(srow + 128) + schunk, a1(srow + 192) + schunk, b1(srow) + schunk, (NT == 4) ? b1(srow + 64) + schunk : 0u};
    const unsigned p2[6] = {a2(srow) + schunk, a2(srow + 64) + schunk, a2(srow + 128) + schunk, a2(srow + 192) + schunk, b2(srow) + schunk, (NT == 4) ? b2(srow + 64) + schunk : 0u};
    auto stage = [&](int t, int buf) {
        unsigned char* base = lds + buf * STAGE + tid * 16;
        const bool s1 = t < nt1;
        const unsigned char* gb = wsbase + (size_t)(s1 ? ((t + koff1) & (nt1 - 1)) : ((t - nt1 + koff2) & (nt - nt1 - 1))) * 128;
        __builtin_amdgcn_global_load_lds((const unsigned*)(gb + (s1 ? p1[0] : p2[0])), LDSP(base), 16, 0, 0);
        __builtin_amdgcn_global_load_lds((const unsigned*)(gb + (s1 ? p1[1] : p2[1])), LDSP(base + 8192), 16, 0, 0);
        __builtin_amdgcn_global_load_lds((const unsigned*)(gb + (s1 ? p1[2] : p2[2])), LDSP(base + 16384), 16, 0, 0);
        __builtin_amdgcn_global_load_lds((const unsigned*)(gb + (s1 ? p1[3] : p2[3])), LDSP(base + 24576), 16, 0, 0);
        __builtin_amdgcn_global_load_lds((const unsigned*)(gb + (s1 ? p1[4] : p2[4])), LDSP(base + G_ASZ), 16, 0, 0);
        if (NT == 4) __builtin_amdgcn_global_load_lds((const unsigned*)(gb + (s1 ? p1[5] : p2[5])), LDSP(base + G_ASZ + 8192), 16, 0, 0);
    };
    stage(0, 0);
    stage(1, 1);
    const int aoff = (wr * 64 + fr) * 128, boff = G_ASZ + (wc * 16 * NT + fr) * 128, sw = fr & 7;
    int buf = 0;
    for (int t = 0; t < nt; ++t) {
        if (t + 1 < nt) { if (NT == 4) asm volatile("s_waitcnt vmcnt(6)" ::: "memory"); else asm volatile("s_waitcnt vmcnt(5)" ::: "memory"); } else asm volatile("s_waitcnt vmcnt(0)" ::: "memory");
        __builtin_amdgcn_s_barrier();
        asm volatile("" ::: "memory");
        if (t + 2 < nt) { int nb = buf + 2; if (nb >= 3) nb -= 3; stage(t + 2, nb); }
        const unsigned char* base = lds + buf * STAGE;
#pragma unroll
        for (int kh = 0; kh < 2; ++kh) {
            bf16x8 af[4], bfr[NT];
            const int ch = ((kh * 4 + fq) ^ sw) * 16;
#pragma unroll
            for (int m = 0; m < 4; ++m) af[m] = *(const bf16x8*)(base + aoff + m * 2048 + ch);
#pragma unroll
            for (int n = 0; n < NT; ++n) bfr[n] = *(const bf16x8*)(base + boff + n * 2048 + ch);
            __builtin_amdgcn_s_setprio(1);
#pragma unroll
            for (int m = 0; m < 4; ++m)
#pragma unroll
                for (int n = 0; n < NT; ++n) acc[m][n] = __builtin_amdgcn_mfma_f32_16x16x32_bf16(bfr[n], af[m], acc[m][n], 0, 0, 0);
            __builtin_amdgcn_s_setprio(0);
        }
        if (t == nt1 - 1) on_switch(acc);
        ++buf; if (buf == 3) buf = 0;
    }
    __builtin_amdgcn_s_barrier();
    asm volatile("" ::: "memory");
}

namespace g8 {
constexpr int BK = 64, HALF = 128, HTB = HALF * BK * 2;
__device__ __forceinline__ int lds_byte(int r, int c) { const int st = (r >> 4) * 2 + (c >> 5), rr = r & 15, cc = c & 31, ob = rr * 64 + cc * 2; return st * 1024 + (ob ^ (((ob >> 9) & 1) << 5)); }
__device__ __forceinline__ void stage_rc(int b, int& R, int& C) { const int st = b / 1024, sb = b % 1024, swz = sb ^ (((sb >> 9) & 1) << 5); R = (st >> 1) * 16 + swz / 64; C = (st & 1) * 32 + (swz % 64) / 2; }
}
#define G8_WAIT_V(n) asm volatile("s_waitcnt vmcnt(" #n ")" ::: "memory")
#define G8_WAIT_L(n) asm volatile("s_waitcnt lgkmcnt(" #n ")" ::: "memory")
#define G8_BAR __builtin_amdgcn_s_barrier()
#define G8_SCHED __builtin_amdgcn_sched_barrier(0)

template <bool ASTORE, class AF, class BF>
__device__ __forceinline__ void gemm8p(f32x4 (&acc)[2][2][4][2], AF aoff, BF boff, int K, unsigned char* lds, const unsigned char* wsbase) {
    using namespace g8;
    unsigned sa[2][2];
    if (ASTORE) {
#pragma unroll
        for (int i = 0; i < 2; ++i) { int R, C; stage_rc(threadIdx.x * 16 + i * 8192, R, C);
#pragma unroll
            for (int h = 0; h < 2; ++h) sa[h][i] = aoff(h * HALF + R) + C * 2; }
    }
    auto srcoff = [&](int T, int op, int h, int i) -> unsigned {
        int R, C; stage_rc(T * 16 + i * 8192, R, C);
        if (op == 0) return ASTORE ? sa[h][i] : (aoff(h * HALF + R) + C * 2);
        return boff(h * HALF + R) + C * 2;
    };
#define G8_SA(b, h) (lds + ((b) * 2 + (h)) * HTB)
#define G8_SB(b, h) (lds + (4 + (b) * 2 + (h)) * HTB)
#define G8_STAGE_X(T, P, OP, H, kt) do { _Pragma("unroll") for (int _i = 0; _i < 2; ++_i) \
        __builtin_amdgcn_global_load_lds((const unsigned*)(wsbase + srcoff(T, OP, H, _i) + (size_t)(kt) * (BK * 2)), LDSP((P) + (T) * 16 + _i * 8192), 16, 0, 0); } while (0)
#define G8_STAGE(P, OP, H, kt) G8_STAGE_X(tq, P, OP, H, kt)
#define G8_LDA(dst, b, h) _Pragma("unroll") for (int m = 0; m < 4; ++m) _Pragma("unroll") for (int k = 0; k < 2; ++k) \
        dst[m][k] = *(const bf16x8*)(G8_SA(b, h) + lds_byte(wr * 64 + m * 16 + fr, k * 32 + fq * 8))
#define G8_LDB(dst, b, h) _Pragma("unroll") for (int n = 0; n < 2; ++n) _Pragma("unroll") for (int k = 0; k < 2; ++k) \
        dst[n][k] = *(const bf16x8*)(G8_SB(b, h) + lds_byte(wc * 32 + n * 16 + fr, k * 32 + fq * 8))
#define G8_MMA(ai, bj, At, Bt) do { __builtin_amdgcn_s_setprio(1); \
        _Pragma("unroll") for (int m = 0; m < 4; ++m) _Pragma("unroll") for (int n = 0; n < 2; ++n) _Pragma("unroll") for (int k = 0; k < 2; ++k) \
            acc[ai][bj][m][n] = __builtin_amdgcn_mfma_f32_16x16x32_bf16(Bt[n][k], At[m][k], acc[ai][bj][m][n], 0, 0, 0); \
        __builtin_amdgcn_s_setprio(0); } while (0)
    int wid = threadIdx.x >> 6, lane = threadIdx.x & 63, wr = wid >> 2, wc = wid & 3, fr = lane & 15, fq = lane >> 4;
    bf16x8 At[4][2], B0[2][2], B1[2][2];
    const int nt = K / BK;
    int tq = threadIdx.x; asm volatile("" : "+v"(tq));
    G8_STAGE(G8_SB(0, 0), 1, 0, 0); G8_STAGE(G8_SA(0, 0), 0, 0, 0);
    G8_STAGE(G8_SB(0, 1), 1, 1, 0); G8_STAGE(G8_SA(0, 1), 0, 1, 0);
    if (wr == 1) G8_BAR;
    G8_WAIT_V(4); G8_BAR;
    G8_STAGE(G8_SB(1, 0), 1, 0, 1); G8_STAGE(G8_SA(1, 0), 0, 0, 1); G8_STAGE(G8_SB(1, 1), 1, 1, 1);
    G8_WAIT_V(6); G8_BAR;
    for (int t = 0; t < nt - 2; t += 2) {
        tq = threadIdx.x; asm volatile("" : "+v"(tq));
        G8_LDB(B0, 0, 0); G8_SCHED; G8_LDA(At, 0, 0); G8_STAGE(G8_SA(1, 1), 0, 1, t + 1);
        G8_WAIT_L(8); G8_BAR; G8_WAIT_L(0); G8_MMA(0, 0, At, B0); G8_BAR; G8_SCHED;
        G8_LDB(B1, 0, 1); G8_STAGE(G8_SB(0, 0), 1, 0, t + 2);
        G8_BAR; G8_WAIT_L(0); G8_MMA(0, 1, At, B1); G8_BAR;
        G8_LDA(At, 0, 1); G8_STAGE(G8_SA(0, 0), 0, 0, t + 2);
        G8_BAR; G8_WAIT_L(0); G8_MMA(1, 0, At, B0); G8_BAR; G8_SCHED;
        G8_STAGE(G8_SB(0, 1), 1, 1, t + 2);
        G8_WAIT_V(6); G8_BAR; G8_MMA(1, 1, At, B1); G8_BAR;
        G8_LDB(B0, 1, 0); G8_SCHED; G8_LDA(At, 1, 0); G8_STAGE(G8_SA(0, 1), 0, 1, t + 2);
        G8_WAIT_L(8); G8_BAR; G8_WAIT_L(0); G8_MMA(0, 0, At, B0); G8_BAR; G8_SCHED;
        G8_LDB(B1, 1, 1); G8_STAGE(G8_SB(1, 0), 1, 0, t + 3);
        G8_BAR; G8_WAIT_L(0); G8_MMA(0, 1, At, B1); G8_BAR;
        G8_LDA(At, 1, 1); G8_STAGE(G8_SA(1, 0), 0, 0, t + 3);
        G8_BAR; G8_WAIT_L(0); G8_MMA(1, 0, At, B0); G8_BAR; G8_SCHED;
        G8_STAGE(G8_SB(1, 1), 1, 1, t + 3);
        G8_WAIT_V(6); G8_BAR; G8_MMA(1, 1, At, B1); G8_BAR;
    }
    int tz = threadIdx.x; asm volatile("" : "+v"(tz)); wid = tz >> 6; lane = tz & 63; wr = wid >> 2; wc = wid & 3; fr = lane & 15; fq = lane >> 4;
    { G8_LDB(B0, 0, 0); G8_WAIT_V(0); G8_LDA(At, 0, 0); G8_STAGE_X(tz, G8_SA(1, 1), 0, 1, nt - 1);
      G8_BAR; G8_WAIT_L(0); G8_MMA(0, 0, At, B0); G8_BAR;
      G8_LDB(B1, 0, 1); G8_BAR; G8_WAIT_L(0); G8_MMA(0, 1, At, B1); G8_BAR;
      G8_LDA(At, 0, 1); G8_WAIT_V(4); G8_BAR; G8_WAIT_L(0); G8_MMA(1, 0, At, B0); G8_MMA(1, 1, At, B1); G8_BAR; }
    { G8_LDB(B0, 1, 0); G8_LDA(At, 1, 0); G8_WAIT_V(2); G8_BAR; G8_WAIT_L(0); G8_MMA(0, 0, At, B0); G8_BAR;
      G8_LDB(B1, 1, 1); G8_WAIT_V(0); G8_BAR; G8_WAIT_L(0); G8_MMA(0, 1, At, B1); G8_BAR;
      G8_LDA(At, 1, 1); G8_BAR; G8_WAIT_L(0); G8_MMA(1, 0, At, B0); G8_MMA(1, 1, At, B1); G8_BAR; }
    if (wr == 0) G8_BAR;
    __syncthreads();
#undef G8_SA
#undef G8_SB
#undef G8_STAGE_X
#undef G8_STAGE
#undef G8_LDA
#undef G8_LDB
#undef G8_MMA
}

template <class UF, class EF>
__device__ __forceinline__ void gemm8s(UF unit_fn, unsigned pitchA, unsigned pitchB, int K, EF epi, unsigned char* lds, const unsigned char* wsbase) {
    using namespace g8;
    const int tid = threadIdx.x, wid = __builtin_amdgcn_readfirstlane(tid >> 6), lane = tid & 63, wr = wid >> 2, wc = wid & 3, fr = lane & 15, fq = lane >> 4;
    const int nt = K / BK;
    unsigned voffA[2], voffB[2];
#pragma unroll
    for (int i = 0; i < 2; ++i) { int R, C; stage_rc(tid * 16 + i * 8192, R, C); voffA[i] = (unsigned)R * pitchA + (unsigned)C * 2u;
        const int p = R & 31, Rp = (R & ~31) | (((p & 15) >> 2) * 8 + (p >> 4) * 4 + (p & 3)); voffB[i] = (unsigned)Rp * pitchB + (unsigned)C * 2u; }
    const size_t kstep = (size_t)(BK * 2);
    const size_t hstepA = (size_t)HALF * pitchA, hstepB = (size_t)HALF * pitchB;
    const unsigned ldsw = (unsigned)wid * 1024u;
    const int aoff = lds_byte(wr * 64 + fr, fq * 8), boff = lds_byte(wc * 32 + fr, fq * 8);
#define S8_SA(b, h) (((b) * 2 + (h)) * HTB)
#define S8_SB(b, h) ((4 + (b) * 2 + (h)) * HTB)
#define S8_STAGE(bufoff, gbase, voff) do { _Pragma("unroll") for (int _i = 0; _i < 2; ++_i) \
        __builtin_amdgcn_global_load_lds((const unsigned*)((const unsigned char*)(gbase) + (voff)[_i]), LDSP(lds + (bufoff) + ldsw + _i * 8192), 16, 0, 0); } while (0)
#define S8_LDA(dst, b, h) do { _Pragma("unroll") for (int m = 0; m < 4; ++m) _Pragma("unroll") for (int k = 0; k < 2; ++k) dst[m][k] = *(const bf16x8*)(lds + S8_SA(b, h) + aoff + m * 2048 + k * 1024); } while (0)
#define S8_LDB(dst, b, h) do { _Pragma("unroll") for (int n = 0; n < 2; ++n) _Pragma("unroll") for (int k = 0; k < 2; ++k) dst[n][k] = *(const bf16x8*)(lds + S8_SB(b, h) + boff + n * 2048 + k * 1024); } while (0)
#define S8_MMA(ai, bj, At, Bt) do { __builtin_amdgcn_s_setprio(1); _Pragma("unroll") for (int m = 0; m < 4; ++m) _Pragma("unroll") for (int n = 0; n < 2; ++n) _Pragma("unroll") for (int k = 0; k < 2; ++k) \
        acc[ai][bj][m][n] = __builtin_amdgcn_mfma_f32_16x16x32_bf16(Bt[n][k], At[m][k], acc[ai][bj][m][n], 0, 0, 0); __builtin_amdgcn_s_setprio(0); } while (0)
    unsigned caB, cbB, naB, nbB; int ctag, ntag, ui = 0;
    if (!unit_fn(0, caB, cbB, ctag)) return;
    f32x4 acc[2][2][4][2];
#pragma unroll
    for (int a_ = 0; a_ < 2; ++a_)
#pragma unroll
        for (int b_ = 0; b_ < 2; ++b_)
#pragma unroll
            for (int m = 0; m < 4; ++m)
#pragma unroll
                for (int n = 0; n < 2; ++n) acc[a_][b_][m][n] = (f32x4){0.f, 0.f, 0.f, 0.f};
    bf16x8 At[4][2], B0[2][2], B1[2][2];
    const unsigned char* cA = wsbase + caB; const unsigned char* cB = wsbase + cbB;
    S8_STAGE(S8_SB(0, 0), cB, voffB); S8_STAGE(S8_SA(0, 0), cA, voffA); S8_STAGE(S8_SB(0, 1), cB + hstepB, voffB); S8_STAGE(S8_SA(0, 1), cA + hstepA, voffA);
    if (wr == 1) G8_BAR;
    G8_WAIT_V(4); G8_BAR;
    S8_STAGE(S8_SB(1, 0), cB + kstep, voffB); S8_STAGE(S8_SA(1, 0), cA + kstep, voffA); S8_STAGE(S8_SB(1, 1), cB + hstepB + kstep, voffB);
    G8_WAIT_V(6); G8_BAR;
    for (;;) {
        const bool has_next = unit_fn(ui + 1, naB, nbB, ntag);
        const unsigned char* nA = has_next ? wsbase + naB : cA; const unsigned char* nB = has_next ? wsbase + nbB : cB;
        for (int t = 0; t < nt; t += 2) {
            const bool last = (t == nt - 2);
            const unsigned char* a1 = cA + (size_t)(t + 1) * kstep;
            const unsigned char* a2 = last ? nA : cA + (size_t)(t + 2) * kstep; const unsigned char* b2 = last ? nB : cB + (size_t)(t + 2) * kstep;
            const unsigned char* a3 = a2 + kstep; const unsigned char* b3 = b2 + kstep;
            S8_LDB(B0, 0, 0); G8_SCHED; S8_LDA(At, 0, 0); S8_STAGE(S8_SA(1, 1), a1 + hstepA, voffA);
            G8_WAIT_L(8); G8_BAR; G8_WAIT_L(0); S8_MMA(0, 0, At, B0); G8_BAR; G8_SCHED;
            S8_LDB(B1, 0, 1); S8_STAGE(S8_SB(0, 0), b2, voffB);
            G8_BAR; G8_WAIT_L(0); S8_MMA(0, 1, At, B1); G8_BAR;
            S8_LDA(At, 0, 1); S8_STAGE(S8_SA(0, 0), a2, voffA);
            G8_BAR; G8_WAIT_L(0); S8_MMA(1, 0, At, B0); G8_BAR; G8_SCHED;
            S8_STAGE(S8_SB(0, 1), b2 + hstepB, voffB);
            G8_WAIT_V(6); G8_BAR; S8_MMA(1, 1, At, B1); G8_BAR;
            S8_LDB(B0, 1, 0); G8_SCHED; S8_LDA(At, 1, 0); S8_STAGE(S8_SA(0, 1), a2 + hstepA, voffA);
            G8_WAIT_L(8); G8_BAR; G8_WAIT_L(0); S8_MMA(0, 0, At, B0); G8_BAR; G8_SCHED;
            S8_LDB(B1, 1, 1); S8_STAGE(S8_SB(1, 0), b3, voffB);
            G8_BAR; G8_WAIT_L(0); S8_MMA(0, 1, At, B1); G8_BAR;
            S8_LDA(At, 1, 1); S8_STAGE(S8_SA(1, 0), a3, voffA);
            G8_BAR; G8_WAIT_L(0); S8_MMA(1, 0, At, B0); G8_BAR; G8_SCHED;
            S8_STAGE(S8_SB(1, 1), b3 + hstepB, voffB);
            G8_WAIT_V(6); G8_BAR; S8_MMA(1, 1, At, B1); G8_BAR;
        }
        epi(acc, ctag);
        if (!has_next) break;
#pragma unroll
        for (int a_ = 0; a_ < 2; ++a_)
#pragma unroll
            for (int b_ = 0; b_ < 2; ++b_)
#pragma unroll
                for (int m = 0; m < 4; ++m)
#pragma unroll
                    for (int n = 0; n < 2; ++n) acc[a_][b_][m][n] = (f32x4){0.f, 0.f, 0.f, 0.f};
        cA = nA; cB = nB; ctag = ntag; ++ui;
    }
    G8_WAIT_V(0);
    if (wr == 0) G8_BAR;
    G8_BAR;
#undef S8_SA
#undef S8_SB
#undef S8_STAGE
#undef S8_LDA
#undef S8_LDB
#undef S8_MMA
}

__device__ __forceinline__ void phase_moe1(const Args& a, int l, unsigned char* lds) {
    int* s_start = (int*)(lds + G_LDS); int* s_cnt = s_start + 64; int* s_tile = s_cnt + 64;
    moe_offsets(a, l, s_start, s_cnt);
    if (threadIdx.x == 0) { int s = 0; for (int e = 0; e < 32; ++e) { s_tile[e] = s; s += (s_cnt[e] + 255) >> 8; } s_tile[32] = s; }
    __syncthreads();
    const int ntiles = s_tile[32];
    const bf16_t* H = (const bf16_t*)(a.ws + WS_H);
    const bf16_t* WG = (const bf16_t*)(a.ws + WS_BIG + BIG_WEG);
    bf16_t* HID = (bf16_t*)(a.ws + WS_BIG + BIG_HID);
    const int* stok = (const int*)(a.ws + WS_STOK);
    XCD_UNITS(w, ntiles * 4) {
        const int rt_g = w >> 2, ntile = w & 3;
        int e = 0; while (s_tile[e + 1] <= rt_g) ++e;
        const int rt = rt_g - s_tile[e], cnt = s_cnt[e], n0 = ntile * 128;
        f32x4 acc[2][2][4][2];
#pragma unroll
        for (int i0 = 0; i0 < 2; ++i0)
#pragma unroll
            for (int i1 = 0; i1 < 2; ++i1)
#pragma unroll
                for (int m = 0; m < 4; ++m)
#pragma unroll
                    for (int n = 0; n < 2; ++n) acc[i0][i1][m][n] = (f32x4){0.f, 0.f, 0.f, 0.f};
        gemm8p<true>(acc, [=](int r) -> unsigned { int p = rt * 256 + r; if (p >= cnt) p = 0; return (unsigned)(WS_H + (size_t)stok[(size_t)e * MOE_CAP + p] * 2048); },
               [=](int rho) -> unsigned { const int p5 = rho & 31, rp = (rho & 96) | (((p5 & 15) >> 2) * 8 + (p5 >> 4) * 4 + (p5 & 3));
                   return (unsigned)(WS_BIG + BIG_WEG + ((size_t)(rho >> 7) * ((size_t)NEXP * EH * 1024) + ((size_t)e * EH + n0 + rp) * 1024) * 2); }, 1024, lds, a.ws);
        int tid = threadIdx.x; asm volatile("" : "+v"(tid));
        const int lane = tid & 63, wid = tid >> 6, wr = wid >> 2, wc = wid & 3, fr = lane & 15, fq = lane >> 4;
#pragma unroll
        for (int ai = 0; ai < 2; ++ai)
#pragma unroll
            for (int m = 0; m < 4; ++m) {
                const int p = rt * 256 + ai * 128 + wr * 64 + m * 16 + fr;
                if (p < cnt) {
                    bf16_t* orow = HID + (size_t)(s_start[e] + p) * EH + n0 + wc * 32 + fq * 8;
                    uint4 o;
                    { const f32x4 gt = acc[ai][0][m][0], up = acc[ai][1][m][0]; o.x = pack2(siluf(gt[0]) * up[0], siluf(gt[1]) * up[1]); o.y = pack2(siluf(gt[2]) * up[2], siluf(gt[3]) * up[3]); }
                    { const f32x4 gt = acc[ai][0][m][1], up = acc[ai][1][m][1]; o.z = pack2(siluf(gt[0]) * up[0], siluf(gt[1]) * up[1]); o.w = pack2(siluf(gt[2]) * up[2], siluf(gt[3]) * up[3]); }
                    *(uint4*)orow = o;
                }
            }
    }
}

__device__ __forceinline__ void phase_moe2(const Args& a, int l, unsigned char* lds) {
    int* s_start = (int*)(lds + G_LDS); int* s_cnt = s_start + 64; int* s_tile = s_cnt + 64;
    moe_offsets(a, l, s_start, s_cnt);
    if (threadIdx.x == 0) { int s = 0; for (int e = 0; e < 32; ++e) { s_tile[e] = s; s += (s_cnt[e] + 255) >> 8; } s_tile[32] = s; }
    __syncthreads();
    const int TOTAL = s_tile[32] * 4, CS = (TOTAL + 7) >> 3;
    bf16_t* YD = (bf16_t*)(a.ws + WS_BIG + BIG_YD);
    const int xcd = blockIdx.x & 7, j0 = blockIdx.x >> 3;
    auto unit_fn = [=](int i, unsigned& aB, unsigned& bB, int& tag) -> bool {
        const int k = j0 + 32 * i; if (k >= CS) return false;
        const int w = xcd * CS + k; if (w >= TOTAL) return false;
        const int rt_g = w >> 2, ntile = w & 3;
        int e = 0; while (s_tile[e + 1] <= rt_g) ++e;
        const int rt = rt_g - s_tile[e];
        aB = (unsigned)(WS_BIG + BIG_HID + (size_t)(s_start[e] + rt * 256) * (EH * 2)); bB = (unsigned)(WS_BIG + BIG_WED + ((size_t)e * 1024 + ntile * 256) * (EH * 2));
        tag = (e << 16) | (rt << 2) | ntile; return true;
    };
    auto epi = [=](const f32x4 (&acc)[2][2][4][2], int tag) {
        const int e = tag >> 16, rt = (tag >> 2) & 0x3FFF, n0 = (tag & 3) * 256, cnt = s_cnt[e], st0 = s_start[e];
        int tid = threadIdx.x; asm volatile("" : "+v"(tid));
        const int lane = tid & 63, wid = tid >> 6, wr = wid >> 2, wc = wid & 3, fr = lane & 15, fq = lane >> 4;
#pragma unroll
        for (int ai = 0; ai < 2; ++ai)
#pragma unroll
            for (int m = 0; m < 4; ++m) {
                const int p = rt * 256 + ai * 128 + wr * 64 + m * 16 + fr;
                if (p < cnt) {
                    bf16_t* orow = YD + (size_t)(st0 + p) * 1024 + n0 + wc * 32 + fq * 8;
#pragma unroll
                    for (int bj = 0; bj < 2; ++bj) {
                        uint4 o; o.x = pack2(acc[ai][bj][m][0][0], acc[ai][bj][m][0][1]); o.y = pack2(acc[ai][bj][m][0][2], acc[ai][bj][m][0][3]);
                        o.z = pack2(acc[ai][bj][m][1][0], acc[ai][bj][m][1][1]); o.w = pack2(acc[ai][bj][m][1][2], acc[ai][bj][m][1][3]);
                        *(uint4*)(orow + bj * 128) = o;
                    }
                }
            }
    };
    gemm8s(unit_fn, (unsigned)(EH * 2), (unsigned)(EH * 2), EH, epi, lds, a.ws);
    __syncthreads();
}

__device__ __forceinline__ void phase_s5params(const Args& a, int l) {
    float2* abar = (float2*)(a.ws + WS_S5P);
    float2* bbar = abar + 2 * 16 * 64;
    for (int i = blockIdx.x * NTHREADS + threadIdx.x; i < 2 * 16 * 64 * 16; i += gridDim.x * NTHREADS) {
        const int c = i & 15, p = (i >> 4) & 63, g = (i >> 10) & 15, d = i >> 14;
        const float lre = a.in[27][((l * 2 + d) * 16 + g) * 64 + p], lim = a.in[28][((l * 2 + d) * 16 + g) * 64 + p];
        const float dt = __expf(a.in[29][(l * 2 + d) * 16 + g]);
        const float mag = __expf(lre * dt); float sn, cs; sincosf(lim * dt, &sn, &cs);
        const float are = mag * cs, aim = mag * sn;
        if (c == 0) abar[(d * 16 + g) * 64 + p] = make_float2(are, aim);
        { float2* PW = (float2*)(a.ws + WS_S5PW); const float fl = (float)c; const float mg = __expf(lre * dt * fl); float s2, c2; sincosf(lim * dt * fl, &s2, &c2); PW[((d * 16 + g) * 64 + p) * 17 + c] = make_float2(mg * c2, mg * s2);
          if (c == 0) { const float m16 = __expf(lre * dt * 16.f); sincosf(lim * dt * 16.f, &s2, &c2); PW[((d * 16 + g) * 64 + p) * 17 + 16] = make_float2(m16 * c2, m16 * s2); } }
        const float nre = are - 1.f, nim = aim, den = lre * lre + lim * lim;
        const float qre = (nre * lre + nim * lim) / den, qim = (nim * lre - nre * lim) / den;
        const float bre = a.in[30][((l * 16 + g) * 64 + p) * 16 + c], bim = a.in[31][((l * 16 + g) * 64 + p) * 16 + c];
        bbar[i] = make_float2(qre * bre - qim * bim, qre * bim + qim * bre);
    }
}

__device__ __forceinline__ void phase_g1(const Args& a, unsigned char* lds) {
    bf16_t* U = (bf16_t*)(a.ws + WS_BIG + BIG_U); bf16_t* AC = (bf16_t*)(a.ws + WS_BIG + T_AC);
    constexpr int TOTAL = (NLAT / 256) * 10, CS = TOTAL / 8;
    static_assert(TOTAL == 5 * 256 && UW == 2592 && NCTX == 2048, "G1 unit map");
    const int xcd = blockIdx.x & 7, j0 = blockIdx.x >> 3;
    auto unit_fn = [=](int i, unsigned& aB, unsigned& bB, int& tag) -> bool {
        const int k = j0 + 32 * i; if (k >= CS) return false;
        const int w = xcd * CS + k;
        const int mt = w / 10, ntl = w % 10;
        aB = (unsigned)(WS_H + (size_t)mt * 256 * 2048); bB = (unsigned)(WS_WIN + (size_t)ntl * 256 * 2048); tag = w; return true;
    };
    auto store_u = [=](int row, int col, uint2 o) {
        if (col >= U_S5 && col < U_S5 + 256) {
            const int cc = col - U_S5, g = cc >> 4, c = cc & 15;
            const int b = (row < NLAT) ? (row >> 12) : ((row - NLAT) >> 8), pos = (row < NLAT) ? (256 + (row & 4095)) : ((row - NLAT) & 255);
            *(uint2*)(AC + (((size_t)g * 2176 + b * 272 + (pos >> 4)) * 512 + (pos & 15) * 16 + c)) = o;
        } else *(uint2*)(U + (size_t)row * UW + col) = o;
    };
    auto store_u8 = [=](int row, int col, uint4 o) {
        if (col >= U_S5 && col < U_S5 + 256) {
            const int cc = col - U_S5, g = cc >> 4, c = cc & 15;
            const int b = (row < NLAT) ? (row >> 12) : ((row - NLAT) >> 8), pos = (row < NLAT) ? (256 + (row & 4095)) : ((row - NLAT) & 255);
            *(uint4*)(AC + (((size_t)g * 2176 + b * 272 + (pos >> 4)) * 512 + (pos & 15) * 16 + c)) = o;
        } else *(uint4*)(U + (size_t)row * UW + col) = o;
    };
    auto epi = [=](const f32x4 (&acc)[2][2][4][2], int w) {
        const int r0 = (w / 10) * 256, n0 = (w % 10) * 256;
        int tid = threadIdx.x; asm volatile("" : "+v"(tid));
        const int lane = tid & 63, wid = tid >> 6, wr = wid >> 2, wc = wid & 3, fr = lane & 15, fq = lane >> 4;
#pragma unroll
        for (int ai = 0; ai < 2; ++ai)
#pragma unroll
            for (int m = 0; m < 4; ++m) {
                const int row = r0 + ai * 128 + wr * 64 + m * 16 + fr;
#pragma unroll
                for (int bj = 0; bj < 2; ++bj) {
                    const int col = n0 + bj * 128 + wc * 32 + fq * 8;
                    uint4 o; o.x = pack2(acc[ai][bj][m][0][0], acc[ai][bj][m][0][1]); o.y = pack2(acc[ai][bj][m][0][2], acc[ai][bj][m][0][3]);
                    o.z = pack2(acc[ai][bj][m][1][0], acc[ai][bj][m][1][1]); o.w = pack2(acc[ai][bj][m][1][2], acc[ai][bj][m][1][3]);
                    store_u8(row, col, o);
                }
            }
    };
    const bool tail_first = ((blockIdx.x >> 3) & 1) != 0;
    auto tail_fn = [&]() {
    const int bid = blockIdx.x;
    if (bid < 160) {
        const int r0 = NLAT + (bid / 20) * 256, n0 = (bid % 20) * 128;
        f32x4 acc[4][4];
#pragma unroll
        for (int m = 0; m < 4; ++m)
#pragma unroll
            for (int n = 0; n < 4; ++n) acc[m][n] = (f32x4){0.f, 0.f, 0.f, 0.f};
        gemm_pipe<4>(acc, [=](int r) -> unsigned { return (unsigned)(WS_H + (size_t)(r0 + r) * 2048); }, [=](int r) -> unsigned { return (unsigned)(WS_WIN + (size_t)(n0 + r) * 2048); }, 1024, lds, a.ws);
        int tid = threadIdx.x; asm volatile("" : "+v"(tid));
        const int lane = tid & 63, wid = tid >> 6, wr = wid >> 1, wc = wid & 1, fr = lane & 15, fq = lane >> 4;
#pragma unroll
        for (int m = 0; m < 4; ++m)
#pragma unroll
            for (int n = 0; n < 4; ++n) {
                uint2 o; o.x = pack2(acc[m][n][0], acc[m][n][1]); o.y = pack2(acc[m][n][2], acc[m][n][3]);
                store_u(r0 + wr * 64 + m * 16 + fr, n0 + wc * 64 + n * 16 + fq * 4, o);
            }
    } else {
#pragma unroll 1
        for (int p = bid - 160; p < NROW / 256; p += 96) {
            const int r0 = p * 256;
            f32x4 acc[4][2];
#pragma unroll
            for (int m = 0; m < 4; ++m)
#pragma unroll
                for (int n = 0; n < 2; ++n) acc[m][n] = (f32x4){0.f, 0.f, 0.f, 0.f};
            gemm_pipe<2>(acc, [=](int r) -> unsigned { return (unsigned)(WS_H + (size_t)(r0 + r) * 2048); }, [=](int r) -> unsigned { return (unsigned)(WS_WIN + (size_t)(2560 + r) * 2048); }, 1024, lds, a.ws);
            int tid = threadIdx.x; asm volatile("" : "+v"(tid));
            const int lane = tid & 63, wid = tid >> 6, wr = wid >> 1, wc = wid & 1, fr = lane & 15, fq = lane >> 4;
            if (wc == 0) {
#pragma unroll
                for (int m = 0; m < 4; ++m)
#pragma unroll
                    for (int n = 0; n < 2; ++n) {
                        uint2 o; o.x = pack2(acc[m][n][0], acc[m][n][1]); o.y = pack2(acc[m][n][2], acc[m][n][3]);
                        *(uint2*)(U + (size_t)(r0 + wr * 64 + m * 16 + fr) * UW + 2560 + n * 16 + fq * 4) = o;
                    }
            }
        }
    }
    };
    if (tail_first) { tail_fn(); __syncthreads(); }
    gemm8s(unit_fn, 2048u, 2048u, 1024, epi, lds, a.ws);
    __syncthreads();
    if (!tail_first) { tail_fn(); }
    __syncthreads();
}

__device__ __forceinline__ int prm32(int r) { const int p = r & 31; return (r & ~31) | (((p & 15) >> 2) * 8 + (p >> 4) * 4 + (p & 3)); }
template <int NT>
__device__ __forceinline__ void merge_tile(const Args& a, int r0, int n0, unsigned char* lds) {
    bf16_t* MG = (bf16_t*)(a.ws + WS_BIG + BIG_MRG);
    uint2 accm[4][NT];
#pragma unroll
    for (int m = 0; m < 4; ++m)
#pragma unroll
        for (int n = 0; n < NT; ++n) accm[m][n] = make_uint2(0u, 0u);
#pragma unroll 1
    for (int i = 0; i < 4; ++i) {
        uint2 pp[4][NT];
        f32x4 ag[4][NT];
#pragma unroll
        for (int m = 0; m < 4; ++m)
#pragma unroll
            for (int n = 0; n < NT; ++n) ag[m][n] = (f32x4){0.f, 0.f, 0.f, 0.f};
        gemm_pipe_seg<NT>(ag,
            [=](int r) -> unsigned { return (unsigned)(WS_BIG + BIG_Y + ((size_t)(r0 + r) * 1024 + 256 * i) * 2); }, [=](int r) -> unsigned { return (unsigned)(WS_WBR + (size_t)(i * 1024 + n0 + prm32(r)) * 512); }, 256,
            [=](int r) -> unsigned { return (unsigned)(WS_H + (size_t)(r0 + r) * 2048); }, [=](int r) -> unsigned { return (unsigned)(WS_WIN + (size_t)(UW + i * 1024 + n0 + prm32(r)) * 2048); }, 1024,
            [&](f32x4 (&acc)[4][NT]) {
#pragma unroll
                for (int m = 0; m < 4; ++m)
#pragma unroll
                    for (int n = 0; n < NT; ++n) { pp[m][n].x = pack2(acc[m][n][0], acc[m][n][1]); pp[m][n].y = pack2(acc[m][n][2], acc[m][n][3]); acc[m][n] = (f32x4){0.f, 0.f, 0.f, 0.f}; }
            }, lds, a.ws, n0 / (32 * NT), (n0 / (32 * NT)) * 2);
#pragma unroll
        for (int m = 0; m < 4; ++m)
#pragma unroll
            for (int n = 0; n < NT; ++n) {
                const float m0 = bf2f((bf16_t)(accm[m][n].x & 0xFFFF)) + sigmf(ag[m][n][0]) * bf2f((bf16_t)(pp[m][n].x & 0xFFFF)), m1 = bf2f((bf16_t)(accm[m][n].x >> 16)) + sigmf(ag[m][n][1]) * bf2f((bf16_t)(pp[m][n].x >> 16));
                const float m2 = bf2f((bf16_t)(accm[m][n].y & 0xFFFF)) + sigmf(ag[m][n][2]) * bf2f((bf16_t)(pp[m][n].y & 0xFFFF)), m3 = bf2f((bf16_t)(accm[m][n].y >> 16)) + sigmf(ag[m][n][3]) * bf2f((bf16_t)(pp[m][n].y >> 16));
                accm[m][n].x = pack2(m0, m1); accm[m][n].y = pack2(m2, m3);
            }
    }
    int tq = threadIdx.x; asm volatile("" : "+v"(tq));
    const int lane = tq & 63, wid = tq >> 6, wr = wid >> 1, wc = wid & 1, fr = lane & 15, fq = lane >> 4;
#pragma unroll
    for (int m = 0; m < 4; ++m) {
        const int row = r0 + wr * 64 + m * 16 + fr;
#pragma unroll
        for (int np = 0; np < NT / 2; ++np) {
            const int col = n0 + wc * 16 * NT + np * 32 + fq * 8;
            *(uint4*)(MG + (size_t)row * 1024 + col) = make_uint4(accm[m][2 * np].x, accm[m][2 * np].y, accm[m][2 * np + 1].x, accm[m][2 * np + 1].y);
        }
    }
}

__device__ __forceinline__ void phase_merge(const Args& a, int l, unsigned char* lds) {
    XCD_UNITS(w, (NLAT / 256) * 8) merge_tile<4>(a, (w >> 3) * 256, (w & 7) * 128, lds);
    if (l == 0) {
        for (int w = blockIdx.x; w < (NCTX / 256) * 16; w += gridDim.x) merge_tile<2>(a, NLAT + (w >> 4) * 256, (w & 15) * 64, lds);
        if (blockIdx.x >= 128) { __syncthreads(); phase_convert(a, 0, lds, false, true, blockIdx.x - 128, 128, 3 * 4096 - ECONV_L0_TAIL, 3 * 4096); }
    }
}

__device__ __forceinline__ void phase_g3(const Args& a, int l, unsigned char* lds) {
    constexpr int TOTAL = (NLAT / 256) * 4, CS = TOTAL / 8;
    const int xcd = blockIdx.x & 7, j0 = blockIdx.x >> 3;
    auto unit_fn = [=](int i, unsigned& aB, unsigned& bB, int& tag) -> bool {
        const int k = j0 + 32 * i; if (k >= CS) return false;
        const int w = xcd * CS + k;
        aB = (unsigned)(WS_BIG + BIG_MRG + (size_t)(w >> 2) * 256 * 2048); bB = (unsigned)(WS_WOUT + (size_t)(w & 3) * 256 * 2048); tag = w; return true;
    };
    bf16_t* DLT = (bf16_t*)(a.ws + WS_BIG + BIG_Y);
    auto epi = [=](const f32x4 (&acc)[2][2][4][2], int w) {
        const int r0 = (w >> 2) * 256, n0 = (w & 3) * 256;
        int tid = threadIdx.x; asm volatile("" : "+v"(tid));
        const int lane = tid & 63, wid = tid >> 6, wr = wid >> 2, wc = wid & 3, fr = lane & 15, fq = lane >> 4;
#pragma unroll
        for (int ai = 0; ai < 2; ++ai)
#pragma unroll
            for (int m = 0; m < 4; ++m) {
                bf16_t* drow = DLT + (size_t)(r0 + ai * 128 + wr * 64 + m * 16 + fr) * 1024 + n0 + wc * 32 + fq * 8;
#pragma unroll
                for (int bj = 0; bj < 2; ++bj) {
                    uint4 o; o.x = pack2(acc[ai][bj][m][0][0], acc[ai][bj][m][0][1]); o.y = pack2(acc[ai][bj][m][0][2], acc[ai][bj][m][0][3]);
                    o.z = pack2(acc[ai][bj][m][1][0], acc[ai][bj][m][1][1]); o.w = pack2(acc[ai][bj][m][1][2], acc[ai][bj][m][1][3]);
                    *(uint4*)(drow + bj * 128) = o;
                }
            }
    };
    gemm8s(unit_fn, 2048u, 2048u, 1024, epi, lds, a.ws);
    __syncthreads();
    if (l == 0 && blockIdx.x < (NCTX / 256) * 16) {
        const int r0 = NLAT + (blockIdx.x >> 4) * 256, n0 = (blockIdx.x & 15) * 64;
        f32x4 acc[4][2];
#pragma unroll
        for (int m = 0; m < 4; ++m)
#pragma unroll
            for (int n = 0; n < 2; ++n) acc[m][n] = (f32x4){0.f, 0.f, 0.f, 0.f};
        gemm_pipe<2>(acc, [=](int r) -> unsigned { return (unsigned)(WS_BIG + BIG_MRG + (size_t)(r0 + r) * 2048); }, [=](int r) -> unsigned { return (unsigned)(WS_WOUT + (size_t)(n0 + r) * 2048); }, 1024, lds, a.ws);
        int tid = threadIdx.x; asm volatile("" : "+v"(tid));
        const int lane = tid & 63, wid = tid >> 6, wr = wid >> 1, wc = wid & 1, fr = lane & 15, fq = lane >> 4;
#pragma unroll
        for (int m = 0; m < 4; ++m) {
            const int row = r0 + wr * 64 + m * 16 + fr;
#pragma unroll
            for (int n = 0; n < 2; ++n) {
                const int col = n0 + wc * 32 + n * 16 + fq * 4;
                uint2 o; o.x = pack2(acc[m][n][0], acc[m][n][1]); o.y = pack2(acc[m][n][2], acc[m][n][3]);
                *(uint2*)(DLT + (size_t)row * 1024 + col) = o;
            }
        }
    }
    __syncthreads();
}


__device__ __forceinline__ void phase_prep(const Args& a, int l, unsigned char* lds) {
    const int tid = threadIdx.x, lane = tid & 63, wv = tid >> 6, fr = lane & 15, fq = lane >> 4;
    bf16_t* U = (bf16_t*)(a.ws + WS_BIG + BIG_U);
    bf16_t* MIX = (bf16_t*)(a.ws + WS_BIG + T_MIX); bf16_t* EXT = (bf16_t*)(a.ws + WS_BIG + T_EXT);
    const bf16_t* R1 = (const bf16_t*)(a.ws + WS_RW1); const bf16_t* R2 = (const bf16_t*)(a.ws + WS_RW2);
    constexpr int TR = 136, MT = 9;
    unsigned char* xa_l = lds;
    unsigned char* t1_l = lds + 144 * 528;
    const float* mu = a.in[10] + (size_t)l * 1024;
    const float* w0 = a.in[11] + (size_t)l * 512; const float* a0 = a.in[14] + (size_t)l * 512;
    const float* kkp = a.in[17] + (size_t)l * 256;
    for (int tile = blockIdx.x; tile < NROW / TR; tile += gridDim.x) {
        const int r0 = tile * TR;
        {
            const int rw0 = r0 + wv * 17;
            uint2 prv[4], cur[4], nxt[4];
            const int rhd = lane >> 3, rii = (lane & 7) * 4;
            const bool ract = lane < 48;
            uint2 rq1 = make_uint2(0u, 0u), rq2 = make_uint2(0u, 0u), rn1, rn2;
            float rinv[4];
#pragma unroll
            for (int j = 0; j < 4; ++j) rinv[j] = __expf(-(float)((rii + j) & 15) * (9.210340371976184f / 16.0f)) * 0.15915494309189535f;
            if (ract) { const bf16_t* ua0 = U + (size_t)rw0 * UW + U_ATT + rhd * 64 + rii; rq1 = *(const uint2*)ua0; rq2 = *(const uint2*)(ua0 + 32); }
#pragma unroll
            for (int sec = 0; sec < 4; ++sec) { prv[sec] = make_uint2(0u, 0u); cur[sec] = *(const uint2*)(U + (size_t)rw0 * UW + sec * 256 + lane * 4); }
            if (rw0 > 0) {
#pragma unroll
                for (int sec = 0; sec < 4; ++sec) prv[sec] = *(const uint2*)(U + (size_t)(rw0 - 1) * UW + sec * 256 + lane * 4);
            }
            float4 mu4[4];
#pragma unroll
            for (int sec = 0; sec < 4; ++sec) mu4[sec] = *(const float4*)(mu + sec * 256 + lane * 4);
            const float4 kp4 = *(const float4*)(kkp + lane * 4);
#pragma unroll 1
            for (int i = 0; i < 17; ++i) {
                const int rl = wv * 17 + i, r = r0 + rl;
                const bool lat = r < NLAT;
                const int rnx = min(r + 1, NROW - 1);
                const bool more = (r + 1) < NROW;
#pragma unroll
                for (int sec = 0; sec < 4; ++sec) nxt[sec] = *(const uint2*)(U + (size_t)rnx * UW + sec * 256 + lane * 4);
                {
                    const bf16_t* uan = U + (size_t)rnx * UW + U_ATT + (ract ? rhd * 64 + rii : 0);
                    rn1 = *(const uint2*)uan; rn2 = *(const uint2*)(uan + 32);
                }
                if (!more) {
#pragma unroll
                    for (int sec = 0; sec < 4; ++sec) nxt[sec] = make_uint2(0u, 0u);
                }
                if (ract) {
                    bf16_t* ua = U + (size_t)r * UW + U_ATT + rhd * 64 + rii;
                    const float x1[4] = {bf2f((bf16_t)(rq1.x & 0xFFFF)), bf2f((bf16_t)(rq1.x >> 16)), bf2f((bf16_t)(rq1.y & 0xFFFF)), bf2f((bf16_t)(rq1.y >> 16))};
                    const float x2[4] = {bf2f((bf16_t)(rq2.x & 0xFFFF)), bf2f((bf16_t)(rq2.x >> 16)), bf2f((bf16_t)(rq2.y & 0xFFFF)), bf2f((bf16_t)(rq2.y >> 16))};
                    const float sc = (rhd < 4) ? 0.125f : 1.0f;
                    float o1[4], o2[4];
                    if (lat) {
                        const int t = r & 4095; const float prow = (float)(t >> 6), pcol = (float)(t & 63);
                        const float pp = (rii < 16) ? prow : pcol;
#pragma unroll
                        for (int j = 0; j < 4; ++j) {
                            const float ang = pp * rinv[j]; const float sn = __builtin_amdgcn_sinf(ang), cs = __builtin_amdgcn_cosf(ang);
                            o1[j] = (x1[j] * cs - x2[j] * sn) * sc; o2[j] = (x1[j] * sn + x2[j] * cs) * sc;
                        }
                    } else {
#pragma unroll
                        for (int j = 0; j < 4; ++j) { o1[j] = x1[j] * sc; o2[j] = x2[j] * sc; }
                    }
                    st4bf(ua, o1[0], o1[1], o1[2], o1[3]); st4bf(ua + 32, o2[0], o2[1], o2[2], o2[3]);
                }
                rq1 = rn1; rq2 = rn2;
                bool hp, hn;
                if (lat) { const int t = r & 4095; hp = t > 0; hn = t < 4095; } else { const int s = (r - NLAT) & 255; hp = s > 0; hn = s < 255; }
                float mx[4][4];
#pragma unroll
                for (int sec = 0; sec < 4; ++sec) {
                    const int c = sec * 256 + lane * 4;
                    const uint2 qc = cur[sec], qp = hp ? prv[sec] : make_uint2(0u, 0u), qn = hn ? nxt[sec] : make_uint2(0u, 0u);
                    const float u0[4] = {bf2f((bf16_t)(qc.x & 0xFFFF)), bf2f((bf16_t)(qc.x >> 16)), bf2f((bf16_t)(qc.y & 0xFFFF)), bf2f((bf16_t)(qc.y >> 16))};
                    const float up[4] = {bf2f((bf16_t)(qp.x & 0xFFFF)), bf2f((bf16_t)(qp.x >> 16)), bf2f((bf16_t)(qp.y & 0xFFFF)), bf2f((bf16_t)(qp.y >> 16))};
                    const float un[4] = {bf2f((bf16_t)(qn.x & 0xFFFF)), bf2f((bf16_t)(qn.x >> 16)), bf2f((bf16_t)(qn.y & 0xFFFF)), bf2f((bf16_t)(qn.y >> 16))};
                    const float4 m4 = mu4[sec];
                    mx[sec][0] = u0[0] + (0.5f * (up[0] + un[0]) - u0[0]) * m4.x; mx[sec][1] = u0[1] + (0.5f * (up[1] + un[1]) - u0[1]) * m4.y;
                    mx[sec][2] = u0[2] + (0.5f * (up[2] + un[2]) - u0[2]) * m4.z; mx[sec][3] = u0[3] + (0.5f * (up[3] + un[3]) - u0[3]) * m4.w;
                }
                float kkv[4];
                {
                    const float4 kp = kp4;
                    kkv[0] = mx[1][0] * kp.x; kkv[1] = mx[1][1] * kp.y; kkv[2] = mx[1][2] * kp.z; kkv[3] = mx[1][3] * kp.w;
                    float ss = kkv[0] * kkv[0] + kkv[1] * kkv[1] + kkv[2] * kkv[2] + kkv[3] * kkv[3];
                    ss += __shfl_xor(ss, 1); ss += __shfl_xor(ss, 2); ss += __shfl_xor(ss, 4); ss += __shfl_xor(ss, 8);
                    const float rn = rsqrtf(ss + 1e-6f);
                    kkv[0] *= rn; kkv[1] *= rn; kkv[2] *= rn; kkv[3] *= rn;
                }
                { uint2 w; w.x = pack2(mx[3][0], mx[3][1]); w.y = pack2(mx[3][2], mx[3][3]); *(uint2*)(xa_l + rl * 528 + lane * 8) = w; }
                bf16_t* mr = MIX + (size_t)r * 768 + lane * 4; bf16_t* er = EXT + (size_t)r * 1536 + lane * 4;
                st4bf(mr, mx[0][0], mx[0][1], mx[0][2], mx[0][3]); st4bf(mr + 256, mx[1][0], mx[1][1], mx[1][2], mx[1][3]); st4bf(mr + 512, mx[2][0], mx[2][1], mx[2][2], mx[2][3]);
                st4bf(er, kkv[0], kkv[1], kkv[2], kkv[3]);
#pragma unroll
                for (int sec = 0; sec < 4; ++sec) { prv[sec] = cur[sec]; cur[sec] = nxt[sec]; }
            }
        }
        __syncthreads();
#pragma unroll 1
        for (int pass = 0; pass < 2; ++pass) {
            const int nt = wv + 8 * pass;
            if (nt < 12) {
                bf16x8 bfr[8];
#pragma unroll
                for (int ks = 0; ks < 8; ++ks) bfr[ks] = *(const bf16x8*)(R1 + (size_t)(16 * nt + fr) * 256 + 32 * ks + 8 * fq);
                f32x4 acc[MT];
#pragma unroll
                for (int m = 0; m < MT; ++m) acc[m] = (f32x4){0.f, 0.f, 0.f, 0.f};
#pragma unroll
                for (int ks = 0; ks < 8; ++ks)
#pragma unroll
                    for (int m = 0; m < MT; ++m) {
                        const bf16x8 af = *(const bf16x8*)(xa_l + (16 * m + fr) * 528 + (32 * ks + 8 * fq) * 2);
                        acc[m] = __builtin_amdgcn_mfma_f32_16x16x32_bf16(bfr[ks], af, acc[m], 0, 0, 0);
                    }
#pragma unroll
                for (int m = 0; m < MT; ++m) {
                    float o[4];
#pragma unroll
                    for (int j = 0; j < 4; ++j) { const float x = acc[m][j]; o[j] = (nt < 4) ? tanh_fast(x) : ((nt < 8) ? x : sigmf(x)); }
                    uint2 w; w.x = pack2(o[0], o[1]); w.y = pack2(o[2], o[3]);
                    *(uint2*)(t1_l + (16 * m + fr) * 400 + (16 * nt + 4 * fq) * 2) = w;
                }
            }
        }
        __syncthreads();
#pragma unroll 1
        for (int q2 = 0; q2 < 5; ++q2) {
            const int nt = wv * 10 + 2 * q2, blk = nt >> 4, n0 = (nt & 15) * 16;
            f32x4 acc[2][MT];
#pragma unroll
            for (int t2 = 0; t2 < 2; ++t2)
#pragma unroll
                for (int m = 0; m < MT; ++m) acc[t2][m] = (f32x4){0.f, 0.f, 0.f, 0.f};
            const int br0 = n0 + ((fr >> 2) * 8 + (fr & 3)), br1 = br0 + 4;
            if (blk < 4) {
                const bf16x8 b0 = *(const bf16x8*)(R2 + ((size_t)blk * 256 + br0) * 32 + 8 * fq), b1 = *(const bf16x8*)(R2 + ((size_t)blk * 256 + br1) * 32 + 8 * fq);
#pragma unroll
                for (int m = 0; m < MT; ++m) {
                    const bf16x8 af = *(const bf16x8*)(t1_l + (16 * m + fr) * 400 + (32 * blk + 8 * fq) * 2);
                    acc[0][m] = __builtin_amdgcn_mfma_f32_16x16x32_bf16(b0, af, acc[0][m], 0, 0, 0);
                    acc[1][m] = __builtin_amdgcn_mfma_f32_16x16x32_bf16(b1, af, acc[1][m], 0, 0, 0);
                }
            } else {
#pragma unroll
                for (int ks = 0; ks < 2; ++ks) {
                    const bf16x8 b0 = *(const bf16x8*)(R2 + 4 * 256 * 32 + (size_t)br0 * 64 + 32 * ks + 8 * fq), b1 = *(const bf16x8*)(R2 + 4 * 256 * 32 + (size_t)br1 * 64 + 32 * ks + 8 * fq);
#pragma unroll
                    for (int m = 0; m < MT; ++m) {
                        const bf16x8 af = *(const bf16x8*)(t1_l + (16 * m + fr) * 400 + (128 + 32 * ks + 8 * fq) * 2);
                        acc[0][m] = __builtin_amdgcn_mfma_f32_16x16x32_bf16(b0, af, acc[0][m], 0, 0, 0);
                        acc[1][m] = __builtin_amdgcn_mfma_f32_16x16x32_bf16(b1, af, acc[1][m], 0, 0, 0);
                    }
                }
            }
            const int c = n0 + 8 * fq;
            float4 bia0 = make_float4(0.f, 0.f, 0.f, 0.f), bia1 = bia0;
            if (blk < 2) { bia0 = *(const float4*)(w0 + blk * 256 + c); bia1 = *(const float4*)(w0 + blk * 256 + c + 4); }
            else if (blk < 4) { bia0 = *(const float4*)(a0 + (blk - 2) * 256 + c); bia1 = *(const float4*)(a0 + (blk - 2) * 256 + c + 4); }
            const int ecol = (blk < 2) ? (256 + blk * 256) : ((blk < 4) ? (768 + (blk - 2) * 256) : 1280);
#pragma unroll
            for (int m = 0; m < MT; ++m) {
                if (16 * m + fr >= TR) continue;
                const int r = r0 + 16 * m + fr;
                float o[8] = {acc[0][m][0] + bia0.x, acc[0][m][1] + bia0.y, acc[0][m][2] + bia0.z, acc[0][m][3] + bia0.w,
                              acc[1][m][0] + bia1.x, acc[1][m][1] + bia1.y, acc[1][m][2] + bia1.z, acc[1][m][3] + bia1.w};
                if (blk < 2) {
#pragma unroll
                    for (int j = 0; j < 8; ++j) o[j] = -sigmf(o[j]) * 0.6065306597f;
                } else if (blk < 4) {
#pragma unroll
                    for (int j = 0; j < 8; ++j) o[j] = sigmf(o[j]);
                }
                *(uint4*)(EXT + (size_t)r * 1536 + ecol + c) = make_uint4(pack2(o[0], o[1]), pack2(o[2], o[3]), pack2(o[4], o[5]), pack2(o[6], o[7]));
            }
        }
        __syncthreads();
    }
}

__device__ __forceinline__ int seq_row(int b, int d, int pos) {
    if (pos < 256) { const int s = d ? 255 - pos : pos; return NLAT + b * 256 + s; }
    int t = pos - 256; if (d) t = 4095 - t; return b * 4096 + t;
}

__device__ __forceinline__ float2 cmul(float2 x, float2 y) { return make_float2(x.x * y.x - x.y * y.y, x.x * y.y + x.y * y.x); }

__device__ __forceinline__ void phase_s5ktab(const Args& a, int l, unsigned char* lds) {
    float* KT = (float*)(a.ws + WS_S5KT);
    float2* QD = (float2*)lds;
    float2* POW = QD + 64;
    static_assert(2 * 16 * 16 * 256 == 256 * NTHREADS, "one output per thread");
    __syncthreads();
    const int i = blockIdx.x * NTHREADS + threadIdx.x;
    const int c2 = i & 15, c = (i >> 4) & 15, lag = (i >> 8) & 15, g = (i >> 12) & 15, d = i >> 16;
    const float dt = __expf(a.in[29][(l * 2 + d) * 16 + g]);
    const float* lre_p = a.in[27] + ((size_t)(l * 2 + d) * 16 + g) * 64; const float* lim_p = a.in[28] + ((size_t)(l * 2 + d) * 16 + g) * 64;
    for (int j = threadIdx.x; j < 16 * 64; j += NTHREADS) {
        const int p = j & 63, lg = j >> 6;
        const float lre = lre_p[p], lim = lim_p[p];
        const float ml = __expf(lre * dt * (float)lg); float s2, c2_; sincosf(lim * dt * (float)lg, &s2, &c2_);
        POW[lg * 64 + p] = make_float2(ml * c2_, ml * s2);
        if (lg == 0) {
            const float mag = __expf(lre * dt); float sn, cs; sincosf(lim * dt, &sn, &cs);
            const float nre = mag * cs - 1.f, nim = mag * sn, den = lre * lre + lim * lim;
            QD[p] = make_float2((nre * lre + nim * lim) / den, (nim * lre - nre * lim) / den);
        }
    }
    __syncthreads();
    const float* cre = a.in[32] + (((size_t)(l * 2 + d) * 16 + g) * 16 + c) * 64; const float* cim = a.in[33] + (((size_t)(l * 2 + d) * 16 + g) * 16 + c) * 64;
    const float* bre = a.in[30] + ((size_t)(l * 16 + g) * 64) * 16 + c2; const float* bim = a.in[31] + ((size_t)(l * 16 + g) * 64) * 16 + c2;
    float v = 0.f;
#pragma unroll 4
    for (int p = 0; p < 64; ++p) {
        const float2 bb = cmul(QD[p], make_float2(bre[p * 16], bim[p * 16]));
        const float2 w = cmul(POW[lag * 64 + p], bb);
        v += cre[p] * w.x - cim[p] * w.y;
    }
    KT[i] = v;
    __syncthreads();
}

__device__ __forceinline__ void phase_s5setup(const Args& a, int l) {
    const float2* bbar = (const float2*)(a.ws + WS_S5P) + 2 * 16 * 64;
    const float2* PW = (const float2*)(a.ws + WS_S5PW);
    bf16_t* KF = (bf16_t*)(a.ws + WS_S5KF); bf16_t* E = (bf16_t*)(a.ws + WS_S5E); const float* KT = (const float*)(a.ws + WS_S5KT);
    const float* cre = a.in[32] + (size_t)l * 2 * 16 * 16 * 64; const float* cim = a.in[33] + (size_t)l * 2 * 16 * 16 * 64;
    const int gsz = gridDim.x * NTHREADS, gid = blockIdx.x * NTHREADS + threadIdx.x;
    for (int i8 = gid; i8 < 16 * 256 * 512 / 8; i8 += gsz) {
        const int k0 = (i8 & 63) * 8, n = (i8 >> 6) & 255, g = i8 >> 14, t = n >> 4, c = n & 15;
        float v[8];
        if (k0 < 256) {
            const int s = k0 >> 4, c20 = k0 & 15;
#pragma unroll
            for (int j = 0; j < 8; ++j) v[j] = 0.f;
            if (s <= t) {
                const float* kp = KT + (((0 * 16 + g) * 16 + (t - s)) * 16 + c) * 16 + c20;
                const float4 x0 = *(const float4*)kp, x1 = *(const float4*)(kp + 4);
                v[0] += x0.x; v[1] += x0.y; v[2] += x0.z; v[3] += x0.w; v[4] += x1.x; v[5] += x1.y; v[6] += x1.z; v[7] += x1.w;
            }
            if (s >= t) {
                const float* kp = KT + (((1 * 16 + g) * 16 + (s - t)) * 16 + c) * 16 + c20;
                const float4 x0 = *(const float4*)kp, x1 = *(const float4*)(kp + 4);
                v[0] += x0.x; v[1] += x0.y; v[2] += x0.z; v[3] += x0.w; v[4] += x1.x; v[5] += x1.y; v[6] += x1.z; v[7] += x1.w;
            }
            if (s == t && c >= c20 && c < c20 + 8) {
                const float dsk = a.in[34][(size_t)l * 256 + g * 16 + c];
#pragma unroll
                for (int j = 0; j < 8; ++j) if (c20 + j == c) v[j] += dsk;
            }
        } else {
            const int d = (k0 - 256) >> 7, pp0 = (k0 - 256) & 127, p0 = pp0 & 63;
            const int lag = d ? (16 - t) : (t + 1);
            const float* crp = cre + ((d * 16 + g) * 16 + c) * 64 + p0; const float* cip = cim + ((d * 16 + g) * 16 + c) * 64 + p0;
            const float4 r0 = *(const float4*)crp, r1 = *(const float4*)(crp + 4), i0 = *(const float4*)cip, i1 = *(const float4*)(cip + 4);
            const float rr[8] = {r0.x, r0.y, r0.z, r0.w, r1.x, r1.y, r1.z, r1.w}, ii[8] = {i0.x, i0.y, i0.z, i0.w, i1.x, i1.y, i1.z, i1.w};
#pragma unroll
            for (int j = 0; j < 8; ++j) {
                const float2 w = cmul(make_float2(rr[j], ii[j]), PW[((d * 16 + g) * 64 + p0 + j) * 17 + lag]);
                v[j] = (pp0 < 64) ? w.x : -w.y;
            }
        }
        *(uint4*)(KF + (size_t)i8 * 8) = make_uint4(pack2(v[0], v[1]), pack2(v[2], v[3]), pack2(v[4], v[5]), pack2(v[6], v[7]));
    }
    for (int i8 = gid; i8 < 16 * 2 * 128 * 256 / 8; i8 += gsz) {
        const int k0 = (i8 & 31) * 8, n = (i8 >> 5) & 127, d = (i8 >> 12) & 1, g = i8 >> 13, s = k0 >> 4, c20 = k0 & 15, p = n & 63;
        const int lag = d ? s : (15 - s);
        const float2 pw = PW[((d * 16 + g) * 64 + p) * 17 + lag];
        const float2* bp = bbar + ((size_t)(d * 16 + g) * 64 + p) * 16 + c20;
        float v[8];
#pragma unroll
        for (int j2 = 0; j2 < 4; ++j2) {
            const float4 b2 = *(const float4*)(bp + 2 * j2);
            const float2 w0 = cmul(pw, make_float2(b2.x, b2.y)), w1 = cmul(pw, make_float2(b2.z, b2.w));
            v[2 * j2] = (n < 64) ? w0.x : w0.y; v[2 * j2 + 1] = (n < 64) ? w1.x : w1.y;
        }
        *(uint4*)(E + (size_t)i8 * 8) = make_uint4(pack2(v[0], v[1]), pack2(v[2], v[3]), pack2(v[4], v[5]), pack2(v[6], v[7]));
    }
}

__device__ __forceinline__ void phase_s5g1(const Args& a, unsigned char* lds) {
    const int tid = threadIdx.x, lane = tid & 63, wid = tid >> 6, wr = wid >> 1, wc = wid & 1, fr = lane & 15, fq = lane >> 4;
    const bf16_t* AC = (const bf16_t*)(a.ws + WS_BIG + T_AC); const bf16_t* E = (const bf16_t*)(a.ws + WS_S5E);
    bf16_t* XE = (bf16_t*)(a.ws + WS_BIG + T_XE);
    for (int w = blockIdx.x; w < 16 * 2 * 9; w += gridDim.x) {
        const int mt = w % 9, gd = w / 9, g = gd >> 1;
        f32x4 acc[4][4];
#pragma unroll
        for (int m = 0; m < 4; ++m)
#pragma unroll
            for (int n = 0; n < 4; ++n) acc[m][n] = (f32x4){0.f, 0.f, 0.f, 0.f};
        gemm_pipe<4>(acc, [=](int r) -> unsigned { int R = mt * 256 + r; if (R > 2175) R = 2175; return (unsigned)(WS_BIG + T_AC + ((size_t)g * 2176 + R) * 1024); },
                     [=](int r) -> unsigned { return (unsigned)(WS_S5E + ((size_t)gd * 128 + r) * 512); }, 256, lds, a.ws);
#pragma unroll
        for (int m = 0; m < 4; ++m) {
            const int R = mt * 256 + wr * 64 + m * 16 + fr;
            if (R < 2176) {
#pragma unroll
                for (int n = 0; n < 4; ++n) st4bf(XE + ((size_t)gd * 2176 + R) * 128 + wc * 64 + n * 16 + fq * 4, acc[m][n][0], acc[m][n][1], acc[m][n][2], acc[m][n][3]);
            }
        }
    }
}

__device__ __forceinline__ void s5_carry(const Args& a, int chain) {
    const int lane = threadIdx.x & 63;
    const int b = chain >> 5, g = (chain >> 1) & 15, d = chain & 1;
    const float2* PW = (const float2*)(a.ws + WS_S5PW);
    const float2 a16 = PW[((d * 16 + g) * 64 + lane) * 17 + 16];
    const bf16_t* XE = (const bf16_t*)(a.ws + WS_BIG + T_XE) + ((size_t)(g * 2 + d) * 2176 + b * 272) * 128;
    bf16_t* AC = (bf16_t*)(a.ws + WS_BIG + T_AC) + ((size_t)g * 2176 + b * 272) * 512 + 256 + d * 128;
    float xr = 0.f, xi = 0.f;
    auto jof = [=](int step) -> int { return d ? ((step < 16) ? (15 - step) : (271 - (step - 16))) : step; };
    float nr[4], ni[4];
#pragma unroll
    for (int u = 0; u < 4; ++u) { const int j = jof(u); nr[u] = bf2f(XE[(size_t)j * 128 + lane]); ni[u] = bf2f(XE[(size_t)j * 128 + 64 + lane]); }
    for (int s0 = 0; s0 < 272; s0 += 4) {
        float cr[4], ci[4];
#pragma unroll
        for (int u = 0; u < 4; ++u) { cr[u] = nr[u]; ci[u] = ni[u]; }
        if (s0 + 4 < 272) {
#pragma unroll
            for (int u = 0; u < 4; ++u) { const int j = jof(s0 + 4 + u); nr[u] = bf2f(XE[(size_t)j * 128 + lane]); ni[u] = bf2f(XE[(size_t)j * 128 + 64 + lane]); }
        }
#pragma unroll
        for (int u = 0; u < 4; ++u) {
            const int j = jof(s0 + u);
            AC[(size_t)j * 512 + lane] = f2bf(xr); AC[(size_t)j * 512 + 64 + lane] = f2bf(xi);
            const float tr_ = a16.x * xr - a16.y * xi + cr[u], ti_ = a16.x * xi + a16.y * xr + ci[u];
            xr = tr_; xi = ti_;
        }
    }
}

__device__ __forceinline__ float gelu_tanh(float x) { return 0.5f * x * (1.f + tanh_fast(0.7978845608028654f * (x + 0.044715f * x * x * x))); }

__device__ __forceinline__ void phase_s5g2(const Args& a, unsigned char* lds, int bidx, int nblk) {
    const int tid = threadIdx.x, lane = tid & 63, wid = tid >> 6, wr = wid >> 1, wc = wid & 1, fr = lane & 15, fq = lane >> 4;
    const bf16_t* AC = (const bf16_t*)(a.ws + WS_BIG + T_AC); const bf16_t* KF = (const bf16_t*)(a.ws + WS_S5KF);
    bf16_t* YG = (bf16_t*)(a.ws + WS_BIG + T_XE);
    for (int w = bidx; w < 16 * 9 * 2; w += nblk) {
        const int nt2 = w & 1, mt = (w >> 1) % 9, g = (w >> 1) / 9;
        f32x4 acc[4][4];
#pragma unroll
        for (int m = 0; m < 4; ++m)
#pragma unroll
            for (int n = 0; n < 4; ++n) acc[m][n] = (f32x4){0.f, 0.f, 0.f, 0.f};
        gemm_pipe<4>(acc, [=](int r) -> unsigned { int R = mt * 256 + r; if (R > 2175) R = 2175; return (unsigned)(WS_BIG + T_AC + ((size_t)g * 2176 + R) * 1024); },
                     [=](int r) -> unsigned { return (unsigned)(WS_S5KF + ((size_t)g * 256 + nt2 * 128 + r) * 1024); }, 512, lds, a.ws);
#pragma unroll
        for (int m = 0; m < 4; ++m) {
            const int R = mt * 256 + wr * 64 + m * 16 + fr;
            if (R < 2176) {
                const int b = R / 272, j = R % 272;
#pragma unroll
                for (int n = 0; n < 4; ++n) {
                    const int nn = nt2 * 128 + wc * 64 + n * 16 + fq * 4, t = nn >> 4, c = nn & 15, pos = 16 * j + t;
                    const int row = (pos < 256) ? (NLAT + b * 256 + pos) : (b * 4096 + pos - 256);
                    st4bf(YG + (size_t)row * 256 + g * 16 + c, gelu_tanh(acc[m][n][0]), gelu_tanh(acc[m][n][1]), gelu_tanh(acc[m][n][2]), gelu_tanh(acc[m][n][3]));
                }
            }
        }
    }
}

__device__ __forceinline__ void phase_s5glu(const Args& a, int l, unsigned char* lds, int bidx, int nblk) {
    const int tid = threadIdx.x, lane = tid & 63, wid = tid >> 6, wr = wid >> 1, wc = wid & 1, fr = lane & 15, fq = lane >> 4;
    const bf16_t* YG = (const bf16_t*)(a.ws + WS_BIG + T_XE); const bf16_t* WG = (const bf16_t*)(a.ws + WS_WGLU);
    bf16_t* Y = (bf16_t*)(a.ws + WS_BIG + BIG_Y);
    const float* bgl = a.in[36] + (size_t)l * 256;
    const int nrows = (l == 0) ? NROW : NLAT;
    for (int w = bidx; w < (nrows / 256) * 2; w += nblk) {
        const int nt2 = w & 1, r0 = (w >> 1) * 256;
        f32x4 acc[4][4];
#pragma unroll
        for (int m = 0; m < 4; ++m)
#pragma unroll
            for (int n = 0; n < 4; ++n) acc[m][n] = (f32x4){0.f, 0.f, 0.f, 0.f};
        gemm_pipe<4>(acc, [=](int r) -> unsigned { return (unsigned)(WS_BIG + T_XE + (size_t)(r0 + r) * 512); }, [=](int r) -> unsigned { return (unsigned)(WS_WGLU + (size_t)(nt2 * 128 + r) * 512); }, 256, lds, a.ws);
#pragma unroll
        for (int m = 0; m < 4; ++m) {
            const int row = r0 + wr * 64 + m * 16 + fr;
#pragma unroll
            for (int n = 0; n < 4; ++n) {
                const int col = nt2 * 128 + wc * 64 + n * 16 + fq * 4;
                float yv[4]; ld4bf(YG + (size_t)row * 256 + col, yv);
                const float4 b4 = *(const float4*)(bgl + col);
                st4bf(Y + (size_t)row * 1024 + 768 + col, yv[0] * sigmf(acc[m][n][0] + b4.x), yv[1] * sigmf(acc[m][n][1] + b4.y), yv[2] * sigmf(acc[m][n][2] + b4.z), yv[3] * sigmf(acc[m][n][3] + b4.w));
            }
        }
    }
}

typedef float f32x16 __attribute__((ext_vector_type(16)));
typedef short s16x4 __attribute__((ext_vector_type(4)));
__device__ __forceinline__ unsigned lds_addr(const void* p) { return (unsigned)(size_t)(__attribute__((address_space(3))) const char*)p; }
template <int O0, int O1, int O2, int O3>
__device__ __forceinline__ void tr_read4(unsigned addr, s16x4& r0, s16x4& r1, s16x4& r2, s16x4& r3) {
    asm volatile("ds_read_b64_tr_b16 %0, %4 offset:%5\n\tds_read_b64_tr_b16 %1, %4 offset:%6\n\tds_read_b64_tr_b16 %2, %4 offset:%7\n\tds_read_b64_tr_b16 %3, %4 offset:%8\n\ts_waitcnt lgkmcnt(0)"
                 : "=&v"(r0), "=&v"(r1), "=&v"(r2), "=&v"(r3) : "v"(addr), "i"(O0), "i"(O1), "i"(O2), "i"(O3) : "memory");
}
__device__ __forceinline__ s16x4 tr_read1(unsigned addr) { s16x4 r; asm volatile("ds_read_b64_tr_b16 %0, %1\n\ts_waitcnt lgkmcnt(0)" : "=&v"(r) : "v"(addr) : "memory"); return r; }
template <int N> __device__ __forceinline__ float dpp_shr(float x) { return __int_as_float(__builtin_amdgcn_update_dpp(0, __float_as_int(x), 0x110 + N, 0xF, 0xF, true)); }
__device__ __forceinline__ s16x4 cvt4(const f32x4& x) { uint2 u; u.x = pack2(x[0], x[1]); u.y = pack2(x[2], x[3]); return __builtin_bit_cast(s16x4, u); }
__device__ __forceinline__ bf16x8 cat8(const s16x4& lo, const s16x4& hi) { bf16x8 r; r[0] = lo[0]; r[1] = lo[1]; r[2] = lo[2]; r[3] = lo[3]; r[4] = hi[0]; r[5] = hi[1]; r[6] = hi[2]; r[7] = hi[3]; return r; }
__device__ __forceinline__ f32x4 mm16(const f32x4& xa, const f32x4& yb) {
    return __builtin_amdgcn_mfma_f32_16x16x16bf16_1k(cvt4(xa), cvt4(yb), (f32x4){0.f, 0.f, 0.f, 0.f}, 0, 0, 0);
}
__device__ __forceinline__ f32x4 mm16b(const f32x4& xa, const s16x4& yb) {
    return __builtin_amdgcn_mfma_f32_16x16x16bf16_1k(cvt4(xa), yb, (f32x4){0.f, 0.f, 0.f, 0.f}, 0, 0, 0);
}
__device__ __forceinline__ void ld16bf(const bf16_t* p, float (&o)[16]) {
    const uint4 q0 = *(const uint4*)p, q1 = *(const uint4*)(p + 8);
    const unsigned w[8] = {q0.x, q0.y, q0.z, q0.w, q1.x, q1.y, q1.z, q1.w};
#pragma unroll
    for (int i = 0; i < 8; ++i) { o[2 * i] = bf2f((bf16_t)(w[i] & 0xFFFF)); o[2 * i + 1] = bf2f((bf16_t)(w[i] >> 16)); }
}
__device__ __forceinline__ void attn_mfma(const Args& a, int l, int aw, int naw, unsigned char* ldsw  ) {
    const int lane = threadIdx.x & 63, c = lane & 31, h2 = lane >> 5;
    const bf16_t* U = (const bf16_t*)(a.ws + WS_BIG + BIG_U);
    bf16_t* Y = (bf16_t*)(a.ws + WS_BIG + BIG_Y);
    bf16_t* vt = (bf16_t*)ldsw;
    const unsigned vtr = (unsigned)(size_t)(__attribute__((address_space(3))) const char*)ldsw + (4 * h2 + ((lane & 15) >> 2)) * 136 + (16 * ((lane >> 4) & 1) + (lane & 3) * 4) * 2;
    const int ntask = 4096 + ((l == 0) ? 256 : 0);
    for (int task = aw; task < ntask; task += naw) {
        int b, qt, h, qrow0; bool lat;
        if (task < 4096) { b = task >> 9; qt = (task >> 2) & 127; h = task & 3; qrow0 = b * 4096 + qt * 32; lat = true; }
        else { const int t2 = task - 4096; b = t2 >> 5; qt = (t2 >> 2) & 7; h = t2 & 3; qrow0 = NLAT + b * 256 + qt * 32; lat = false; }
        const int kvh = h >> 1;
        const int ti_lo = lat ? max(0, 4 - qt) : 0, nwin = lat ? (min(8, 131 - qt) - ti_lo + 1) : 0, ntile = nwin + 8;
        auto tile_row = [=](int n) -> int { return (n < nwin) ? (b * 4096 + (qt + ti_lo + n - 4) * 32) : (NLAT + b * 256 + (n - nwin) * 32); };
        bf16x8 qf[4];
        {
            const bf16_t* qp = U + (size_t)(qrow0 + c) * UW + U_ATT + h * 64 + 8 * h2;
#pragma unroll
            for (int s = 0; s < 4; ++s) qf[s] = *(const bf16x8*)(qp + 16 * s);
        }
        bf16x8 kfn[4]; uint4 vn[4];
        auto load_tile = [&](int n) {
            const int krow0 = tile_row(n);
            const bf16_t* kp = U + (size_t)(krow0 + c) * UW + U_ATT + 256 + kvh * 64 + 8 * h2;
#pragma unroll
            for (int s = 0; s < 4; ++s) kfn[s] = *(const bf16x8*)(kp + 16 * s);
#pragma unroll
            for (int i = 0; i < 4; ++i) {
                const int ch = lane + 64 * i, key = ch >> 3, dc = ch & 7;
                vn[i] = *(const uint4*)(U + (size_t)(krow0 + key) * UW + U_ATT + 384 + kvh * 64 + dc * 8);
            }
        };
        load_tile(0);
        f32x16 o0, o1;
#pragma unroll
        for (int r = 0; r < 16; ++r) { o0[r] = 0.f; o1[r] = 0.f; }
        float m = a.in[26][l * 4 + h];
        float lsum = (h2 == 0) ? 1.0f : 0.0f;
#pragma unroll 1
        for (int n = 0; n < ntile; ++n) {
            const int ti = ti_lo + n;
            const int mtype = (n < nwin) ? ((ti == 0) ? 1 : ((ti == 8) ? 2 : 0)) : 0;
            bf16x8 kf[4];
#pragma unroll
            for (int s = 0; s < 4; ++s) kf[s] = kfn[s];
#pragma unroll
            for (int i = 0; i < 4; ++i) {
                const int ch = lane + 64 * i, key = ch >> 3, dc = ch & 7;
                *(uint2*)(vt + key * 68 + dc * 8) = make_uint2(vn[i].x, vn[i].y);
                *(uint2*)(vt + key * 68 + dc * 8 + 4) = make_uint2(vn[i].z, vn[i].w);
            }
            if (n + 1 < ntile) load_tile(n + 1);
            f32x16 s;
#pragma unroll
            for (int r = 0; r < 16; ++r) s[r] = 0.f;
#pragma unroll
            for (int k4 = 0; k4 < 4; ++k4) s = __builtin_amdgcn_mfma_f32_32x32x16_bf16(kf[k4], qf[k4], s, 0, 0, 0);
            if (mtype != 0) {
#pragma unroll
                for (int r = 0; r < 16; ++r) {
                    const int j = (r & 3) + 8 * (r >> 2) + 4 * h2;
                    if ((mtype == 1 && j < c) || (mtype == 2 && j > c)) s[r] = -1.0e30f;
                }
            }
            float mx = s[0];
#pragma unroll
            for (int r = 1; r < 16; ++r) mx = fmaxf(mx, s[r]);
            mx = fmaxf(mx, __shfl_xor(mx, 32));
            const float mn = fmaxf(m, mx);
            const float alpha = __expf(m - mn);
            m = mn;
            float ps = 0.f;
#pragma unroll
            for (int r = 0; r < 16; ++r) { s[r] = __expf(s[r] - mn); ps += s[r]; }
            lsum = lsum * alpha + ps;
#pragma unroll
            for (int r = 0; r < 16; ++r) { o0[r] *= alpha; o1[r] *= alpha; }
            __builtin_amdgcn_wave_barrier();
#pragma unroll
            for (int ks = 0; ks < 2; ++ks) {
                bf16x8 pb;
                {
                    unsigned w0 = pack2(s[8 * ks], s[8 * ks + 1]), w1 = pack2(s[8 * ks + 2], s[8 * ks + 3]), w2 = pack2(s[8 * ks + 4], s[8 * ks + 5]), w3 = pack2(s[8 * ks + 6], s[8 * ks + 7]);
                    uint4 t4 = make_uint4(w0, w1, w2, w3); pb = __builtin_bit_cast(bf16x8, t4);
                }
                s16x4 a0, a1, b0, b1;
                if (ks == 0) tr_read4<0, 8 * 136, 64, 8 * 136 + 64>(vtr, a0, a1, b0, b1);
                else tr_read4<16 * 136, 24 * 136, 16 * 136 + 64, 24 * 136 + 64>(vtr, a0, a1, b0, b1);
                o0 = __builtin_amdgcn_mfma_f32_32x32x16_bf16(cat8(a0, a1), pb, o0, 0, 0, 0);
                o1 = __builtin_amdgcn_mfma_f32_32x32x16_bf16(cat8(b0, b1), pb, o1, 0, 0, 0);
            }
            __builtin_amdgcn_wave_barrier();
        }
        const float ltot = lsum + __shfl_xor(lsum, 32);
        const float inv = 1.0f / ltot;
        bf16_t* yo = Y + (size_t)(qrow0 + c) * 1024 + 512 + h * 64 + 4 * h2;
#pragma unroll
        for (int g = 0; g < 4; ++g) {
            st4bf(yo + 8 * g, o0[4 * g] * inv, o0[4 * g + 1] * inv, o0[4 * g + 2] * inv, o0[4 * g + 3] * inv);
            st4bf(yo + 32 + 8 * g, o1[4 * g] * inv, o1[4 * g + 1] * inv, o1[4 * g + 2] * inv, o1[4 * g + 3] * inv);
        }
    }
}

constexpr int RC_WA = 0, RC_BK = 2048, RC_V = 6144, RC_R = 8192, RC_U0 = 10240  , RC_AA = 12288, RC_PC = 13312, RC_SIZE = 13568;

struct RwRaw { uint4 q[12]; };
__device__ __forceinline__ void rwkv_load_raw(const Args& a, int b, int h, int d, int chunk, RwRaw& raw) {
    const int lane = threadIdx.x & 63, t = lane & 15, qp = lane >> 4;
    const bf16_t* MIX = (const bf16_t*)(a.ws + WS_BIG + T_MIX); const bf16_t* EXT = (const bf16_t*)(a.ws + WS_BIG + T_EXT);
    const int row = seq_row(b, d, chunk * 16 + t);
    const bf16_t* e0 = EXT + (size_t)row * 1536 + h * 64 + 16 * qp; const bf16_t* m0 = MIX + (size_t)row * 768 + h * 64 + 16 * qp;
    raw.q[0] = *(const uint4*)(e0 + 256 + d * 256); raw.q[1] = *(const uint4*)(e0 + 256 + d * 256 + 8);
    raw.q[2] = *(const uint4*)(e0); raw.q[3] = *(const uint4*)(e0 + 8);
    raw.q[4] = *(const uint4*)(e0 + 768 + d * 256); raw.q[5] = *(const uint4*)(e0 + 768 + d * 256 + 8);
    raw.q[6] = *(const uint4*)(m0); raw.q[7] = *(const uint4*)(m0 + 8);
    raw.q[8] = *(const uint4*)(m0 + 256); raw.q[9] = *(const uint4*)(m0 + 256 + 8);
    raw.q[10] = *(const uint4*)(m0 + 512); raw.q[11] = *(const uint4*)(m0 + 512 + 8);
}
__device__ __forceinline__ void un16(const uint4& q0, const uint4& q1, float (&o)[16]) {
    const unsigned w[8] = {q0.x, q0.y, q0.z, q0.w, q1.x, q1.y, q1.z, q1.w};
#pragma unroll
    for (int i = 0; i < 8; ++i) { o[2 * i] = bf2f((bf16_t)(w[i] & 0xFFFF)); o[2 * i + 1] = bf2f((bf16_t)(w[i] >> 16)); }
}
__device__ __forceinline__ void rwkv_chunkA(const RwRaw& raw, unsigned char* cl, const float (&ka)[16]) {
    const int lane = threadIdx.x & 63, t = lane & 15, qp = lane >> 4;
    unsigned pa[8], pr[8], pb[8], pk[8];
    {
        float L[16], lw[16];
        un16(raw.q[0], raw.q[1], lw);
#pragma unroll
        for (int e = 0; e < 16; ++e) {
            float x = lw[e];
            x += dpp_shr<1>(x); x += dpp_shr<2>(x); x += dpp_shr<4>(x); x += dpp_shr<8>(x);
            L[e] = x;
        }
        float kk[16], ic[16], rr[16], kx[16], vv[16];
        un16(raw.q[2], raw.q[3], kk); un16(raw.q[4], raw.q[5], ic); un16(raw.q[6], raw.q[7], rr); un16(raw.q[8], raw.q[9], kx); un16(raw.q[10], raw.q[11], vv);
        float eL[16];
#pragma unroll
        for (int e = 0; e < 16; ++e) eL[e] = __expf(L[e]);
        if (t == 15) {
            float* pcp = (float*)(cl + RC_PC) + 16 * qp;
#pragma unroll
            for (int e4 = 0; e4 < 4; ++e4) *(float4*)(pcp + 4 * e4) = make_float4(eL[4 * e4], eL[4 * e4 + 1], eL[4 * e4 + 2], eL[4 * e4 + 3]);
        }
        __builtin_amdgcn_wave_barrier();
        float pc[16];
        {
            const float* pcp = (const float*)(cl + RC_PC) + 16 * qp;
#pragma unroll
            for (int e4 = 0; e4 < 4; ++e4) { const float4 p4 = *(const float4*)(pcp + 4 * e4); pc[4 * e4] = p4.x; pc[4 * e4 + 1] = p4.y; pc[4 * e4 + 2] = p4.z; pc[4 * e4 + 3] = p4.w; }
        }
        unsigned pBh[8], pKh[8], pv[8];
#pragma unroll
        for (int e2 = 0; e2 < 8; ++e2) {
            float at[2], rt[2], bt[2], kt[2], Bh[2], Kh[2];
#pragma unroll
            for (int u = 0; u < 2; ++u) {
                const int e = 2 * e2 + u;
                const float aa = -kk[e], bb = kk[e] * ic[e], ke = kx[e] * (1.f + (ic[e] - 1.f) * ka[e]);
                const float sh = dpp_shr<1>(eL[e]);
                const float ePrev = (t == 0) ? 1.0f : sh, inv = __builtin_amdgcn_rcpf(eL[e]), eC = pc[e] * inv;
                at[u] = aa * ePrev; rt[u] = rr[e] * eL[e]; bt[u] = bb * inv; kt[u] = ke * inv; Bh[u] = bb * eC; Kh[u] = ke * eC;
            }
            pa[e2] = pack2(at[0], at[1]); pr[e2] = pack2(rt[0], rt[1]); pb[e2] = pack2(bt[0], bt[1]); pk[e2] = pack2(kt[0], kt[1]);
            pBh[e2] = pack2(Bh[0], Bh[1]); pKh[e2] = pack2(Kh[0], Kh[1]); pv[e2] = pack2(vv[2 * e2], vv[2 * e2 + 1]);
        }
        unsigned char* wp = cl + t * 128 + qp * 32;
        *(uint4*)(wp + RC_WA) = make_uint4(pa[0], pa[1], pa[2], pa[3]); *(uint4*)(wp + RC_WA + 16) = make_uint4(pa[4], pa[5], pa[6], pa[7]);
        *(uint4*)(wp + RC_BK) = make_uint4(pBh[0], pBh[1], pBh[2], pBh[3]); *(uint4*)(wp + RC_BK + 16) = make_uint4(pBh[4], pBh[5], pBh[6], pBh[7]);
        *(uint4*)(wp + RC_BK + 2048) = make_uint4(pKh[0], pKh[1], pKh[2], pKh[3]); *(uint4*)(wp + RC_BK + 2048 + 16) = make_uint4(pKh[4], pKh[5], pKh[6], pKh[7]);
        *(uint4*)(wp + RC_V) = make_uint4(pv[0], pv[1], pv[2], pv[3]); *(uint4*)(wp + RC_V + 16) = make_uint4(pv[4], pv[5], pv[6], pv[7]);
        *(uint4*)(wp + RC_R) = make_uint4(pr[0], pr[1], pr[2], pr[3]); *(uint4*)(wp + RC_R + 16) = make_uint4(pr[4], pr[5], pr[6], pr[7]);
    }
    bf16x8 fa[2], frr[2], fb[2], fk[2];
#pragma unroll
    for (int s = 0; s < 2; ++s) {
        fa[s] = __builtin_bit_cast(bf16x8, make_uint4(pa[4 * s], pa[4 * s + 1], pa[4 * s + 2], pa[4 * s + 3]));
        frr[s] = __builtin_bit_cast(bf16x8, make_uint4(pr[4 * s], pr[4 * s + 1], pr[4 * s + 2], pr[4 * s + 3]));
        fb[s] = __builtin_bit_cast(bf16x8, make_uint4(pb[4 * s], pb[4 * s + 1], pb[4 * s + 2], pb[4 * s + 3]));
        fk[s] = __builtin_bit_cast(bf16x8, make_uint4(pk[4 * s], pk[4 * s + 1], pk[4 * s + 2], pk[4 * s + 3]));
    }
    const f32x4 z4 = (f32x4){0.f, 0.f, 0.f, 0.f};
    auto mm2 = [&](const bf16x8 (&x)[2], const bf16x8 (&y)[2]) -> f32x4 {
        f32x4 r = __builtin_amdgcn_mfma_f32_16x16x32_bf16(x[0], y[0], z4, 0, 0, 0);
        return __builtin_amdgcn_mfma_f32_16x16x32_bf16(x[1], y[1], r, 0, 0, 0);
    };
    const int c = t, q = qp;
    f32x4 N = mm2(fa, fb), NT = mm2(fb, fa), AkT = mm2(fk, fa), ArbT = mm2(fb, frr), ArkT = mm2(fk, frr);
#pragma unroll
    for (int j = 0; j < 4; ++j) {
        const int rw = 4 * q + j;
        if (!(c < rw)) N[j] = 0.f;
        if (!(rw < c)) { NT[j] = 0.f; AkT[j] = 0.f; }
        if (!(rw <= c)) { ArbT[j] = 0.f; ArkT[j] = 0.f; }
    }
    f32x4 eye;
#pragma unroll
    for (int j = 0; j < 4; ++j) eye[j] = (4 * q + j == c) ? 1.f : 0.f;
    const f32x4 N2 = mm16(NT, N), N2T = mm16(N, NT);
    const f32x4 N4 = mm16(N2T, N2), N4T = mm16(N2, N2T);
    const f32x4 N8T = mm16(N4, N4T);
    f32x4 TT = N8T + eye;
    TT = mm16(N4 + eye, TT); TT = mm16(N2 + eye, TT); TT = mm16(N + eye, TT);
    const unsigned abase = lds_addr(cl) + (4 * q + (c >> 2)) * 128 + (c & 3) * 8;
    s16x4 ac[4], vc[4], bc[4], kc[4];
    tr_read4<RC_WA, RC_WA + 32, RC_WA + 64, RC_WA + 96>(abase, ac[0], ac[1], ac[2], ac[3]);
    tr_read4<RC_V, RC_V + 32, RC_V + 64, RC_V + 96>(abase, vc[0], vc[1], vc[2], vc[3]);
    tr_read4<RC_BK, RC_BK + 32, RC_BK + 64, RC_BK + 96>(abase, bc[0], bc[1], bc[2], bc[3]);
    tr_read4<RC_BK + 2048, RC_BK + 2048 + 32, RC_BK + 2048 + 64, RC_BK + 2048 + 96>(abase, kc[0], kc[1], kc[2], kc[3]);
#pragma unroll
    for (int nb = 0; nb < 4; ++nb) {
        const f32x4 wa = mm16b(TT, ac[nb]);
        const f32x4 g = mm16b(AkT, vc[nb]);
        const f32x4 u0 = mm16(TT, g);
        *(s16x4*)(cl + RC_WA + ((16 * nb + c) * 16 + 4 * q) * 2) = cvt4(wa);
        *(s16x4*)(cl + RC_U0 + ((16 * nb + c) * 16 + 4 * q) * 2) = cvt4(u0);
        *(bf16x8*)(cl + RC_BK + ((16 * nb + c) * 4 + q) * 16) = cat8(bc[nb], kc[nb]);
    }
    *(bf16x8*)(cl + RC_AA + (c * 4 + q) * 16) = cat8(cvt4(ArbT), cvt4(ArkT));
}

struct RwOps { s16x4 w0, w1, w2, w3, r0, r1, r2, r3, vcol[2], u0[2]; bf16x8 aa; bf16x8 bk[4]; float4 pc[4]; };
__device__ __forceinline__ void rwkv_ldops(const unsigned char* cl, int vh, RwOps& o) {
    const int lane = threadIdx.x & 63, c = lane & 15, q = lane >> 4;
    const unsigned base = lds_addr(cl);
    asm volatile("ds_read_b64_tr_b16 %0, %6\n\tds_read_b64_tr_b16 %1, %6 offset:512\n\tds_read_b64_tr_b16 %2, %6 offset:1024\n\tds_read_b64_tr_b16 %3, %6 offset:1536\n\tds_read_b64_tr_b16 %4, %7\n\tds_read_b64_tr_b16 %5, %7 offset:32"
                 : "=&v"(o.w0), "=&v"(o.w1), "=&v"(o.w2), "=&v"(o.w3), "=&v"(o.vcol[0]), "=&v"(o.vcol[1])
                 : "v"(base + RC_WA + (4 * q + (c >> 2)) * 32 + (c & 3) * 8), "v"(base + RC_V + (4 * q + (c >> 2)) * 128 + (vh * 32 + 4 * (c & 3)) * 2) : "memory");
    o.u0[0] = *(const s16x4*)(cl + RC_U0 + ((vh * 32 + c) * 16 + 4 * q) * 2); o.u0[1] = *(const s16x4*)(cl + RC_U0 + ((vh * 32 + 16 + c) * 16 + 4 * q) * 2);
    o.r0 = *(const s16x4*)(cl + RC_R + c * 128 + (4 * q) * 2); o.r1 = *(const s16x4*)(cl + RC_R + c * 128 + (16 + 4 * q) * 2);
    o.r2 = *(const s16x4*)(cl + RC_R + c * 128 + (32 + 4 * q) * 2); o.r3 = *(const s16x4*)(cl + RC_R + c * 128 + (48 + 4 * q) * 2);
    o.aa = *(const bf16x8*)(cl + RC_AA + (c * 4 + q) * 16);
#pragma unroll
    for (int i = 0; i < 4; ++i) { o.bk[i] = *(const bf16x8*)(cl + RC_BK + ((16 * i + c) * 4 + q) * 16); o.pc[i] = *(const float4*)(cl + RC_PC + (16 * i + 4 * q) * 4); }
}
__device__ __forceinline__ void rwkv_chunkB(int b, int h, int d, int chunk, RwOps& o, const unsigned char* nxt_cl, RwOps& on, int vh, f32x4 (&st)[2][4], bf16_t* YO) {
    const int lane = threadIdx.x & 63, c = lane & 15, q = lane >> 4;
    asm volatile("s_waitcnt lgkmcnt(0)" : "+v"(o.w0), "+v"(o.w1), "+v"(o.w2), "+v"(o.w3), "+v"(o.vcol[0]), "+v"(o.vcol[1]) :: "memory");
    float4 pc[4];
#pragma unroll
    for (int i = 0; i < 4; ++i) pc[i] = o.pc[i];
    if (nxt_cl) rwkv_ldops(nxt_cl, vh, on);
    const bf16x8 wa0 = cat8(o.w0, o.w1), wa1 = cat8(o.w2, o.w3), ra0 = cat8(o.r0, o.r1), ra1 = cat8(o.r2, o.r3);
    bf16_t* yrow = YO + (size_t)seq_row(b, d, chunk * 16 + c) * 256 + h * 64 + vh * 32 + 4 * q;
#pragma unroll
    for (int u2 = 0; u2 < 2; ++u2) {
        const bf16x8 sf0 = cat8(cvt4(st[u2][0]), cvt4(st[u2][1])), sf1 = cat8(cvt4(st[u2][2]), cvt4(st[u2][3]));
        f32x4 u;
        { const uint2 t = __builtin_bit_cast(uint2, o.u0[u2]); u = (f32x4){bf2f((bf16_t)(t.x & 0xFFFF)), bf2f((bf16_t)(t.x >> 16)), bf2f((bf16_t)(t.y & 0xFFFF)), bf2f((bf16_t)(t.y >> 16))}; }
        u = __builtin_amdgcn_mfma_f32_16x16x32_bf16(wa0, sf0, u, 0, 0, 0);
        u = __builtin_amdgcn_mfma_f32_16x16x32_bf16(wa1, sf1, u, 0, 0, 0);
        f32x4 y = __builtin_amdgcn_mfma_f32_16x16x32_bf16(sf0, ra0, (f32x4){0.f, 0.f, 0.f, 0.f}, 0, 0, 0);
        y = __builtin_amdgcn_mfma_f32_16x16x32_bf16(sf1, ra1, y, 0, 0, 0);
        const bf16x8 uv = cat8(cvt4(u), o.vcol[u2]);
#pragma unroll
        for (int i = 0; i < 4; ++i) {
            f32x4 cin = st[u2][i]; cin[0] *= pc[i].x; cin[1] *= pc[i].y; cin[2] *= pc[i].z; cin[3] *= pc[i].w;
            st[u2][i] = __builtin_amdgcn_mfma_f32_16x16x32_bf16(o.bk[i], uv, cin, 0, 0, 0);
        }
        y = __builtin_amdgcn_mfma_f32_16x16x32_bf16(uv, o.aa, y, 0, 0, 0);
        st4bf(yrow + u2 * 16, y[0], y[1], y[2], y[3]);
    }
}

#define RW_STEP_BARRIER() do { asm volatile("s_waitcnt lgkmcnt(0)" ::: "memory"); __builtin_amdgcn_s_barrier(); asm volatile("" ::: "memory"); } while (0)
__device__ __forceinline__ void scan_rwkv_chunked(const Args& a, int l, int chain, unsigned char* lds) {
    const int lane = threadIdx.x & 63, wv = threadIdx.x >> 6;
    const int b = chain >> 3, h = (chain >> 1) & 3, d = chain & 1;
    bf16_t* YO = (bf16_t*)(a.ws + WS_BIG + T_YRW) + (size_t)d * NROW * 256;
    constexpr int NCH = 272, SW = 6, NSTEP = (NCH + SW - 1) / SW;
    if (wv >= 2) {
        const int aw = wv - 2;
        float ka[16];
        {
            const float* kp = a.in[18] + (size_t)l * 256 + h * 64 + 16 * (lane >> 4);
#pragma unroll
            for (int e = 0; e < 16; ++e) ka[e] = kp[e];
        }
        RwRaw raw0, raw1;
        rwkv_load_raw(a, b, h, d, aw, raw0);
        rwkv_chunkA(raw0, lds + aw * RC_SIZE, ka);
        rwkv_load_raw(a, b, h, d, min(SW + aw, NCH - 1), raw0);
        rwkv_load_raw(a, b, h, d, min(2 * SW + aw, NCH - 1), raw1);
        RW_STEP_BARRIER();
        static_assert(NSTEP % 2 == 0, "step loop is unrolled by two");
#pragma unroll 1
        for (int step = 0; step < NSTEP; step += 2) {
            {
                const int cn = (step + 1) * SW + aw;
                if (step + 1 < NSTEP && cn < NCH) rwkv_chunkA(raw0, lds + (((step + 1) & 1) * SW + aw) * RC_SIZE, ka);
                rwkv_load_raw(a, b, h, d, min(cn + 2 * SW, NCH - 1), raw0);
            }
            RW_STEP_BARRIER();
            {
                const int cn = (step + 2) * SW + aw;
                if (step + 2 < NSTEP && cn < NCH) rwkv_chunkA(raw1, lds + (((step + 2) & 1) * SW + aw) * RC_SIZE, ka);
                rwkv_load_raw(a, b, h, d, min(cn + 2 * SW, NCH - 1), raw1);
            }
            RW_STEP_BARRIER();
        }
    } else {
        __builtin_amdgcn_s_setprio(3);
        f32x4 st[2][4];
#pragma unroll
        for (int u2 = 0; u2 < 2; ++u2)
#pragma unroll
            for (int i = 0; i < 4; ++i) st[u2][i] = (f32x4){0.f, 0.f, 0.f, 0.f};
        RW_STEP_BARRIER();
        for (int step = 0; step < NSTEP; ++step) {
            const unsigned char* bl = lds + ((step & 1) * SW) * RC_SIZE;
            const int n = min(SW, NCH - step * SW);
            RwOps o0, o1;
            rwkv_ldops(bl, wv, o0);
#pragma unroll 1
            for (int cc = 0; cc < n; cc += 2) {
                rwkv_chunkB(b, h, d, step * SW + cc, o0, bl + (cc + 1) * RC_SIZE, o1, wv, st, YO);
                rwkv_chunkB(b, h, d, step * SW + cc + 1, o1, (cc + 2 < n) ? bl + (cc + 2) * RC_SIZE : (const unsigned char*)nullptr, o0, wv, st, YO);
            }
            RW_STEP_BARRIER();
        }
        __builtin_amdgcn_s_setprio(0);
    }
}

#undef RW_STEP_BARRIER
template <int N> __device__ __forceinline__ float dpp_shl(float x) { return __int_as_float(__builtin_amdgcn_update_dpp(0, __float_as_int(x), 0x100 + N, 0xF, 0xF, true)); }
__device__ __forceinline__ f32x4 mfma16(const s16x4& a_, const s16x4& b_, const f32x4& c_) { return __builtin_amdgcn_mfma_f32_16x16x16bf16_1k(a_, b_, c_, 0, 0, 0); }
__device__ __forceinline__ float logsigf(float x) { return -0.6931471805599453f * __builtin_amdgcn_logf(1.0f + __expf(-x)); }

struct GlaBlk { int rowbase; };
__device__ __forceinline__ int gla_rowbase(int b, int tb) { return (tb < 4) ? (NLAT + b * 256 + tb * 64) : (b * 4096 + (tb - 4) * 64); }
__device__ __forceinline__ int gla_tb_of_chunk(int d, int cidx) { return d ? ((cidx < 4) ? (3 - cidx) : (4 + 63 - (cidx - 4))) : cidx; }

__device__ __forceinline__ void gla_logdecay(const bf16_t* U, int rowbase, int l, int h, int d, const float* A2, const float* AB, float (&la)[4][2][4], float (&P)[4][2][4], float (&tot)[2][4]) {
    const int lane = threadIdx.x & 63, t = lane & 15, q = lane >> 4;
    s16x4 a2t[2]; f32x4 bias[2];
#pragma unroll
    for (int kt = 0; kt < 2; ++kt) {
        uint2 w; w.x = pack2(A2[(4 * q) * 128 + h * 32 + 16 * kt + t], A2[(4 * q + 1) * 128 + h * 32 + 16 * kt + t]);
        w.y = pack2(A2[(4 * q + 2) * 128 + h * 32 + 16 * kt + t], A2[(4 * q + 3) * 128 + h * 32 + 16 * kt + t]);
        a2t[kt] = __builtin_bit_cast(s16x4, w);
        const float4 b4 = *(const float4*)(AB + h * 32 + 16 * kt + 4 * q);
        bias[kt] = (f32x4){b4.x, b4.y, b4.z, b4.w};
    }
    float run[2][4];
#pragma unroll
    for (int kt = 0; kt < 2; ++kt)
#pragma unroll
        for (int j = 0; j < 4; ++j) run[kt][j] = 0.f;
#pragma unroll
    for (int tt = 0; tt < 4; ++tt) {
        const s16x4 al = *(const s16x4*)(U + (size_t)(rowbase + 16 * tt + t) * UW + U_GLA + 768 + d * 16 + 4 * q);
#pragma unroll
        for (int kt = 0; kt < 2; ++kt) {
            const f32x4 x = mfma16(a2t[kt], al, bias[kt]);
#pragma unroll
            for (int j = 0; j < 4; ++j) {
                const float v = logsigf(x[j]) * (1.0f / 16.0f);
                la[tt][kt][j] = v;
                float s = v;
                s += dpp_shr<1>(s); s += dpp_shr<2>(s); s += dpp_shr<4>(s); s += dpp_shr<8>(s);
                P[tt][kt][j] = s + run[kt][j];
                run[kt][j] += __shfl(s, (lane & 48) | 15);
            }
        }
    }
#pragma unroll
    for (int kt = 0; kt < 2; ++kt)
#pragma unroll
        for (int j = 0; j < 4; ++j) tot[kt][j] = run[kt][j];
}

__device__ __forceinline__ void gla_stage_v(const bf16_t* U, int rowbase, int h, unsigned char* vl) {
    const int lane = threadIdx.x & 63;
#pragma unroll
    for (int i = 0; i < 8; ++i) {
        const int ch = lane + 64 * i, tok = ch >> 3, dc = ch & 7;
        *(uint4*)(vl + tok * 128 + dc * 16) = *(const uint4*)(U + (size_t)(rowbase + tok) * UW + U_GLA + 256 + h * 64 + dc * 8);
    }
}

__device__ __forceinline__ void gla_qk(const bf16_t* U, int rowbase, int h, int d, const float* A2, const float* AB, s16x4 (&qd)[4][2], s16x4 (&ki)[4][2]) {
    const int lane = threadIdx.x & 63, t = lane & 15, q = lane >> 4;
    s16x4 a2t[2]; f32x4 bias[2];
#pragma unroll
    for (int kt = 0; kt < 2; ++kt) {
        uint2 w; w.x = pack2(A2[(4 * q) * 128 + h * 32 + 16 * kt + t], A2[(4 * q + 1) * 128 + h * 32 + 16 * kt + t]);
        w.y = pack2(A2[(4 * q + 2) * 128 + h * 32 + 16 * kt + t], A2[(4 * q + 3) * 128 + h * 32 + 16 * kt + t]);
        a2t[kt] = __builtin_bit_cast(s16x4, w);
        const float4 b4 = *(const float4*)(AB + h * 32 + 16 * kt + 4 * q);
        bias[kt] = (f32x4){b4.x, b4.y, b4.z, b4.w};
    }
    float tot[2][4];
#pragma unroll
    for (int kt = 0; kt < 2; ++kt)
#pragma unroll
        for (int j = 0; j < 4; ++j) tot[kt][j] = 0.f;
    if (d) {
#pragma unroll
        for (int tt = 0; tt < 4; ++tt) {
            const s16x4 al = *(const s16x4*)(U + (size_t)(rowbase + 16 * tt + t) * UW + U_GLA + 768 + d * 16 + 4 * q);
#pragma unroll
            for (int kt = 0; kt < 2; ++kt) {
                const f32x4 x = mfma16(a2t[kt], al, bias[kt]);
#pragma unroll
                for (int j = 0; j < 4; ++j) tot[kt][j] += logsigf(x[j]) * (1.0f / 16.0f);
            }
        }
#pragma unroll
        for (int kt = 0; kt < 2; ++kt)
#pragma unroll
            for (int j = 0; j < 4; ++j) { float v = tot[kt][j]; v += __shfl_xor(v, 1); v += __shfl_xor(v, 2); v += __shfl_xor(v, 4); v += __shfl_xor(v, 8); tot[kt][j] = v; }
    }
    float run[2][4];
#pragma unroll
    for (int kt = 0; kt < 2; ++kt)
#pragma unroll
        for (int j = 0; j < 4; ++j) run[kt][j] = 0.f;
#pragma unroll
    for (int tt = 0; tt < 4; ++tt) {
        asm volatile("" ::: "memory");
        const s16x4 al = *(const s16x4*)(U + (size_t)(rowbase + 16 * tt + t) * UW + U_GLA + 768 + d * 16 + 4 * q);
#pragma unroll
        for (int kt = 0; kt < 2; ++kt) {
            const f32x4 x = mfma16(a2t[kt], al, bias[kt]);
            float qv[4], kv[4];
            ld4bf(U + (size_t)(rowbase + 16 * tt + t) * UW + U_GLA + h * 32 + 16 * kt + 4 * q, qv);
            ld4bf(U + (size_t)(rowbase + 16 * tt + t) * UW + U_GLA + 128 + h * 32 + 16 * kt + 4 * q, kv);
            float eq[4], ek[4];
#pragma unroll
            for (int j = 0; j < 4; ++j) {
                const float v = logsigf(x[j]) * (1.0f / 16.0f);
                float s = v;
                s += dpp_shr<1>(s); s += dpp_shr<2>(s); s += dpp_shr<4>(s); s += dpp_shr<8>(s);
                const float P = s + run[kt][j];
                run[kt][j] += __shfl(s, (lane & 48) | 15);
                const float cum = d ? (tot[kt][j] - P + v) : P;
                eq[j] = qv[j] * __expf(cum) * 0.17677669529663687f; ek[j] = kv[j] * __expf(-cum);
            }
            uint2 w; w.x = pack2(eq[0], eq[1]); w.y = pack2(eq[2], eq[3]); qd[tt][kt] = __builtin_bit_cast(s16x4, w);
            w.x = pack2(ek[0], ek[1]); w.y = pack2(ek[2], ek[3]); ki[tt][kt] = __builtin_bit_cast(s16x4, w);
        }
    }
}

__device__ __forceinline__ void gla_phaseA(const Args& a, int l, unsigned char* lds) {
    const int lane = threadIdx.x & 63, wv = threadIdx.x >> 6, t = lane & 15, q = lane >> 4;
    const bf16_t* U = (const bf16_t*)(a.ws + WS_BIG + BIG_U);
    f32x4* GD = (f32x4*)(a.ws + WS_BIG + T_GD); float* GDEC = (float*)(a.ws + WS_BIG + T_GDEC);
    unsigned char* vl = lds + wv * 12288; unsigned char* kl = vl + 8192;
    for (int task = blockIdx.x * 8 + wv; task < 64 * 68; task += gridDim.x * 8) {
        const int chain = task / 68, cidx = task % 68;
        const int b = chain >> 3, h = (chain >> 1) & 3, d = chain & 1;
        const int rowbase = gla_rowbase(b, gla_tb_of_chunk(d, cidx));
        const float* A2 = a.in[23] + ((size_t)l * 2 + d) * 16 * 128; const float* AB = a.in[24] + ((size_t)l * 2 + d) * 128;
        float la[4][2][4], P[4][2][4], tot[2][4];
        gla_logdecay(U, rowbase, l, h, d, A2, AB, la, P, tot);
        gla_stage_v(U, rowbase, h, vl);
#pragma unroll
        for (int tt = 0; tt < 4; ++tt)
#pragma unroll
            for (int kt = 0; kt < 2; ++kt) {
                float kv[4]; ld4bf(U + (size_t)(rowbase + 16 * tt + t) * UW + U_GLA + 128 + h * 32 + 16 * kt + 4 * q, kv);
                float e[4];
#pragma unroll
                for (int j = 0; j < 4; ++j) e[j] = kv[j] * __expf(d ? (P[tt][kt][j] - la[tt][kt][j]) : (tot[kt][j] - P[tt][kt][j]));
                uint2 w; w.x = pack2(e[0], e[1]); w.y = pack2(e[2], e[3]);
                *(uint2*)(kl + (16 * tt + t) * 64 + (16 * kt + 4 * q) * 2) = w;
            }
        if (t == 0) {
#pragma unroll
            for (int kt = 0; kt < 2; ++kt) *(float4*)(GDEC + (size_t)task * 32 + 16 * kt + 4 * q) = make_float4(__expf(tot[kt][0]), __expf(tot[kt][1]), __expf(tot[kt][2]), __expf(tot[kt][3]));
        }
        __builtin_amdgcn_wave_barrier();
        const unsigned kbase = lds_addr(kl) + (4 * q + (t >> 2)) * 64 + (t & 3) * 8;
        const unsigned vbase = lds_addr(vl) + (4 * q + (t >> 2)) * 128 + (t & 3) * 8;
        f32x4 acc[2][4];
#pragma unroll
        for (int kt = 0; kt < 2; ++kt)
#pragma unroll
            for (int dvt = 0; dvt < 4; ++dvt) acc[kt][dvt] = (f32x4){0.f, 0.f, 0.f, 0.f};
#pragma unroll
        for (int tt = 0; tt < 4; ++tt) {
            s16x4 k0 = tr_read1(kbase + tt * 1024), k1 = tr_read1(kbase + tt * 1024 + 32);
            s16x4 v0, v1, v2, v3;
            tr_read4<0, 32, 64, 96>(vbase + tt * 2048, v0, v1, v2, v3);
            acc[0][0] = mfma16(k0, v0, acc[0][0]); acc[0][1] = mfma16(k0, v1, acc[0][1]); acc[0][2] = mfma16(k0, v2, acc[0][2]); acc[0][3] = mfma16(k0, v3, acc[0][3]);
            acc[1][0] = mfma16(k1, v0, acc[1][0]); acc[1][1] = mfma16(k1, v1, acc[1][1]); acc[1][2] = mfma16(k1, v2, acc[1][2]); acc[1][3] = mfma16(k1, v3, acc[1][3]);
        }
#pragma unroll
        for (int kt = 0; kt < 2; ++kt)
#pragma unroll
            for (int dvt = 0; dvt < 4; ++dvt) GD[((size_t)task * 8 + kt * 4 + dvt) * 64 + lane] = acc[kt][dvt];
        __builtin_amdgcn_wave_barrier();
    }
}

__device__ __forceinline__ void gla_phaseB(const Args& a, int task) {
    const int lane = threadIdx.x & 63, q = lane >> 4, chain = task >> 1, hf = task & 1;
    f32x4* GD = (f32x4*)(a.ws + WS_BIG + T_GD) + (size_t)chain * 68 * 8 * 64 + hf * 4 * 64 + lane;
    const float* GDEC = (const float*)(a.ws + WS_BIG + T_GDEC) + (size_t)chain * 68 * 32 + hf * 16 + 4 * q;
    f32x4 s[4];
#pragma unroll
    for (int i = 0; i < 4; ++i) s[i] = (f32x4){0.f, 0.f, 0.f, 0.f};
    f32x4 nx[4][4]; float4 ndc[4];
#pragma unroll
    for (int p = 0; p < 4; ++p) {
#pragma unroll
        for (int i = 0; i < 4; ++i) nx[p][i] = GD[((size_t)p * 8 + i) * 64];
        ndc[p] = *(const float4*)(GDEC + p * 32);
    }
#pragma unroll 1
    for (int c = 0; c < 68; c += 4) {
#pragma unroll
        for (int u = 0; u < 4; ++u) {
            f32x4 dl[4];
#pragma unroll
            for (int i = 0; i < 4; ++i) dl[i] = nx[u][i];
            const float4 dd = ndc[u];
            if (c + u + 4 < 68) {
#pragma unroll
                for (int i = 0; i < 4; ++i) nx[u][i] = GD[((size_t)(c + u + 4) * 8 + i) * 64];
                ndc[u] = *(const float4*)(GDEC + (c + u + 4) * 32);
            }
#pragma unroll
            for (int i = 0; i < 4; ++i) {
                GD[((size_t)(c + u) * 8 + i) * 64] = s[i];
                s[i][0] = s[i][0] * dd.x + dl[i][0]; s[i][1] = s[i][1] * dd.y + dl[i][1]; s[i][2] = s[i][2] * dd.z + dl[i][2]; s[i][3] = s[i][3] * dd.w + dl[i][3];
            }
        }
    }
}

__device__ __forceinline__ void gla_phaseC(const Args& a, int l, unsigned char* lds, int bidx, int nblk) {
    const int lane = threadIdx.x & 63, wv = threadIdx.x >> 6, t = lane & 15, q = lane >> 4;
    const bf16_t* U = (const bf16_t*)(a.ws + WS_BIG + BIG_U);
    const f32x4* GD = (const f32x4*)(a.ws + WS_BIG + T_GD);
    bf16_t* Y = (bf16_t*)(a.ws + WS_BIG + BIG_Y);
    unsigned char* vl = lds + wv * 8192;
    const int tb0 = (l == 0) ? 0 : 4;
    const int ntb = 68 - tb0;
    for (int task = bidx * 8 + wv; task < 8 * 4 * ntb * 2; task += nblk * 8) {
        const int half = task & 1, tk = task >> 1;
        const int b = tk / (4 * ntb), rem = tk % (4 * ntb), h = rem / ntb, tb = tb0 + rem % ntb;
        const int rowbase = gla_rowbase(b, tb);
        gla_stage_v(U, rowbase, h, vl);
        __builtin_amdgcn_wave_barrier();
        const unsigned vbase = lds_addr(vl) + (4 * q + (t >> 2)) * 128 + (t & 3) * 8;
        f32x4 o[4][2];
#pragma unroll
        for (int dvt = 0; dvt < 4; ++dvt)
#pragma unroll
            for (int i2 = 0; i2 < 2; ++i2) o[dvt][i2] = (f32x4){0.f, 0.f, 0.f, 0.f};
#pragma unroll 1
        for (int d = 0; d < 2; ++d) {
            const float* A2 = a.in[23] + ((size_t)l * 2 + d) * 16 * 128; const float* AB = a.in[24] + ((size_t)l * 2 + d) * 128;
            const int cidx = d ? ((tb < 4) ? (3 - tb) : (4 + 63 - (tb - 4))) : tb;
            const int chain = (b * 4 + h) * 2 + d;
            const f32x4* sg = GD + ((size_t)chain * 68 + cidx) * 8 * 64 + lane;
            f32x4 sra[4], srb[4];
#pragma unroll
            for (int i8 = 0; i8 < 4; ++i8) sra[i8] = sg[i8 * 64];
            asm volatile("" ::: "memory");
            s16x4 qall[4][2], ki[4][2];
            gla_qk(U, rowbase, h, d, A2, AB, qall, ki);
            s16x4 qd[2][2];
#pragma unroll
            for (int i2 = 0; i2 < 2; ++i2)
#pragma unroll
                for (int kt = 0; kt < 2; ++kt)
#pragma unroll
                    for (int e = 0; e < 4; ++e) qd[i2][kt][e] = half ? qall[2 + i2][kt][e] : qall[i2][kt][e];
#pragma unroll
            for (int i2 = 0; i2 < 2; ++i2) {
                const int it = 2 * half + i2;
#pragma unroll
                for (int jt = 0; jt < 4; ++jt) {
                    if (d == 0 ? (jt > it) : (jt < it)) continue;
                    f32x4 p = mfma16(ki[jt][0], qd[i2][0], (f32x4){0.f, 0.f, 0.f, 0.f});
                    p = mfma16(ki[jt][1], qd[i2][1], p);
                    if (jt == it) {
#pragma unroll
                        for (int j = 0; j < 4; ++j) { const int jj = 4 * q + j; if (d == 0 ? (jj > t) : (jj < t)) p[j] = 0.f; }
                    }
                    const s16x4 pb = cvt4(p);
                    s16x4 v0, v1, v2, v3;
                    tr_read4<0, 32, 64, 96>(vbase + jt * 2048, v0, v1, v2, v3);
                    o[0][i2] = mfma16(v0, pb, o[0][i2]); o[1][i2] = mfma16(v1, pb, o[1][i2]); o[2][i2] = mfma16(v2, pb, o[2][i2]); o[3][i2] = mfma16(v3, pb, o[3][i2]);
                }
            }
#pragma unroll
            for (int i8 = 0; i8 < 4; ++i8) srb[i8] = sg[(4 + i8) * 64];
            asm volatile("" ::: "memory");
#pragma unroll
            for (int kt = 0; kt < 2; ++kt)
#pragma unroll
                for (int dvt = 0; dvt < 4; ++dvt) {
                    const s16x4 sa = cvt4(kt ? srb[dvt] : sra[dvt]);
                    o[dvt][0] = mfma16(sa, qd[0][kt], o[dvt][0]); o[dvt][1] = mfma16(sa, qd[1][kt], o[dvt][1]);
                }
        }
#pragma unroll
        for (int i2 = 0; i2 < 2; ++i2) {
            float ss = 0.f;
#pragma unroll
            for (int dvt = 0; dvt < 4; ++dvt)
#pragma unroll
                for (int j = 0; j < 4; ++j) ss += o[dvt][i2][j] * o[dvt][i2][j];
            ss += __shfl_xor(ss, 16); ss += __shfl_xor(ss, 32);
            const float rn = rsqrtf(ss * (1.0f / 64.0f) + 1e-6f);
            const int row = rowbase + 16 * (2 * half + i2) + t;
#pragma unroll
            for (int dvt = 0; dvt < 4; ++dvt) {
                const int c0 = h * 64 + 16 * dvt + 4 * q;
                float rr[4]; ld4bf(U + (size_t)row * UW + U_GLA + 512 + c0, rr);
                const float4 g4 = *(const float4*)(a.in[25] + (size_t)l * 256 + c0);
                st4bf(Y + (size_t)row * 1024 + 256 + c0, o[dvt][i2][0] * rn * g4.x * siluf(rr[0]), o[dvt][i2][1] * rn * g4.y * siluf(rr[1]),
                      o[dvt][i2][2] * rn * g4.z * siluf(rr[2]), o[dvt][i2][3] * rn * g4.w * siluf(rr[3]));
            }
        }
        __builtin_amdgcn_wave_barrier();
    }
}

__device__ __forceinline__ void sub_barrier(unsigned* cnt, unsigned target) {
    asm volatile("s_waitcnt vmcnt(0)" ::: "memory");
    __syncthreads();
    if (threadIdx.x == 0) {
        __builtin_amdgcn_fence(__ATOMIC_RELEASE, "agent");
        asm volatile("s_waitcnt vmcnt(0)" ::: "memory");
        (void)__hip_atomic_fetch_add(cnt, 1u, __ATOMIC_RELAXED, __HIP_MEMORY_SCOPE_AGENT);
        unsigned sp = 0;
        while (__hip_atomic_load(cnt, __ATOMIC_RELAXED, __HIP_MEMORY_SCOPE_AGENT) < target) { __builtin_amdgcn_s_sleep(2); if (++sp > (1u << 22)) break; }
        __builtin_amdgcn_fence(__ATOMIC_ACQUIRE, "agent");
        asm volatile("s_waitcnt vmcnt(0)" ::: "memory");
    }
    __syncthreads();
}

__device__ __forceinline__ void phase_scan(const Args& a, int l, unsigned char* lds) {
    const int wv = threadIdx.x >> 6;
    unsigned char* ldsw = lds + wv * 12288;
    const int bid = blockIdx.x;
    if (bid < 64) { scan_rwkv_chunked(a, l, bid, lds); return; }
    if (bid < 80) gla_phaseB(a, (bid - 64) * 8 + wv);
    else if (bid < 112) s5_carry(a, (bid - 80) * 8 + wv);
    else attn_mfma(a, l, (bid - 112) * 8 + wv, (gridDim.x - 112) * 8, ldsw);
    unsigned* sc = (unsigned*)(a.ws + WS_CNT) + 256 + l * 128;
    const unsigned nsub = gridDim.x - 64;
    sub_barrier(sc, nsub);
    gla_phaseC(a, l, lds, bid - 64, (int)nsub);
    __syncthreads();
    phase_s5g2(a, lds, bid - 64, (int)nsub);
    sub_barrier(sc + 64, nsub);
    phase_s5glu(a, l, lds, bid - 64, (int)nsub);
    phase_convert(a, l, lds, false, true, bid - 64, (int)nsub, 0, (l == 0) ? 3 * 4096 - ECONV_L0_TAIL : 3 * 4096);
}

__device__ __forceinline__ void phase_fin(const Args& a, int l, unsigned char* lds) {
    int tid = threadIdx.x; asm volatile("" : "+v"(tid));
    const int lane = tid & 63, wv = tid >> 6, l32 = lane & 31, rsel = lane >> 5;
    const int gw = blockIdx.x * 8 + wv, nw = gridDim.x * 8;
    const bf16_t* MIX = (const bf16_t*)(a.ws + WS_BIG + T_MIX); const bf16_t* EXT = (const bf16_t*)(a.ws + WS_BIG + T_EXT);
    const bf16_t* YRW = (const bf16_t*)(a.ws + WS_BIG + T_YRW);
    bf16_t* Y = (bf16_t*)(a.ws + WS_BIG + BIG_Y);
    const int nrows = (l == 0) ? NROW : NLAT;
    const int c = l32 * 8;
    float rk[8], lg[8];
    {
        const float4 r0 = *(const float4*)(a.in[19] + (size_t)l * 256 + c), r1 = *(const float4*)(a.in[19] + (size_t)l * 256 + c + 4);
        const float4 g0 = *(const float4*)(a.in[22] + (size_t)l * 256 + c), g1 = *(const float4*)(a.in[22] + (size_t)l * 256 + c + 4);
        rk[0] = r0.x; rk[1] = r0.y; rk[2] = r0.z; rk[3] = r0.w; rk[4] = r1.x; rk[5] = r1.y; rk[6] = r1.z; rk[7] = r1.w;
        lg[0] = g0.x; lg[1] = g0.y; lg[2] = g0.z; lg[3] = g0.w; lg[4] = g1.x; lg[5] = g1.y; lg[6] = g1.z; lg[7] = g1.w;
    }
    auto un8 = [](const uint4& q, float (&o)[8]) {
        o[0] = bf2f((bf16_t)(q.x & 0xFFFF)); o[1] = bf2f((bf16_t)(q.x >> 16)); o[2] = bf2f((bf16_t)(q.y & 0xFFFF)); o[3] = bf2f((bf16_t)(q.y >> 16));
        o[4] = bf2f((bf16_t)(q.z & 0xFFFF)); o[5] = bf2f((bf16_t)(q.z >> 16)); o[6] = bf2f((bf16_t)(q.w & 0xFFFF)); o[7] = bf2f((bf16_t)(q.w >> 16));
    };
    for (int rp = gw; 2 * rp < nrows; rp += nw) {
        const int r = 2 * rp + rsel;
        float y0[8], y1[8], rr[8], kk[8], vv[8], gg[8];
        un8(*(const uint4*)(YRW + (size_t)r * 256 + c), y0); un8(*(const uint4*)(YRW + (size_t)(NROW + r) * 256 + c), y1);
        un8(*(const uint4*)(MIX + (size_t)r * 768 + c), rr); un8(*(const uint4*)(MIX + (size_t)r * 768 + 256 + c), kk); un8(*(const uint4*)(MIX + (size_t)r * 768 + 512 + c), vv);
        un8(*(const uint4*)(EXT + (size_t)r * 1536 + 1280 + c), gg);
        float y[8]; float sm = 0.f;
#pragma unroll
        for (int j = 0; j < 8; ++j) { y[j] = y0[j] + y1[j]; sm += y[j]; }
        sm += __shfl_xor(sm, 1); sm += __shfl_xor(sm, 2); sm += __shfl_xor(sm, 4);
        const float mu = sm * (1.0f / 64.0f);
        float vs = 0.f, bs = 0.f;
#pragma unroll
        for (int j = 0; j < 8; ++j) { vs += (y[j] - mu) * (y[j] - mu); bs += rr[j] * kk[j] * rk[j]; }
        vs += __shfl_xor(vs, 1); vs += __shfl_xor(vs, 2); vs += __shfl_xor(vs, 4);
        bs += __shfl_xor(bs, 1); bs += __shfl_xor(bs, 2); bs += __shfl_xor(bs, 4);
        const float rsd = rsqrtf(vs * (1.0f / 64.0f) + 64e-5f);
        float o[8];
#pragma unroll
        for (int j = 0; j < 8; ++j) o[j] = ((y[j] - mu) * rsd * lg[j] + bs * vv[j]) * gg[j];
        *(uint4*)(Y + (size_t)r * 1024 + c) = make_uint4(pack2(o[0], o[1]), pack2(o[2], o[3]), pack2(o[4], o[5]), pack2(o[6], o[7]));
    }
}

constexpr int LDS_BYTES = 160 * 1024;
enum { PH_PRO = 0, PH_N1, PH_G1, PH_PREP, PH_SCAN, PH_FIN, PH_MERGE, PH_G3, PH_N2, PH_M1, PH_M2, PH_PER_LAYER };
constexpr int PH_FINAL = 2 * PH_PER_LAYER, PH_COUNT = PH_FINAL + 1;

__global__ void __launch_bounds__(NTHREADS, 2) mega(Args a) {
    extern __shared__ __attribute__((aligned(16))) unsigned char lds[];
    if (threadIdx.x == 0) *(uint4*)(lds + LDS_BYTES - 16) = make_uint4(0u, 0u, 0u, 0u);
    __syncthreads();
    XcdBarrier bar = xcd_barrier_post((unsigned*)(a.ws + WS_BAR), (volatile LAS unsigned*)(lds + LDS_BYTES - 16));
#define IN(p) ((p) >= a.ph_lo && (p) < a.ph_hi)
#define SEAM(p) if (IN(p) && IN((p) + 1)) xcd_barrier(bar);
#define LAYER(l) { constexpr int base = (l) * PH_PER_LAYER; \
        if ((l) == 0) { if (IN(base + PH_PRO)) { phase_convert(a, 0, lds, true, false, blockIdx.x, gridDim.x); phase_ada(a, lds); phase_s5params(a, 0); phase_s5ktab(a, 0, lds); } \
        SEAM(base + PH_PRO) } \
        if (IN(base + PH_N1)) { phase_norm1(a, l, lds); phase_s5setup(a, l); } \
        SEAM(base + PH_N1) \
        if (IN(base + PH_G1)) phase_g1(a, lds); \
        SEAM(base + PH_G1) \
        if (IN(base + PH_PREP)) { phase_prep(a, l, lds); __syncthreads(); gla_phaseA(a, l, lds); __syncthreads(); phase_s5g1(a, lds); } \
        SEAM(base + PH_PREP) \
        if (IN(base + PH_SCAN)) phase_scan(a, l, lds); \
        SEAM(base + PH_SCAN) \
        if (IN(base + PH_FIN)) phase_fin(a, l, lds); \
        SEAM(base + PH_FIN) \
        if (IN(base + PH_MERGE)) phase_merge(a, l, lds); \
        SEAM(base + PH_MERGE) \
        if (IN(base + PH_G3)) phase_g3(a, l, lds); \
        SEAM(base + PH_G3) \
        if (IN(base + PH_N2)) phase_norm2(a, l, lds); \
        SEAM(base + PH_N2) \
        if (IN(base + PH_M1)) phase_moe1(a, l, lds); \
        SEAM(base + PH_M1) \
        if (IN(base + PH_M2)) { phase_moe2(a, l, lds); if ((l) == 0) { __syncthreads(); phase_convert(a, 1, lds, true, false, blockIdx.x, gridDim.x); phase_s5params(a, 1); phase_s5ktab(a, 1, lds); } } \
        if ((l) == 0) { if (IN(base + PH_M2) && IN(PH_PER_LAYER + PH_N1)) xcd_barrier(bar); } else { SEAM(base + PH_M2) } }
    LAYER(0)
    LAYER(1)
#undef LAYER
    if (IN(PH_FINAL)) phase_norm1(a, 2, lds);
#undef IN
}

extern "C" void kernel_launch(void* const* d_in, const int* in_sizes, int n_in, void* d_out, int out_size, void* d_ws, size_t ws_size, hipStream_t stream) {
    static int inited = 0;
    if (!inited) {
        if (n_in != 46 || ws_size < WS_END) { fprintf(stderr, "kernel_launch: bad sizes n_in %d ws %zu need %zu\n", n_in, ws_size, (size_t)WS_END); inited = -1; return; }
        if (hipFuncSetAttribute((const void*)mega, hipFuncAttributeMaxDynamicSharedMemorySize, LDS_BYTES) != hipSuccess) { fprintf(stderr, "hipFuncSetAttribute failed\n"); inited = -1; return; }
        int per_cu = 0;
        if (hipOccupancyMaxActiveBlocksPerMultiprocessor(&per_cu, (const void*)mega, NTHREADS, LDS_BYTES) != hipSuccess || per_cu < 1) { fprintf(stderr, "occupancy query says %d blocks per CU\n", per_cu); }
        (void)hipGetLastError();
        inited = 1;
    }
    if (inited < 0) return;
    (void)hipMemsetAsync((char*)d_ws, 0, 32768, stream);
    Args a{};
    for (int i = 0; i < 46; ++i) a.in[i] = (const float*)d_in[i];
    a.out = (float*)d_out; a.ws = (unsigned char*)d_ws;
    a.ph_lo = 0; a.ph_hi = PH_COUNT;
    hipLaunchKernelGGL(mega, dim3(256), dim3(NTHREADS), LDS_BYTES, stream, a);
}
```
